# Optimizing an MI355X kernel written in HIP

```python
import math
import jax, jax.numpy as jnp
from jax import lax
import numpy as np

D_MODEL = 1024
BATCH = 4
SEQ = 4096
DEPTH = 2
DEC_BATCH = 8
DEC_SEQ = 32
PAST_LEN = 4096

CHUNK = 64
N_MIXERS = 2
N_SSM_LAYERS = (DEPTH + 1) // 2
N_ATTN_LAYERS = DEPTH // 2
SSM_GROUP = 16
SSM_GROUPS = D_MODEL // SSM_GROUP
SSM_STATE = 64
DT_MIN = 1e-3
DT_MAX = 1e-1
N_HEADS = 16
N_KV_HEADS = 4
HEAD_DIM = 64
ATTN_WIDTH = N_HEADS * HEAD_DIM
KV_WIDTH = N_KV_HEADS * HEAD_DIM
IDX_HEADS = 8
IDX_DIM = 64
TOPK_MAX = 256
Q_BLOCK = 128
ROT_DIM = HEAD_DIM // 4
ROPE_THETA = 500000.0
OFF_K = ATTN_WIDTH
OFF_V = OFF_K + KV_WIDTH
OFF_QI = OFF_V + KV_WIDTH
OFF_KI = OFF_QI + IDX_HEADS * IDX_DIM
OFF_WI = OFF_KI + IDX_DIM
IN_COLS = OFF_WI + IDX_HEADS
D_FF = 2816
CONV_W = 3
EPS = 1e-6
NEG = -1e30

kernel_name = "hybrid_s5_dsa_convffn_stream_step"


def rms_norm(x, g):
    xf = x.astype(jnp.float32)
    y = xf * lax.rsqrt(jnp.mean(xf * xf, axis=-1, keepdims=True) + EPS)
    return (y * g.astype(jnp.float32)).astype(x.dtype)


def rotary_partial(x, pos):
    half = ROT_DIM // 2
    inv = ROPE_THETA ** (-jnp.arange(half, dtype=jnp.float32) / half)
    ang = pos.astype(jnp.float32)[:, None] * inv[None, :]
    cos = jnp.cos(ang)[None, :, None, :]
    sin = jnp.sin(ang)[None, :, None, :]
    xr = x[..., :ROT_DIM].astype(jnp.float32)
    x1, x2 = xr[..., :half], xr[..., half:]
    rot = jnp.concatenate([x1 * cos - x2 * sin, x2 * cos + x1 * sin], axis=-1).astype(x.dtype)
    return jnp.concatenate([rot, x[..., ROT_DIM:]], axis=-1)


def s5_discretize(lam_re, lam_im, log_dt, b_re, b_im):
    lre = jnp.minimum(lam_re.astype(jnp.float32), -1e-4)
    lim = lam_im.astype(jnp.float32)
    dt = jnp.exp(log_dt.astype(jnp.float32))[:, None]
    mag = jnp.exp(lre * dt)
    a_re = mag * jnp.cos(lim * dt)
    a_im = mag * jnp.sin(lim * dt)
    den = lre * lre + lim * lim
    n_re = a_re - 1.0
    f_re = (n_re * lre + a_im * lim) / den
    f_im = (a_im * lre - n_re * lim) / den
    br = b_re.astype(jnp.float32)
    bi = b_im.astype(jnp.float32)
    bb_re = f_re[..., None] * br - f_im[..., None] * bi
    bb_im = f_re[..., None] * bi + f_im[..., None] * br
    return a_re, a_im, bb_re, bb_im


def _cplx_combine(e1, e2):
    a1r, a1i, b1r, b1i = e1
    a2r, a2i, b2r, b2i = e2
    return (a2r * a1r - a2i * a1i,
            a2r * a1i + a2i * a1r,
            a2r * b1r - a2i * b1i + b2r,
            a2r * b1i + a2i * b1r + b2i)


def s5_mixer(u, h0_re, h0_im, lam_re, lam_im, log_dt, b_re, b_im, c_re, c_im, d_skip, w_glu, b_glu):
    b, t, _ = u.shape
    uf = u.astype(jnp.float32).reshape(b, t, SSM_GROUPS, SSM_GROUP)
    a_re, a_im, bb_re, bb_im = s5_discretize(lam_re, lam_im, log_dt, b_re, b_im)
    bu_re = jnp.einsum('btgc,gpc->btgp', uf, bb_re)
    bu_im = jnp.einsum('btgc,gpc->btgp', uf, bb_im)
    h0r = h0_re.astype(jnp.float32)
    h0i = h0_im.astype(jnp.float32)
    bu_re = bu_re.at[:, 0].add(a_re * h0r - a_im * h0i)
    bu_im = bu_im.at[:, 0].add(a_re * h0i + a_im * h0r)
    ar = jnp.broadcast_to(a_re, bu_re.shape)
    ai = jnp.broadcast_to(a_im, bu_im.shape)
    _, _, h_re, h_im = lax.associative_scan(_cplx_combine, (ar, ai, bu_re, bu_im), axis=1)
    y = (jnp.einsum('btgp,gcp->btgc', h_re, c_re.astype(jnp.float32))
         - jnp.einsum('btgp,gcp->btgc', h_im, c_im.astype(jnp.float32)))
    y = y + d_skip.astype(jnp.float32).reshape(SSM_GROUPS, SSM_GROUP) * uf
    z = jax.nn.gelu(y.reshape(b, t, D_MODEL)).astype(u.dtype)
    g = z @ w_glu + b_glu
    out = g[..., :D_MODEL] * jax.nn.sigmoid(g[..., D_MODEL:])
    return out.astype(u.dtype), h_re[:, -1], h_im[:, -1]


def dsa_project(xn, pos, w_in, q_norm, k_norm):
    b, t, _ = xn.shape
    proj = xn @ w_in
    q = proj[..., :OFF_K].reshape(b, t, N_HEADS, HEAD_DIM)
    k = proj[..., OFF_K:OFF_V].reshape(b, t, N_KV_HEADS, HEAD_DIM)
    v = proj[..., OFF_V:OFF_QI].reshape(b, t, N_KV_HEADS, HEAD_DIM)
    qi = proj[..., OFF_QI:OFF_KI].reshape(b, t, IDX_HEADS, IDX_DIM)
    ki = proj[..., OFF_KI:OFF_WI]
    wi = proj[..., OFF_WI:]
    q = rotary_partial(rms_norm(q, q_norm), pos)
    k = rotary_partial(rms_norm(k, k_norm), pos)
    qi = rotary_partial(qi, pos)
    ki = rotary_partial(ki[:, :, None, :], pos)[:, :, 0]
    return q, k, v, qi, ki, wi


def dsa_attend_block(q, qi, wi, qpos, k, v, ki, kpos, topk):
    b, tb = q.shape[0], q.shape[1]
    logits = jnp.einsum('bthd,bsd->bths', qi.astype(jnp.float32), ki.astype(jnp.float32)) * (IDX_DIM ** -0.5)
    score = jnp.einsum('bths,bth->bts', jax.nn.relu(logits), wi.astype(jnp.float32) * (IDX_HEADS ** -0.5))
    allowed = (kpos[None, :] // CHUNK) <= (qpos[:, None] // CHUNK)
    score = jnp.where(allowed[None], score, NEG)
    vals, idx = lax.top_k(score, topk)
    valid = vals > (0.5 * NEG)
    gather = jax.vmap(lambda rows, ii: rows[ii])
    ks = gather(k, idx).astype(jnp.float32)
    vs = gather(v, idx).astype(jnp.float32)
    qg = q.astype(jnp.float32).reshape(b, tb, N_KV_HEADS, N_HEADS // N_KV_HEADS, HEAD_DIM)
    s = jnp.einsum('btkgd,btjkd->btkgj', qg, ks) * (HEAD_DIM ** -0.5)
    s = jnp.where(valid[:, :, None, None, :], s, NEG)
    p = jax.nn.softmax(s, axis=-1)
    o = jnp.einsum('btkgj,btjkd->btkgd', p, vs)
    return o.reshape(b, tb, ATTN_WIDTH).astype(q.dtype)


def dsa_prompt_attend(q, qi, wi, pos, k, v, ki, topk):
    b, t = q.shape[0], q.shape[1]
    nb = t // Q_BLOCK
    to_blocks = lambda a: a.reshape((b, nb, Q_BLOCK) + a.shape[2:]).swapaxes(0, 1)

    def one_block(args):
        qb, qib, wib, pb = args
        return dsa_attend_block(qb, qib, wib, pb, k, v, ki, pos, topk)

    out = lax.map(one_block, (to_blocks(q), to_blocks(qi), to_blocks(wi), pos.reshape(nb, Q_BLOCK)))
    return out.swapaxes(0, 1).reshape(b, t, ATTN_WIDTH)


def conv_ffn(xn, conv_state, w_up, conv_w, conv_b, w_down):
    t = xn.shape[1]
    h = xn @ w_up
    a, bv = h[..., :D_FF], h[..., D_FF:]
    padded = jnp.concatenate([conv_state.astype(a.dtype), a], axis=1)
    c = conv_b + sum(conv_w[j] * padded[:, j:j + t] for j in range(CONV_W))
    out = (jax.nn.gelu(c) * bv) @ w_down
    return out, padded[:, -(CONV_W - 1):]


def setup_inputs(seed: int = 0) -> dict:
    key = jax.random.key(seed)
    ks = jax.random.split(key, 32)
    nrm = lambda k, shape, s: jax.random.normal(k, shape, jnp.float32) * s
    lam_im0 = math.pi * jnp.arange(SSM_STATE, dtype=jnp.float32)
    return {
        "x_prompt": nrm(ks[0], (BATCH, SEQ, D_MODEL), 1.0),
        "x_sample": nrm(ks[1], (DEC_BATCH, DEC_SEQ, D_MODEL), 1.0),
        "state_ssm_re": nrm(ks[2], (N_SSM_LAYERS, DEC_BATCH, SSM_GROUPS, SSM_STATE), 0.1),
        "state_ssm_im": nrm(ks[3], (N_SSM_LAYERS, DEC_BATCH, SSM_GROUPS, SSM_STATE), 0.1),
        "cache_k": nrm(ks[4], (N_ATTN_LAYERS, DEC_BATCH, PAST_LEN, N_KV_HEADS, HEAD_DIM), 1.0),
        "cache_v": nrm(ks[5], (N_ATTN_LAYERS, DEC_BATCH, PAST_LEN, N_KV_HEADS, HEAD_DIM), 1.0),
        "cache_kidx": nrm(ks[6], (N_ATTN_LAYERS, DEC_BATCH, PAST_LEN, IDX_DIM), 1.0),
        "cache_conv": nrm(ks[7], (DEPTH, DEC_BATCH, CONV_W - 1, D_FF), 1.0),
        "norm_mix": 1.0 + nrm(ks[8], (DEPTH, D_MODEL), 0.02),
        "norm_ffn": 1.0 + nrm(ks[9], (DEPTH, D_MODEL), 0.02),
        "ssm_lambda_re": -0.5 + nrm(ks[10], (N_SSM_LAYERS, SSM_GROUPS, SSM_STATE), 0.01),
        "ssm_lambda_im": lam_im0 + nrm(ks[11], (N_SSM_LAYERS, SSM_GROUPS, SSM_STATE), 0.01),
        "ssm_log_dt": jax.random.uniform(ks[12], (N_SSM_LAYERS, SSM_GROUPS), jnp.float32,
                                         math.log(DT_MIN), math.log(DT_MAX)),
        "ssm_b_re": nrm(ks[13], (N_SSM_LAYERS, SSM_GROUPS, SSM_STATE, SSM_GROUP), (2.0 * SSM_GROUP) ** -0.5),
        "ssm_b_im": nrm(ks[14], (N_SSM_LAYERS, SSM_GROUPS, SSM_STATE, SSM_GROUP), (2.0 * SSM_GROUP) ** -0.5),
        "ssm_c_re": nrm(ks[15], (N_SSM_LAYERS, SSM_GROUPS, SSM_GROUP, SSM_STATE), SSM_STATE ** -0.5),
        "ssm_c_im": nrm(ks[16], (N_SSM_LAYERS, SSM_GROUPS, SSM_GROUP, SSM_STATE), SSM_STATE ** -0.5),
        "ssm_d": nrm(ks[17], (N_SSM_LAYERS, D_MODEL), 1.0),
        "ssm_w_glu": nrm(ks[18], (N_SSM_LAYERS, D_MODEL, 2 * D_MODEL), D_MODEL ** -0.5),
        "ssm_b_glu": nrm(ks[19], (N_SSM_LAYERS, 2 * D_MODEL), 0.01),
        "attn_w_in": nrm(ks[20], (N_ATTN_LAYERS, D_MODEL, IN_COLS), D_MODEL ** -0.5),
        "attn_q_norm": 1.0 + nrm(ks[21], (N_ATTN_LAYERS, HEAD_DIM), 0.02),
        "attn_k_norm": 1.0 + nrm(ks[22], (N_ATTN_LAYERS, HEAD_DIM), 0.02),
        "attn_w_o": nrm(ks[23], (N_ATTN_LAYERS, ATTN_WIDTH, D_MODEL), ATTN_WIDTH ** -0.5),
        "ffn_w_up": nrm(ks[24], (DEPTH, D_MODEL, 2 * D_FF), D_MODEL ** -0.5),
        "ffn_conv_w": nrm(ks[25], (DEPTH, CONV_W, D_FF), CONV_W ** -0.5),
        "ffn_conv_b": nrm(ks[26], (DEPTH, D_FF), 0.01),
        "ffn_w_down": nrm(ks[27], (DEPTH, D_FF, D_MODEL), D_FF ** -0.5),
    }


def reference(x_prompt, x_sample, state_ssm_re, state_ssm_im, cache_k, cache_v, cache_kidx, cache_conv,
              norm_mix, norm_ffn, ssm_lambda_re, ssm_lambda_im, ssm_log_dt, ssm_b_re, ssm_b_im,
              ssm_c_re, ssm_c_im, ssm_d, ssm_w_glu, ssm_b_glu, attn_w_in, attn_q_norm, attn_k_norm,
              attn_w_o, ffn_w_up, ffn_conv_w, ffn_conv_b, ffn_w_down):
    b_p, t_p = x_prompt.shape[0], x_prompt.shape[1]
    b_s, t_s = x_sample.shape[0], x_sample.shape[1]
    past = cache_k.shape[2]
    pos_p = jnp.arange(t_p, dtype=jnp.int32)
    pos_s = past + jnp.arange(t_s, dtype=jnp.int32)
    kpos_s = jnp.arange(past + t_s, dtype=jnp.int32)
    topk_p = min(TOPK_MAX, t_p // 4)
    topk_s = min(TOPK_MAX, (past + t_s) // 4)

    xp, xs = x_prompt, x_sample
    ssm_re_p, ssm_im_p, ssm_re_s, ssm_im_s = [], [], [], []
    k_p, v_p, ki_p, k_s, v_s, ki_s = [], [], [], [], [], []
    conv_p, conv_s = [], []
    for i in range(DEPTH):
        j = i // N_MIXERS
        hp = rms_norm(xp, norm_mix[i])
        hs = rms_norm(xs, norm_mix[i])
        if i % N_MIXERS == 0:
            sp = (ssm_lambda_re[j], ssm_lambda_im[j], ssm_log_dt[j], ssm_b_re[j], ssm_b_im[j],
                  ssm_c_re[j], ssm_c_im[j], ssm_d[j], ssm_w_glu[j], ssm_b_glu[j])
            zero = jnp.zeros((b_p, SSM_GROUPS, SSM_STATE), jnp.float32)
            yp, hpr, hpi = s5_mixer(hp, zero, zero, *sp)
            ys, hsr, hsi = s5_mixer(hs, state_ssm_re[j], state_ssm_im[j], *sp)
            ssm_re_p.append(hpr.astype(x_prompt.dtype))
            ssm_im_p.append(hpi.astype(x_prompt.dtype))
            ssm_re_s.append(hsr.astype(state_ssm_re.dtype))
            ssm_im_s.append(hsi.astype(state_ssm_im.dtype))
        else:
            qp, kp, vp, qip, kip, wip = dsa_project(hp, pos_p, attn_w_in[j], attn_q_norm[j], attn_k_norm[j])
            yp = dsa_prompt_attend(qp, qip, wip, pos_p, kp, vp, kip, topk_p) @ attn_w_o[j]
            qs, ks_, vs_, qis, kis, wis = dsa_project(hs, pos_s, attn_w_in[j], attn_q_norm[j], attn_k_norm[j])
            k_all = jnp.concatenate([cache_k[j].astype(ks_.dtype), ks_], axis=1)
            v_all = jnp.concatenate([cache_v[j].astype(vs_.dtype), vs_], axis=1)
            ki_all = jnp.concatenate([cache_kidx[j].astype(kis.dtype), kis], axis=1)
            ys = dsa_attend_block(qs, qis, wis, pos_s, k_all, v_all, ki_all, kpos_s, topk_s) @ attn_w_o[j]
            k_p.append(kp); v_p.append(vp); ki_p.append(kip)
            k_s.append(ks_); v_s.append(vs_); ki_s.append(kis)
        xp = xp + yp.astype(xp.dtype)
        xs = xs + ys.astype(xs.dtype)
        zero_conv = jnp.zeros((b_p, CONV_W - 1, D_FF), xp.dtype)
        fp, cp = conv_ffn(rms_norm(xp, norm_ffn[i]), zero_conv, ffn_w_up[i], ffn_conv_w[i], ffn_conv_b[i], ffn_w_down[i])
        fs, cs = conv_ffn(rms_norm(xs, norm_ffn[i]), cache_conv[i], ffn_w_up[i], ffn_conv_w[i], ffn_conv_b[i], ffn_w_down[i])
        xp = xp + fp.astype(xp.dtype)
        xs = xs + fs.astype(xs.dtype)
        conv_p.append(cp)
        conv_s.append(cs)

    new_ssm_re_p = jnp.stack(ssm_re_p)
    new_ssm_im_p = jnp.stack(ssm_im_p)
    new_ssm_re_s = jnp.stack(ssm_re_s)
    new_ssm_im_s = jnp.stack(ssm_im_s)
    new_k_p = jnp.stack(k_p)
    new_v_p = jnp.stack(v_p)
    new_ki_p = jnp.stack(ki_p)
    new_k_s = jnp.stack(k_s)
    new_v_s = jnp.stack(v_s)
    new_ki_s = jnp.stack(ki_s)
    new_conv_p = jnp.stack(conv_p)
    new_conv_s = jnp.stack(conv_s)
    return (xp, xs, new_ssm_re_p, new_ssm_im_p, new_ssm_re_s, new_ssm_im_s,
            new_k_p, new_v_p, new_ki_p, new_k_s, new_v_s, new_ki_s, new_conv_p, new_conv_s)
```

```cpp
#include <hip/hip_runtime.h>
#include <hip/hip_cooperative_groups.h>
#include <stdint.h>
#include <cstdio>
namespace cg = cooperative_groups;

typedef unsigned short u16;
typedef __attribute__((ext_vector_type(8))) __bf16 bf16x8;
typedef __attribute__((ext_vector_type(4))) short s16x4;
typedef __attribute__((ext_vector_type(16))) float f32x16;
typedef __attribute__((ext_vector_type(4))) float f32x4;

#define NTOK 16640
#define NPR 16384
#define LDSK 72
#define LDC 129
#define LDG 132
#define SC_LD 4128
#define SMEM_BYTES (73728)

#define O_SSM_RE_P 17039360
#define O_SSM_IM_P 17055744
#define O_SSM_RE_S 17072128
#define O_SSM_IM_S 17104896
#define O_K_P 17137664
#define O_V_P 21331968
#define O_KI_P 25526272
#define O_K_S 26574848
#define O_V_S 26640384
#define O_KI_S 26705920
#define O_CONV_P 26722304
#define O_CONV_S 26767360

constexpr size_t MB = 1ull << 20;
constexpr size_t W_GLU = 0;
constexpr size_t W_IN = W_GLU + 2048ull * 1024 * 2;
constexpr size_t W_O = W_IN + 2176ull * 1024 * 2;
constexpr size_t W_UP = W_O + 1024ull * 1024 * 2;
constexpr size_t W_DN = W_UP + 2ull * 5632 * 1024 * 2;
constexpr size_t R0 = W_DN + 2ull * 1024 * 2816 * 2;
constexpr size_t R_UG = R0;
constexpr size_t R_Z = R0 + 35 * MB;
constexpr size_t R_S = R0 + 70 * MB;
constexpr size_t R_HP = R0 + 88 * MB;
constexpr size_t R_W1 = R0 + 97 * MB;
constexpr size_t R_W3 = R0 + 106 * MB;
constexpr size_t R_KT = R0 + 115 * MB;
constexpr size_t R_AP = R0 + 117 * MB;
constexpr size_t R_BB = R0 + 119 * MB;
constexpr size_t R_HN = R0;
constexpr size_t R_GT = R0 + 35 * MB;
constexpr size_t R_OB = R0;
constexpr size_t R_QB = R0 + 35 * MB;
constexpr size_t R_KB = R0 + 70 * MB;
constexpr size_t R_VB = R0 + 96 * MB;
constexpr size_t R_QI = R0 + 122 * MB;
constexpr size_t R_KI = R0 + 140 * MB;
constexpr size_t R_WI = R0 + 147 * MB;
constexpr size_t R_SEL = R0 + 148 * MB;
constexpr size_t R_CNT = R0 + 157 * MB;
constexpr size_t R_BAR = R0 + 158 * MB;
constexpr size_t R_ZERO = R_BAR + 16384;
constexpr size_t WS_NEED = R0 + 159 * MB;

struct Params {
  const float *x_prompt, *x_sample, *st_re, *st_im, *cache_k, *cache_v, *cache_kidx, *cache_conv;
  const float *norm_mix, *norm_ffn, *lam_re, *lam_im, *log_dt, *b_re, *b_im, *c_re, *c_im, *ssm_d, *w_glu, *b_glu;
  const float *w_in, *q_norm, *k_norm, *w_o, *w_up, *conv_w, *conv_b, *w_down;
  float* out;
  char* ws;
  int use_cg;
  int pad0;
};

typedef __attribute__((ext_vector_type(2))) __bf16 bf16x2_t;
__device__ __forceinline__ u16 f2bf(float f) {
  __bf16 h = (__bf16)f;
  return __builtin_bit_cast(u16, h);
}
__device__ __forceinline__ float bf2f(u16 h) { return __uint_as_float(((unsigned)h) << 16); }
__device__ __forceinline__ unsigned pack2(float a, float b) {
  bf16x2_t v;
  v[0] = (__bf16)a;
  v[1] = (__bf16)b;
  return __builtin_bit_cast(unsigned, v);
}
__device__ __forceinline__ float gelu_tanh(float x) {
  const float k2 = -2.f * 0.7978845608028654f * 1.4426950408889634f;
  float x2 = x * x;
  float w = x * fmaf(x2, 0.044715f, 1.f);
  float e = __builtin_amdgcn_exp2f(w * k2);
  return x * __builtin_amdgcn_rcpf(1.f + e);
}
__device__ __forceinline__ float sigmoid_fast(float x) {
  return __builtin_amdgcn_rcpf(1.f + __builtin_amdgcn_exp2f(x * -1.4426950408889634f));
}
__device__ __forceinline__ uint4 zero4() { return make_uint4(0u, 0u, 0u, 0u); }
__device__ __forceinline__ uint4 ld16(const void* p) { return *reinterpret_cast<const uint4*>(p); }

template <class LA, class LB, class KM>
__device__ __forceinline__ void gemm_core(LA la, LB lb, KM kmap, int nkt, char* smem) {
  u16* sA = reinterpret_cast<u16*>(smem);
  u16* sB = sA + 128 * LDSK;
  const int tid = threadIdx.x, lane = tid & 63, wave = tid >> 6;
  const int wm = wave >> 1, wn = wave & 1;
  const int lr = tid >> 3, kc = (tid & 7) * 8;
  f32x16 acc[2][2];
#pragma unroll
  for (int i = 0; i < 2; ++i)
#pragma unroll
    for (int j = 0; j < 2; ++j)
#pragma unroll
      for (int r = 0; r < 16; ++r) acc[i][j][r] = 0.f;
  uint4 ra[4], rb[4];
  {
    int k0 = kmap(0);
#pragma unroll
    for (int i = 0; i < 4; ++i) {
      ra[i] = la(lr + 32 * i, k0 + kc);
      rb[i] = lb(lr + 32 * i, k0 + kc);
    }
  }
#pragma unroll 1
  for (int kt = 0; kt < nkt; ++kt) {
    __syncthreads();
#pragma unroll
    for (int i = 0; i < 4; ++i) {
      *reinterpret_cast<uint4*>(&sA[(lr + 32 * i) * LDSK + kc]) = ra[i];
      *reinterpret_cast<uint4*>(&sB[(lr + 32 * i) * LDSK + kc]) = rb[i];
    }
    __syncthreads();
    if (kt + 1 < nkt) {
      int k1 = kmap(kt + 1);
#pragma unroll
      for (int i = 0; i < 4; ++i) {
        ra[i] = la(lr + 32 * i, k1 + kc);
        rb[i] = lb(lr + 32 * i, k1 + kc);
      }
    }
#pragma unroll
    for (int kk = 0; kk < 4; ++kk) {
      bf16x8 af[2], bfr[2];
#pragma unroll
      for (int mi = 0; mi < 2; ++mi)
        af[mi] = *reinterpret_cast<const bf16x8*>(&sA[(wm * 64 + mi * 32 + (lane & 31)) * LDSK + kk * 16 + (lane >> 5) * 8]);
#pragma unroll
      for (int ni = 0; ni < 2; ++ni)
        bfr[ni] = *reinterpret_cast<const bf16x8*>(&sB[(wn * 64 + ni * 32 + (lane & 31)) * LDSK + kk * 16 + (lane >> 5) * 8]);
#pragma unroll
      for (int mi = 0; mi < 2; ++mi)
#pragma unroll
        for (int ni = 0; ni < 2; ++ni)
          acc[mi][ni] = __builtin_amdgcn_mfma_f32_32x32x16_bf16(af[mi], bfr[ni], acc[mi][ni], 0, 0, 0);
    }
  }
  __syncthreads();
  float* sC = reinterpret_cast<float*>(smem);
#pragma unroll
  for (int mi = 0; mi < 2; ++mi)
#pragma unroll
    for (int ni = 0; ni < 2; ++ni)
#pragma unroll
      for (int r = 0; r < 16; ++r) {
        int row = wm * 64 + mi * 32 + (r & 3) + 8 * (r >> 2) + 4 * (lane >> 5);
        int col = wn * 64 + ni * 32 + (lane & 31);
        sC[row * LDC + col] = acc[mi][ni][r];
      }
  __syncthreads();
}


struct TileSched {
  int i, end, step;
  __device__ __forceinline__ TileSched(int T) {
    int nx = gridDim.x >> 3;
    int x = blockIdx.x & 7, lb = blockIdx.x >> 3;
    int c0 = (int)((long long)T * x / 8);
    end = (int)((long long)T * (x + 1) / 8);
    i = c0 + lb;
    step = nx;
  }
};
__device__ __forceinline__ void tile_decode(int i, int MT, int NT, int& mt, int& nt) {
  int gsz = 8 * NT;
  int g8 = i / gsz;
  int rem = i - g8 * gsz;
  int mrows = min(8, MT - 8 * g8);
  nt = rem / mrows;
  mt = 8 * g8 + (rem - nt * mrows);
}

struct KOff {
  int base;
  __device__ __forceinline__ int operator()(int kt) const { return base + kt * 64; }
};
struct KIdent {
  __device__ __forceinline__ int operator()(int kt) const { return kt * 64; }
};

__device__ __forceinline__ void transpose_job(const float* __restrict__ src, u16* __restrict__ dst, int K, int N, int kt, int nt, char* smem) {
  float* tile = reinterpret_cast<float*>(smem);
  const int tid = threadIdx.x;
  __syncthreads();
  {
    int c4 = (tid & 15) * 4;
    int n = nt * 64 + c4;
#pragma unroll
    for (int i = 0; i < 4; ++i) {
      int kr = (tid >> 4) + 16 * i;
      float4 v = make_float4(0.f, 0.f, 0.f, 0.f);
      if (n < N) v = *reinterpret_cast<const float4*>(src + (size_t)(kt * 64 + kr) * N + n);
      tile[kr * 65 + c4 + 0] = v.x;
      tile[kr * 65 + c4 + 1] = v.y;
      tile[kr * 65 + c4 + 2] = v.z;
      tile[kr * 65 + c4 + 3] = v.w;
    }
  }
  __syncthreads();
  {
    int nr = tid >> 2, kch = (tid & 3) * 16;
    unsigned w[8];
#pragma unroll
    for (int i = 0; i < 8; ++i) w[i] = pack2(tile[(kch + 2 * i) * 65 + nr], tile[(kch + 2 * i + 1) * 65 + nr]);
    u16* d = dst + (size_t)(nt * 64 + nr) * K + kt * 64 + kch;
    *reinterpret_cast<uint4*>(d) = make_uint4(w[0], w[1], w[2], w[3]);
    *reinterpret_cast<uint4*>(d + 8) = make_uint4(w[4], w[5], w[6], w[7]);
  }
}

__device__ __forceinline__ const float* xrow_in(const Params& p, int row) {
  return row < NPR ? p.x_prompt + (size_t)row * 1024 : p.x_sample + (size_t)(row - NPR) * 1024;
}

__device__ __forceinline__ void norm_ug_job(const Params& p, int job) {
  const int lane = threadIdx.x & 63, wave = threadIdx.x >> 6;
  int row = job * 4 + wave;
  if (row >= NTOK) return;
  const float* x = xrow_in(p, row) + lane * 16;
  float v[16];
#pragma unroll
  for (int i = 0; i < 4; ++i) {
    float4 t = *reinterpret_cast<const float4*>(x + 4 * i);
    v[4 * i] = t.x; v[4 * i + 1] = t.y; v[4 * i + 2] = t.z; v[4 * i + 3] = t.w;
  }
  float ss = 0.f;
#pragma unroll
  for (int i = 0; i < 16; ++i) ss += v[i] * v[i];
#pragma unroll
  for (int d = 32; d >= 1; d >>= 1) ss += __shfl_xor(ss, d);
  float rs = rsqrtf(ss * (1.f / 1024.f) + 1e-6f);
  const float* g = p.norm_mix + lane * 16;
  unsigned w[8];
#pragma unroll
  for (int i = 0; i < 8; ++i) w[i] = pack2(v[2 * i] * rs * g[2 * i], v[2 * i + 1] * rs * g[2 * i + 1]);
  u16* ug = reinterpret_cast<u16*>(p.ws + R_UG) + ((size_t)lane * NTOK + row) * 16;
  *reinterpret_cast<uint4*>(ug) = make_uint4(w[0], w[1], w[2], w[3]);
  *reinterpret_cast<uint4*>(ug + 8) = make_uint4(w[4], w[5], w[6], w[7]);
}

__device__ __forceinline__ void norm_hn_job(const Params& p, const float* __restrict__ X, const float* __restrict__ gw, int job) {
  const int lane = threadIdx.x & 63, wave = threadIdx.x >> 6;
  const int row0 = job * 16 + wave * 4;
  float4 t[4][4];
#pragma unroll
  for (int rr = 0; rr < 4; ++rr) {
    const float* x = X + (size_t)(row0 + rr) * 1024;
#pragma unroll
    for (int i = 0; i < 4; ++i) t[rr][i] = *reinterpret_cast<const float4*>(x + 4 * lane + 256 * i);
  }
  float4 g[4];
#pragma unroll
  for (int i = 0; i < 4; ++i) g[i] = *reinterpret_cast<const float4*>(gw + 4 * lane + 256 * i);
#pragma unroll
  for (int rr = 0; rr < 4; ++rr) {
    float ss = 0.f;
#pragma unroll
    for (int i = 0; i < 4; ++i) ss += t[rr][i].x * t[rr][i].x + t[rr][i].y * t[rr][i].y + t[rr][i].z * t[rr][i].z + t[rr][i].w * t[rr][i].w;
#pragma unroll
    for (int d = 32; d >= 1; d >>= 1) ss += __shfl_xor(ss, d);
    float rs = rsqrtf(ss * (1.f / 1024.f) + 1e-6f);
    u16* hn = reinterpret_cast<u16*>(p.ws + R_HN) + (size_t)(row0 + rr) * 1024;
#pragma unroll
    for (int i = 0; i < 4; ++i) {
      uint2 o;
      o.x = pack2(t[rr][i].x * rs * g[i].x, t[rr][i].y * rs * g[i].y);
      o.y = pack2(t[rr][i].z * rs * g[i].z, t[rr][i].w * rs * g[i].w);
      *reinterpret_cast<uint2*>(hn + 4 * lane + 256 * i) = o;
    }
  }
}

__device__ __forceinline__ void s5_table_job(const Params& p, int job) {
  int t = job * 256 + threadIdx.x;
  int c = t & 15, pp = (t >> 4) & 63, g = t >> 10;
  float lre = fminf(p.lam_re[g * 64 + pp], -1e-4f);
  float lim = p.lam_im[g * 64 + pp];
  float dt = expf(p.log_dt[g]);
  float mag = expf(lre * dt);
  float sn, cs;
  sincosf(lim * dt, &sn, &cs);
  float are = mag * cs, aim = mag * sn;
  float den = lre * lre + lim * lim;
  float nre = are - 1.f;
  float fre = (nre * lre + aim * lim) / den;
  float fim = (aim * lre - nre * lim) / den;
  float br = p.b_re[(g * 64 + pp) * 16 + c], bi = p.b_im[(g * 64 + pp) * 16 + c];
  float bbr = fre * br - fim * bi;
  float bbi = fre * bi + fim * br;
  float* bb = reinterpret_cast<float*>(p.ws + R_BB) + ((size_t)(g * 64 + pp) * 16 + c) * 2;
  bb[0] = bbr; bb[1] = bbi;
  u16* W1 = reinterpret_cast<u16*>(p.ws + R_W1) + (size_t)g * 128 * 512;
  float pr = 1.f, pi = 0.f;
  for (int n = 0; n < 32; ++n) {
    int i = 31 - n;
    W1[(size_t)pp * 512 + i * 16 + c] = f2bf(pr * bbr - pi * bbi);
    W1[(size_t)(64 + pp) * 512 + i * 16 + c] = f2bf(pr * bbi + pi * bbr);
    float nr = pr * are - pi * aim, ni = pr * aim + pi * are;
    pr = nr; pi = ni;
  }
  if (c == 0) {
    float* ap = reinterpret_cast<float*>(p.ws + R_AP) + (size_t)(g * 64 + pp) * 66;
    float qr = 1.f, qi = 0.f;
    for (int n = 0; n <= 32; ++n) {
      ap[2 * n] = qr; ap[2 * n + 1] = qi;
      float nr = qr * are - qi * aim, ni = qr * aim + qi * are;
      qr = nr; qi = ni;
    }
  }
}

__device__ __forceinline__ void phase0(const Params& p, char* smem) {
  const int NJ_T = 5536, NJ_N = 4160, NJ_S = 256;
  for (int job = blockIdx.x; job < NJ_S + NJ_N + NJ_T; job += gridDim.x) {
    if (job < NJ_S) {
      s5_table_job(p, job);
    } else if (job < NJ_S + NJ_N) {
      norm_ug_job(p, job - NJ_S);
    } else {
      int j = job - NJ_S - NJ_N;
      const float* src; u16* dst; int K, N, ntn;
      if (j < 512) { src = p.w_glu; dst = (u16*)(p.ws + W_GLU); K = 1024; N = 2048; ntn = 32; }
      else if (j < 1056) { j -= 512; src = p.w_in; dst = (u16*)(p.ws + W_IN); K = 1024; N = 2120; ntn = 34; }
      else if (j < 1312) { j -= 1056; src = p.w_o; dst = (u16*)(p.ws + W_O); K = 1024; N = 1024; ntn = 16; }
      else if (j < 2720) { j -= 1312; src = p.w_up; dst = (u16*)(p.ws + W_UP); K = 1024; N = 5632; ntn = 88; }
      else if (j < 4128) { j -= 2720; src = p.w_up + (size_t)1024 * 5632; dst = (u16*)(p.ws + W_UP) + (size_t)5632 * 1024; K = 1024; N = 5632; ntn = 88; }
      else if (j < 4832) { j -= 4128; src = p.w_down; dst = (u16*)(p.ws + W_DN); K = 2816; N = 1024; ntn = 16; }
      else { j -= 4832; src = p.w_down + (size_t)2816 * 1024; dst = (u16*)(p.ws + W_DN) + (size_t)1024 * 2816; K = 2816; N = 1024; ntn = 16; }
      transpose_job(src, dst, K, N, j / ntn, j % ntn, smem);
    }
  }
}

__device__ __forceinline__ void phase1(const Params& p, char* smem) {
  const int NT_G = 320, NJ_K = 2048, NJ_W = 8192;
  const u16* UG = reinterpret_cast<const u16*>(p.ws + R_UG);
  const u16* W1 = reinterpret_cast<const u16*>(p.ws + R_W1);
  float* S = reinterpret_cast<float*>(p.ws + R_S);
  const float* AP = reinterpret_cast<const float*>(p.ws + R_AP);
  const float* BB = reinterpret_cast<const float*>(p.ws + R_BB);
  for (int job = blockIdx.x; job < NT_G; job += gridDim.x) {
    {
      int g = job / 5, mt = job % 5;
      const u16* ug = UG + (size_t)g * NTOK * 16;
      const u16* w1 = W1 + (size_t)g * 128 * 512;
      auto la = [=](int r, int k) -> uint4 {
        int col = mt * 128 + r;
        return col < 520 ? ld16(ug + (size_t)col * 512 + k) : zero4();
      };
      auto lb = [=](int n, int k) -> uint4 { return ld16(w1 + (size_t)n * 512 + k); };
      gemm_core(la, lb, KIdent(), 8, smem);
      const float* sC = reinterpret_cast<const float*>(smem);
      {
        const int cg = threadIdx.x & 31, r0 = threadIdx.x >> 5;
#pragma unroll
        for (int i = 0; i < 16; ++i) {
          int r = r0 + 8 * i;
          int col = mt * 128 + r;
          const float* c = sC + r * LDC + 4 * cg;
          if (col < 520) *reinterpret_cast<float4*>(&S[((size_t)col * 64 + g) * 128 + 4 * cg]) = make_float4(c[0], c[1], c[2], c[3]);
        }
      }
    }
  }
}


__device__ __forceinline__ void ktab_job(const Params& p, int j) {
  const float* AP = reinterpret_cast<const float*>(p.ws + R_AP);
  const float* BB = reinterpret_cast<const float*>(p.ws + R_BB);
  int t = j * 256 + threadIdx.x;
  int c = t & 15, cp = (t >> 4) & 15, tau = (t >> 8) & 31, g = t >> 13;
  float acc = 0.f;
#pragma unroll 16
  for (int pp = 0; pp < 64; ++pp) {
    float cr = p.c_re[(g * 16 + cp) * 64 + pp], ci = p.c_im[(g * 16 + cp) * 64 + pp];
    const float* bb = BB + ((size_t)(g * 64 + pp) * 16 + c) * 2;
    const float* ap = AP + (size_t)(g * 64 + pp) * 66 + 2 * tau;
    float br = bb[0], bi = bb[1];
    float ar = ap[0], ai = ap[1];
    float xr = br * ar - bi * ai, xi = br * ai + bi * ar;
    acc += cr * xr - ci * xi;
  }
  reinterpret_cast<u16*>(p.ws + R_KT)[t] = f2bf(acc);
}
__device__ __forceinline__ void w3_job(const Params& p, int j) {
  const float* AP = reinterpret_cast<const float*>(p.ws + R_AP);
  int t = j * 256 + threadIdx.x;
  int pp = t & 63, cp = (t >> 6) & 15, jj = (t >> 10) & 31, g = t >> 15;
  float cr = p.c_re[(g * 16 + cp) * 64 + pp], ci = p.c_im[(g * 16 + cp) * 64 + pp];
  const float* ap = AP + (size_t)(g * 64 + pp) * 66 + 2 * (jj + 1);
  float ar = ap[0], ai = ap[1];
  float vr = cr * ar - ci * ai, vi = cr * ai + ci * ar;
  u16* W3 = reinterpret_cast<u16*>(p.ws + R_W3) + ((size_t)g * 512 + jj * 16 + cp) * 128;
  W3[pp] = f2bf(vr);
  W3[64 + pp] = f2bf(-vi);
}

__device__ __forceinline__ void phase2_tables(const Params& p) {
  const int nb = (int)gridDim.x, b = (int)blockIdx.x;
  const int ns = nb > 256 ? 192 : 0;
  const int nlight = ns * 10;
  if (b < ns) {
    for (int j = b; j < nlight; j += ns) w3_job(p, j);
  } else {
    const int nr = nb - ns;
    for (int i = b - ns; i < (8192 - nlight) + 2048; i += nr) {
      if (i < 8192 - nlight) w3_job(p, nlight + i);
      else ktab_job(p, i - (8192 - nlight));
    }
  }
}

__device__ __forceinline__ void phase2(const Params& p) {
  const float* S = reinterpret_cast<const float*>(p.ws + R_S);
  u16* HP = reinterpret_cast<u16*>(p.ws + R_HP);
  const float* AP = reinterpret_cast<const float*>(p.ws + R_AP);
  for (int job = blockIdx.x; job < 192; job += gridDim.x) {
    int t = job * 256 + threadIdx.x;
    if (t < 16384) {
      int pp = t & 63, g = (t >> 6) & 63, b = t >> 12;
      float ar = AP[(size_t)(g * 64 + pp) * 66 + 64], ai = AP[(size_t)(g * 64 + pp) * 66 + 65];
      float hr = 0.f, hi = 0.f;
      for (int c0 = 0; c0 < 128; c0 += 16) {
        float sr[16], si[16];
#pragma unroll
        for (int u = 0; u < 16; ++u) {
          size_t o = ((size_t)(b * 128 + c0 + u) * 64 + g) * 128 + pp;
          sr[u] = S[o]; si[u] = S[o + 64];
        }
#pragma unroll
        for (int u = 0; u < 16; ++u) {
          size_t o = ((size_t)(b * 128 + c0 + u) * 64 + g) * 128 + pp;
          HP[o] = f2bf(hr);
          HP[o + 64] = f2bf(hi);
          float nr = ar * hr - ai * hi + sr[u];
          float ni = ar * hi + ai * hr + si[u];
          hr = nr; hi = ni;
        }
      }
      p.out[O_SSM_RE_P + (b * 64 + g) * 64 + pp] = hr;
      p.out[O_SSM_IM_P + (b * 64 + g) * 64 + pp] = hi;
    } else {
      int u = t - 16384;
      int pp = u & 63, g = (u >> 6) & 63, b = u >> 12;
      float ar = AP[(size_t)(g * 64 + pp) * 66 + 64], ai = AP[(size_t)(g * 64 + pp) * 66 + 65];
      float hr = p.st_re[(b * 64 + g) * 64 + pp], hi = p.st_im[(b * 64 + g) * 64 + pp];
      size_t o = ((size_t)(512 + b) * 64 + g) * 128 + pp;
      HP[o] = f2bf(hr);
      HP[o + 64] = f2bf(hi);
      float nr = ar * hr - ai * hi + S[o];
      float ni = ar * hi + ai * hr + S[o + 64];
      p.out[O_SSM_RE_S + (b * 64 + g) * 64 + pp] = nr;
      p.out[O_SSM_IM_S + (b * 64 + g) * 64 + pp] = ni;
    }
  }
}

struct KMapS3 {
  int nlow;
  __device__ __forceinline__ int operator()(int kt) const { return kt < nlow ? kt * 64 : 512 + (kt - nlow) * 64; }
};

__device__ __forceinline__ void phase3(const Params& p, char* smem) {
  const u16* UG = reinterpret_cast<const u16*>(p.ws + R_UG);
  const u16* HP = reinterpret_cast<const u16*>(p.ws + R_HP);
  const u16* KT = reinterpret_cast<const u16*>(p.ws + R_KT);
  const u16* W3 = reinterpret_cast<const u16*>(p.ws + R_W3);
  u16* Z = reinterpret_cast<u16*>(p.ws + R_Z);
  for (int job = blockIdx.x; job < 1280; job += gridDim.x) {
    int nt = 3 - (job & 3);
    int mt = (job >> 2) % 5, g = job / 20;
    const u16* ug = UG + (size_t)g * NTOK * 16;
    auto la = [=](int r, int k) -> uint4 {
      int col = mt * 128 + r;
      if (col >= 520) return zero4();
      if (k < 512) return ld16(ug + (size_t)col * 512 + k);
      return ld16(HP + ((size_t)col * 64 + g) * 128 + (k - 512));
    };
    auto lb = [=](int nl, int k) -> uint4 {
      int n = nt * 128 + nl;
      if (k < 512) {
        int j = n >> 4, cp = n & 15, i = k >> 4, c0 = k & 15;
        if (j < i) return zero4();
        return ld16(KT + ((size_t)(g * 32 + (j - i)) * 16 + cp) * 16 + c0);
      }
      return ld16(W3 + ((size_t)g * 512 + n) * 128 + (k - 512));
    };
    KMapS3 km; km.nlow = 2 * (nt + 1);
    gemm_core(la, lb, km, km.nlow + 2, smem);
    const float* sC = reinterpret_cast<const float*>(smem);
    {
      const int cg = threadIdx.x & 31, r0 = threadIdx.x >> 5;
      const int n = nt * 128 + 4 * cg;
      const int j = n >> 4, cp = n & 15;
      const float4 dv = *reinterpret_cast<const float4*>(p.ssm_d + g * 16 + cp);
      uint2 uv[16];
#pragma unroll
      for (int i = 0; i < 16; ++i) {
        int col = mt * 128 + r0 + 8 * i;
        uv[i] = make_uint2(0u, 0u);
        if (col < 520) uv[i] = *reinterpret_cast<const uint2*>(ug + (size_t)(col * 32 + j) * 16 + cp);
      }
#pragma unroll
      for (int i = 0; i < 16; ++i) {
        int r = r0 + 8 * i;
        int col = mt * 128 + r;
        if (col < 520) {
          const float* c = sC + r * LDC + 4 * cg;
          float y0 = c[0] + dv.x * __uint_as_float(uv[i].x << 16);
          float y1 = c[1] + dv.y * __uint_as_float(uv[i].x & 0xffff0000u);
          float y2 = c[2] + dv.z * __uint_as_float(uv[i].y << 16);
          float y3 = c[3] + dv.w * __uint_as_float(uv[i].y & 0xffff0000u);
          uint2 o;
          o.x = pack2(gelu_tanh(y0), gelu_tanh(y1));
          o.y = pack2(gelu_tanh(y2), gelu_tanh(y3));
          *reinterpret_cast<uint2*>(Z + (size_t)(col * 32 + j) * 1024 + g * 16 + cp) = o;
        }
      }
    }
  }
}


#define LDK2 40
#define STAGE2 (384 * LDK2)
template <bool HALO, class LA, class LB, class EPI>
__device__ __forceinline__ void gemm256(LA la, LB lb, EPI epi, int nk, char* smem) {
  u16* sbuf = reinterpret_cast<u16*>(smem);
  const int tid = threadIdx.x, lane = tid & 63, wave = tid >> 6;
  const int wm = wave >> 1, wn = wave & 1;
  const int lrow = tid >> 2, kc = (tid & 3) * 8;
  f32x16 acc[4][2];
#pragma unroll
  for (int i = 0; i < 4; ++i)
#pragma unroll
    for (int j = 0; j < 2; ++j)
#pragma unroll
      for (int r = 0; r < 16; ++r) acc[i][j][r] = 0.f;
  uint4 ra[4], rb[2];
#pragma unroll
  for (int i = 0; i < 4; ++i) ra[i] = la(lrow + 64 * i, kc);
#pragma unroll
  for (int i = 0; i < 2; ++i) rb[i] = lb(lrow + 64 * i, kc);
  __syncthreads();
#pragma unroll
  for (int i = 0; i < 4; ++i) *reinterpret_cast<uint4*>(&sbuf[(lrow + 64 * i) * LDK2 + kc]) = ra[i];
#pragma unroll
  for (int i = 0; i < 2; ++i) *reinterpret_cast<uint4*>(&sbuf[(256 + lrow + 64 * i) * LDK2 + kc]) = rb[i];
  if (nk > 1) {
#pragma unroll
    for (int i = 0; i < 4; ++i) ra[i] = la(lrow + 64 * i, 32 + kc);
#pragma unroll
    for (int i = 0; i < 2; ++i) rb[i] = lb(lrow + 64 * i, 32 + kc);
  }
#pragma unroll 1
  for (int kt = 0; kt < nk; ++kt) {
    __syncthreads();
    const u16* cA = sbuf + (kt & 1) * STAGE2;
    const u16* cB = cA + 256 * LDK2;
    u16* nA = sbuf + ((kt + 1) & 1) * STAGE2;
    {
      bf16x8 af[4], bfr[2];
#pragma unroll
      for (int mi = 0; mi < 4; ++mi)
        af[mi] = *reinterpret_cast<const bf16x8*>(&cA[(wm * 128 + mi * 32 + (lane & 31)) * LDK2 + (lane >> 5) * 8]);
#pragma unroll
      for (int ni = 0; ni < 2; ++ni)
        bfr[ni] = *reinterpret_cast<const bf16x8*>(&cB[(wn * 64 + ni * 32 + (lane & 31)) * LDK2 + (lane >> 5) * 8]);
#pragma unroll
      for (int mi = 0; mi < 4; ++mi)
#pragma unroll
        for (int ni = 0; ni < 2; ++ni)
          acc[mi][ni] = __builtin_amdgcn_mfma_f32_32x32x16_bf16(af[mi], bfr[ni], acc[mi][ni], 0, 0, 0);
    }
    if (kt + 1 < nk) {
#pragma unroll
      for (int i = 0; i < 4; ++i) *reinterpret_cast<uint4*>(&nA[(lrow + 64 * i) * LDK2 + kc]) = ra[i];
#pragma unroll
      for (int i = 0; i < 2; ++i) *reinterpret_cast<uint4*>(&nA[(256 + lrow + 64 * i) * LDK2 + kc]) = rb[i];
      if (kt + 2 < nk) {
        int k2 = (kt + 2) * 32 + kc;
#pragma unroll
        for (int i = 0; i < 4; ++i) ra[i] = la(lrow + 64 * i, k2);
#pragma unroll
        for (int i = 0; i < 2; ++i) rb[i] = lb(lrow + 64 * i, k2);
      }
    }
    {
      bf16x8 af[4], bfr[2];
#pragma unroll
      for (int mi = 0; mi < 4; ++mi)
        af[mi] = *reinterpret_cast<const bf16x8*>(&cA[(wm * 128 + mi * 32 + (lane & 31)) * LDK2 + 16 + (lane >> 5) * 8]);
#pragma unroll
      for (int ni = 0; ni < 2; ++ni)
        bfr[ni] = *reinterpret_cast<const bf16x8*>(&cB[(wn * 64 + ni * 32 + (lane & 31)) * LDK2 + 16 + (lane >> 5) * 8]);
#pragma unroll
      for (int mi = 0; mi < 4; ++mi)
#pragma unroll
        for (int ni = 0; ni < 2; ++ni)
          acc[mi][ni] = __builtin_amdgcn_mfma_f32_32x32x16_bf16(af[mi], bfr[ni], acc[mi][ni], 0, 0, 0);
    }
  }
  float* sC = reinterpret_cast<float*>(smem);
#pragma unroll
  for (int h = 0; h < 2; ++h) {
    __syncthreads();
#pragma unroll
    for (int m2 = 0; m2 < 2; ++m2)
#pragma unroll
      for (int ni = 0; ni < 2; ++ni)
#pragma unroll
        for (int r = 0; r < 16; ++r) {
          int j = m2 * 32 + (r & 3) + 8 * (r >> 2) + 4 * (lane >> 5);
          int col = wn * 64 + ni * 32 + (lane & 31);
          sC[(wm * 66 + 2 + j) * LDC + col] = acc[2 * h + m2][ni][r];
        }
    if (HALO) {
      if (h == 0) {
        if (wm == 0 && lane >= 32) {
#pragma unroll
          for (int ni = 0; ni < 2; ++ni) {
            int col = wn * 64 + ni * 32 + (lane & 31);
            sC[(66 + 0) * LDC + col] = acc[3][ni][14];
            sC[(66 + 1) * LDC + col] = acc[3][ni][15];
          }
        }
      } else {
        if (lane >= 32) {
#pragma unroll
          for (int ni = 0; ni < 2; ++ni) {
            int col = wn * 64 + ni * 32 + (lane & 31);
            sC[(wm * 66 + 0) * LDC + col] = acc[1][ni][14];
            sC[(wm * 66 + 1) * LDC + col] = acc[1][ni][15];
          }
        }
      }
    }
    __syncthreads();
    epi(h, sC);
  }
}


#define GSTAGE_B (384 * 64)
#define WAITV(n) asm volatile("s_waitcnt vmcnt(%0)" ::"n"(n) : "memory")
#define RAWBAR() do { asm volatile("s_waitcnt lgkmcnt(0)" ::: "memory"); __builtin_amdgcn_s_barrier(); } while (0)
template <bool HALO, class PA, class PB, class EPI>
__device__ __forceinline__ void gemm256g(const u16* baseA, const u16* baseB, PA pa, PB pb, EPI epi, int nk, char* smem) {
  const int tid = threadIdx.x, lane = tid & 63, wave = tid >> 6;
  const int wm = wave >> 1, wn = wave & 1;
  const int lrow = tid >> 2, cpos = tid & 3;
  f32x16 acc[4][2];
#pragma unroll
  for (int i = 0; i < 4; ++i)
#pragma unroll
    for (int j = 0; j < 2; ++j)
#pragma unroll
      for (int r = 0; r < 16; ++r) acc[i][j][r] = 0.f;
  const int koff = 8 * (cpos ^ ((lrow >> 2) & 3));
  unsigned offA[4], offB[2];
#pragma unroll
  for (int i = 0; i < 4; ++i) offA[i] = (pa(lrow + 64 * i) + koff) * 2u;
#pragma unroll
  for (int i = 0; i < 2; ++i) offB[i] = (pb(lrow + 64 * i) + koff) * 2u;
  auto issue = [&](int kt, int st) {
    char* base = smem + st * GSTAGE_B;
    const unsigned kb = kt * 64;
#pragma unroll
    for (int i = 0; i < 4; ++i)
      __builtin_amdgcn_global_load_lds((const unsigned*)(reinterpret_cast<const char*>(baseA) + (size_t)(offA[i] + kb)),
                                       (unsigned*)(base + (lrow + 64 * i) * 64 + cpos * 16), 16, 0, 0);
#pragma unroll
    for (int i = 0; i < 2; ++i)
      __builtin_amdgcn_global_load_lds((const unsigned*)(reinterpret_cast<const char*>(baseB) + (size_t)(offB[i] + kb)),
                                       (unsigned*)(base + (256 + lrow + 64 * i) * 64 + cpos * 16), 16, 0, 0);
  };
  WAITV(0);
  __syncthreads();
  issue(0, 0);
  if (nk > 1) issue(1, 1);
  if (nk > 2) issue(2, 2);
  if (nk > 2) WAITV(12); else if (nk > 1) WAITV(6); else WAITV(0);
  RAWBAR();
  const int sw = ((lane & 31) >> 2) & 3;
  const unsigned lds0 = (unsigned)(size_t)((__attribute__((address_space(3))) char*)smem);
  const unsigned ra_off = lds0 + (wm * 128 + (lane & 31)) * 64;
  const unsigned rb_off = lds0 + (256 + wn * 64 + (lane & 31)) * 64;
  const unsigned ph0 = (((lane >> 5)) ^ sw) * 16, ph1 = ((2 + (lane >> 5)) ^ sw) * 16;
#define GR6(F, aA, aB)                                                                                              \
  asm volatile("ds_read_b128 %0, %6\n\tds_read_b128 %4, %7\n\tds_read_b128 %1, %6 offset:2048\n\t"                 \
               "ds_read_b128 %5, %7 offset:2048\n\tds_read_b128 %2, %6 offset:4096\n\tds_read_b128 %3, %6 offset:6144" \
               : "=&v"(F[0]), "=&v"(F[1]), "=&v"(F[2]), "=&v"(F[3]), "=&v"(F[4]), "=&v"(F[5])                       \
               : "v"(aA), "v"(aB)                                                                                   \
               : "memory")
#define GW(n, F)                                                                                                    \
  asm volatile("s_waitcnt lgkmcnt(" #n ")"                                                                          \
               : "+v"(F[0]), "+v"(F[1]), "+v"(F[2]), "+v"(F[3]), "+v"(F[4]), "+v"(F[5])::"memory")
#define GMMA(F)                                                                                                     \
  _Pragma("unroll") for (int mi = 0; mi < 4; ++mi) _Pragma("unroll") for (int ni = 0; ni < 2; ++ni)                 \
      acc[mi][ni] = __builtin_amdgcn_mfma_f32_32x32x16_bf16(F[mi], F[4 + ni], acc[mi][ni], 0, 0, 0)
  bf16x8 F0[6], F1[6];
  {
    const unsigned aA = ra_off + ph0, aB = rb_off + ph0;
    GR6(F0, aA, aB);
  }
  int st = 0;
#pragma unroll 1
  for (int kt = 0; kt < nk; ++kt) {
    const unsigned sb = st * GSTAGE_B;
    {
      const unsigned aA = sb + ra_off + ph1, aB = sb + rb_off + ph1;
      GR6(F1, aA, aB);
    }
    GW(6, F0);
    __builtin_amdgcn_sched_barrier(0);
    GMMA(F0);
    __builtin_amdgcn_sched_barrier(0);
    GW(0, F1);
    if (kt + 1 < nk) { if (kt + 2 < nk) WAITV(6); else WAITV(0); }
    __builtin_amdgcn_s_barrier();
    __builtin_amdgcn_sched_barrier(0);
    int st1 = st + 1; if (st1 >= 3) st1 = 0;
    if (kt + 1 < nk) {
      const unsigned aA = st1 * GSTAGE_B + ra_off + ph0, aB = st1 * GSTAGE_B + rb_off + ph0;
      GR6(F0, aA, aB);
    }
    if (kt + 3 < nk) issue(kt + 3, st);
    __builtin_amdgcn_sched_barrier(0);
    GMMA(F1);
    __builtin_amdgcn_sched_barrier(0);
    st = st1;
  }
  asm volatile("s_waitcnt lgkmcnt(0)" ::: "memory");
  float* sC = reinterpret_cast<float*>(smem);
#pragma unroll
  for (int h = 0; h < 2; ++h) {
    __syncthreads();
#pragma unroll
    for (int m2 = 0; m2 < 2; ++m2)
#pragma unroll
      for (int ni = 0; ni < 2; ++ni)
#pragma unroll
        for (int r = 0; r < 16; ++r) {
          int j = m2 * 32 + (r & 3) + 8 * (r >> 2) + 4 * (lane >> 5);
          int col = wn * 64 + ni * 32 + (lane & 31);
          sC[(wm * 66 + 2 + j) * LDG + col] = acc[2 * h + m2][ni][r];
        }
    if (HALO) {
      if (h == 0) {
        if (wm == 0 && lane >= 32) {
#pragma unroll
          for (int ni = 0; ni < 2; ++ni) {
            int col = wn * 64 + ni * 32 + (lane & 31);
            sC[(66 + 0) * LDG + col] = acc[3][ni][14];
            sC[(66 + 1) * LDG + col] = acc[3][ni][15];
          }
        }
      } else {
        if (lane >= 32) {
#pragma unroll
          for (int ni = 0; ni < 2; ++ni) {
            int col = wn * 64 + ni * 32 + (lane & 31);
            sC[(wm * 66 + 0) * LDG + col] = acc[1][ni][14];
            sC[(wm * 66 + 1) * LDG + col] = acc[1][ni][15];
          }
        }
      }
    }
    __syncthreads();
    epi(h, sC);
  }
}

__device__ __forceinline__ float4 ld4f(const float* p, bool vec) {
  if (vec) return *reinterpret_cast<const float4*>(p);
  return make_float4(p[0], p[1], p[2], p[3]);
}
template <bool SPLIT>
__device__ __forceinline__ int epi_srow(int v) { return SPLIT ? (v >> 6) * 66 + 2 + (v & 63) : v; }
template <bool SPLIT>
__device__ __forceinline__ int epi_grow(int v, int row0, int h) { return SPLIT ? row0 + 128 * (v >> 6) + 64 * h + (v & 63) : row0 + v; }

template <bool SPLIT>
__device__ __forceinline__ void glu_epi(const Params& p, const float* sC, int row0, int h, int n0) {
  float* X = p.out;
  const int cg = threadIdx.x & 15, r0 = threadIdx.x >> 4;
  const float4 b1 = *reinterpret_cast<const float4*>(p.b_glu + n0 + 4 * cg);
  const float4 b2 = *reinterpret_cast<const float4*>(p.b_glu + 1024 + n0 + 4 * cg);
#pragma unroll
  for (int hh = 0; hh < 2; ++hh) {
    float4 xv[4];
#pragma unroll
    for (int i = 0; i < 4; ++i) xv[i] = *reinterpret_cast<const float4*>(xrow_in(p, epi_grow<SPLIT>(r0 + 16 * (hh * 4 + i), row0, h)) + n0 + 4 * cg);
#pragma unroll
    for (int i = 0; i < 4; ++i) {
      int v = r0 + 16 * (hh * 4 + i);
      const float* c = sC + epi_srow<SPLIT>(v) * (SPLIT ? LDG : LDC) + 4 * cg;
      const float4 g1 = ld4f(c, SPLIT), g2 = ld4f(c + 64, SPLIT);
      float4 o;
      o.x = xv[i].x + (g1.x + b1.x) * sigmoid_fast(g2.x + b2.x);
      o.y = xv[i].y + (g1.y + b1.y) * sigmoid_fast(g2.y + b2.y);
      o.z = xv[i].z + (g1.z + b1.z) * sigmoid_fast(g2.z + b2.z);
      o.w = xv[i].w + (g1.w + b1.w) * sigmoid_fast(g2.w + b2.w);
      *reinterpret_cast<float4*>(X + (size_t)epi_grow<SPLIT>(v, row0, h) * 1024 + n0 + 4 * cg) = o;
    }
  }
}
template <bool SPLIT>
__device__ __forceinline__ void resid_epi(const Params& p, const float* sC, int row0, int h, int col0) {
  const int cg = threadIdx.x & 31, r0 = threadIdx.x >> 5;
  float* xb = p.out + col0 + 4 * cg;
#pragma unroll
  for (int half = 0; half < 2; ++half) {
    float4 xv[8];
#pragma unroll
    for (int i = 0; i < 8; ++i) xv[i] = *reinterpret_cast<const float4*>(xb + (size_t)epi_grow<SPLIT>(r0 + 8 * (half * 8 + i), row0, h) * 1024);
#pragma unroll
    for (int i = 0; i < 8; ++i) {
      int v = r0 + 8 * (half * 8 + i);
      const float4 cv = ld4f(sC + epi_srow<SPLIT>(v) * (SPLIT ? LDG : LDC) + 4 * cg, SPLIT);
      float4 o = make_float4(xv[i].x + cv.x, xv[i].y + cv.y, xv[i].z + cv.z, xv[i].w + cv.w);
      *reinterpret_cast<float4*>(xb + (size_t)epi_grow<SPLIT>(v, row0, h) * 1024) = o;
    }
  }
}

__device__ __forceinline__ void phase4(const Params& p, char* smem) {
  const u16* Z = reinterpret_cast<const u16*>(p.ws + R_Z);
  const u16* W = reinterpret_cast<const u16*>(p.ws + W_GLU);
  for (TileSched ts(64 * 16); ts.i < ts.end; ts.i += ts.step) {
    int mt, nt;
    tile_decode(ts.i, 64, 16, mt, nt);
    int n0 = nt * 64;
    auto la = [=](int r) -> unsigned { return (unsigned)(mt * 256 + r) * 1024u; };
    auto lb = [=](int nl) -> unsigned {
      int nrow = nl < 64 ? n0 + nl : 1024 + n0 + nl - 64;
      return (unsigned)nrow * 1024u;
    };
    auto epi = [&](int h, const float* sC) { glu_epi<true>(p, sC, mt * 256, h, n0); };
    gemm256g<false>(Z, W, la, lb, epi, 32, smem);
  }
  for (int job = blockIdx.x; job < 32; job += gridDim.x) {
    int mt = 128 + (job >> 4), nt = job & 15;
    int n0 = nt * 64;
    auto la = [=](int r, int k) -> uint4 { return ld16(Z + (size_t)(mt * 128 + r) * 1024 + k); };
    auto lb = [=](int nl, int k) -> uint4 {
      int nrow = nl < 64 ? n0 + nl : 1024 + n0 + nl - 64;
      return ld16(W + (size_t)nrow * 1024 + k);
    };
    gemm_core(la, lb, KIdent(), 16, smem);
    glu_epi<false>(p, reinterpret_cast<const float*>(smem), mt * 128, 0, n0);
  }
}


__device__ __forceinline__ size_t ki_off(int row, int kc) { return ((size_t)((row >> 5) * 8 + kc) * 32 + (row & 31)) * 8; }

__device__ __forceinline__ void phase_norm(const Params& p, const float* gw, bool conv_caches) {
  int nj = 1040 + (conv_caches ? (4096 + 4096 + 1024) : 0);
  if (blockIdx.x == 0 && threadIdx.x < 128) *reinterpret_cast<uint4*>(reinterpret_cast<u16*>(p.ws + R_HN) + (size_t)NTOK * 1024 + threadIdx.x * 8) = zero4();
  for (int job = blockIdx.x; job < nj; job += gridDim.x) {
    if (job < 1040) {
      norm_hn_job(p, p.out, gw, job);
    } else {
      int j = job - 1040;
      if (j < 8192) {
        const float* src = j < 4096 ? p.cache_k : p.cache_v;
        u16* dst = reinterpret_cast<u16*>(p.ws + (j < 4096 ? R_KB : R_VB));
        int jj = j & 4095;
        size_t e = ((size_t)jj * 256 + threadIdx.x) * 8;
        int b = (int)(e >> 20);
        size_t within = e & ((1u << 20) - 1);
        float4 a = *reinterpret_cast<const float4*>(src + e);
        float4 c = *reinterpret_cast<const float4*>(src + e + 4);
        uint4 o = make_uint4(pack2(a.x, a.y), pack2(a.z, a.w), pack2(c.x, c.y), pack2(c.z, c.w));
        *reinterpret_cast<uint4*>(dst + ((size_t)NPR + (size_t)b * 4128) * 256 + within) = o;
      } else {
        int jj = j - 8192;
        size_t e = ((size_t)jj * 256 + threadIdx.x) * 8;
        int b = (int)(e >> 18);
        size_t within = e & ((1u << 18) - 1);
        float4 a = *reinterpret_cast<const float4*>(p.cache_kidx + e);
        float4 c = *reinterpret_cast<const float4*>(p.cache_kidx + e + 4);
        uint4 o = make_uint4(pack2(a.x, a.y), pack2(a.z, a.w), pack2(c.x, c.y), pack2(c.z, c.w));
        {
          int row = NPR + b * 4128 + (int)(within >> 6), kc = (int)((within & 63) >> 3);
          *reinterpret_cast<uint4*>(reinterpret_cast<u16*>(p.ws + R_KI) + ki_off(row, kc)) = o;
        }
      }
    }
  }
}

__device__ __forceinline__ void phase_up(const Params& p, int layer, char* smem) {
  const u16* HN = reinterpret_cast<const u16*>(p.ws + R_HN);
  const u16* W = reinterpret_cast<const u16*>(p.ws + W_UP) + (size_t)layer * 5632 * 1024;
  u16* GT = reinterpret_cast<u16*>(p.ws + R_GT);
  const float* cw = p.conv_w + (size_t)layer * 3 * 2816;
  const float* cb = p.conv_b + (size_t)layer * 2816;
  for (TileSched ts(69 * 44); ts.i < ts.end; ts.i += ts.step) {
    int mt, nt;
    tile_decode(ts.i, 69, 44, mt, nt);
    const int n0 = nt * 64;
    const bool prompt = mt < 68;
    const int s = mt / 17, it = mt - s * 17;
    const int tbase = 254 * it - 2;
    const int rbase = prompt ? s * 4096 : NPR;
    auto la = [=](int r) -> unsigned {
      if (prompt) {
        int tp = tbase + r;
        if (tp < 0 || tp >= 4096) return (unsigned)NTOK * 1024u;
        return (unsigned)(rbase + tp) * 1024u;
      }
      return (unsigned)(rbase + r) * 1024u;
    };
    auto lb = [=](int nl) -> unsigned {
      int nrow = nl < 64 ? n0 + nl : 2816 + n0 + nl - 64;
      return (unsigned)nrow * 1024u;
    };
    auto epi = [&](int h, const float* sC) {
      const int cg = threadIdx.x & 15, r0 = threadIdx.x >> 4;
      const int col = n0 + 4 * cg;
      const float4 w0 = *reinterpret_cast<const float4*>(cw + col);
      const float4 w1 = *reinterpret_cast<const float4*>(cw + 2816 + col);
      const float4 w2 = *reinterpret_cast<const float4*>(cw + 2 * 2816 + col);
      const float4 bb = *reinterpret_cast<const float4*>(cb + col);
#pragma unroll 1
      for (int i = 0; i < 8; ++i) {
        const int v = r0 + 16 * i;
        const int r = 128 * (v >> 6) + 64 * h + (v & 63);
        const int sr = (v >> 6) * 66 + 2 + (v & 63);
        const float* c = sC + sr * LDG + 4 * cg;
        float4 a0 = *reinterpret_cast<const float4*>(c);
        float4 bv = *reinterpret_cast<const float4*>(c + 64);
        float4 a1 = *reinterpret_cast<const float4*>(c - LDG);
        float4 a2 = *reinterpret_cast<const float4*>(c - 2 * LDG);
        size_t orow;
        bool doit;
        if (prompt) {
          int tp = tbase + r;
          doit = (r >= 2 && tp < 4096);
          orow = (size_t)(rbase + tp);
          if (doit && tp >= 4094)
            *reinterpret_cast<float4*>(p.out + O_CONV_P + ((size_t)(layer * 4 + s) * 2 + (tp - 4094)) * 2816 + col) = a0;
        } else {
          doit = true;
          int b = r >> 5, t = r & 31;
          const float* cc = p.cache_conv + ((size_t)(layer * 8 + b) * 2) * 2816 + col;
          if (t < 1) a1 = *reinterpret_cast<const float4*>(cc + 2816);
          if (t < 2) a2 = *reinterpret_cast<const float4*>(cc + (size_t)t * 2816);
          orow = (size_t)(rbase + r);
          if (t >= 30) *reinterpret_cast<float4*>(p.out + O_CONV_S + ((size_t)(layer * 8 + b) * 2 + (t - 30)) * 2816 + col) = a0;
        }
        if (doit) {
          float c0 = bb.x + w0.x * a2.x + w1.x * a1.x + w2.x * a0.x;
          float c1v = bb.y + w0.y * a2.y + w1.y * a1.y + w2.y * a0.y;
          float c2v = bb.z + w0.z * a2.z + w1.z * a1.z + w2.z * a0.z;
          float c3v = bb.w + w0.w * a2.w + w1.w * a1.w + w2.w * a0.w;
          uint2 o;
          o.x = pack2(gelu_tanh(c0) * bv.x, gelu_tanh(c1v) * bv.y);
          o.y = pack2(gelu_tanh(c2v) * bv.z, gelu_tanh(c3v) * bv.w);
          *reinterpret_cast<uint2*>(GT + orow * 2816 + col) = o;
        }
      }
    };
    gemm256g<true>(HN, W, la, lb, epi, 32, smem);
  }
}

__device__ __forceinline__ void phase_resid_gemm(const Params& p, const u16* A, const u16* W, int K, char* smem) {
  {
    const int nsplit = K / 256;
    for (int job = blockIdx.x; job < 16 * nsplit; job += gridDim.x) {
      int sp = job / 16, tl = job % 16;
      int mt = 128 + (tl >> 3), nt = tl & 7;
      auto la = [=](int r, int k) -> uint4 { return ld16(A + (size_t)(mt * 128 + r) * K + k); };
      auto lb = [=](int nl, int k) -> uint4 { return ld16(W + (size_t)(nt * 128 + nl) * K + k); };
      KOff ko; ko.base = sp * 256;
      gemm_core(la, lb, ko, 4, smem);
      const float* sC = reinterpret_cast<const float*>(smem);
      float* xb = p.out + (size_t)(mt * 128) * 1024 + nt * 128;
      for (int idx = threadIdx.x; idx < 128 * 128; idx += 256) {
        int r = idx >> 7, n = idx & 127;
        unsafeAtomicAdd(xb + (size_t)r * 1024 + n, sC[r * LDC + n]);
      }
    }
  }
  for (TileSched ts(64 * 8); ts.i < ts.end; ts.i += ts.step) {
    int mt, nt;
    tile_decode(ts.i, 64, 8, mt, nt);
    auto la = [=](int r) -> unsigned { return (unsigned)(mt * 256 + r) * (unsigned)K; };
    auto lb = [=](int nl) -> unsigned { return (unsigned)(nt * 128 + nl) * (unsigned)K; };
    auto epi = [&](int h, const float* sC) { resid_epi<true>(p, sC, mt * 256, h, nt * 128); };
    gemm256g<false>(A, W, la, lb, epi, K / 32, smem);
  }
}

__device__ __forceinline__ void rope16(float* v, int pos) {
  const float inv[8] = {1.000000000e+00f, 1.939227432e-01f, 3.760603070e-02f, 7.292664610e-03f,
                        1.414213562e-03f, 2.742481884e-04f, 5.318296098e-05f, 1.031338616e-05f};
  float fp = (float)pos;
#pragma unroll
  for (int i = 0; i < 8; ++i) {
    float ang = fp * inv[i];
    float sn, cs;
    sincosf(ang, &sn, &cs);
    float x1 = v[i], x2 = v[8 + i];
    v[i] = x1 * cs - x2 * sn;
    v[8 + i] = x2 * cs + x1 * sn;
  }
}

__device__ __forceinline__ void store64_bf16(u16* dst, const float* v) {
#pragma unroll
  for (int i = 0; i < 8; ++i) {
    uint4 o = make_uint4(pack2(v[8 * i], v[8 * i + 1]), pack2(v[8 * i + 2], v[8 * i + 3]),
                         pack2(v[8 * i + 4], v[8 * i + 5]), pack2(v[8 * i + 6], v[8 * i + 7]));
    *reinterpret_cast<uint4*>(dst + 8 * i) = o;
  }
}
__device__ __forceinline__ void store64_f32(float* dst, const float* v) {
#pragma unroll
  for (int i = 0; i < 16; ++i) *reinterpret_cast<float4*>(dst + 4 * i) = make_float4(v[4 * i], v[4 * i + 1], v[4 * i + 2], v[4 * i + 3]);
}

__device__ __forceinline__ void phase_win(const Params& p, char* smem) {
  const u16* HN = reinterpret_cast<const u16*>(p.ws + R_HN);
  const u16* W = reinterpret_cast<const u16*>(p.ws + W_IN);
  u16* QB = reinterpret_cast<u16*>(p.ws + R_QB);
  u16* KB = reinterpret_cast<u16*>(p.ws + R_KB);
  u16* VB = reinterpret_cast<u16*>(p.ws + R_VB);
  u16* QI = reinterpret_cast<u16*>(p.ws + R_QI);
  u16* KI = reinterpret_cast<u16*>(p.ws + R_KI);
  float* WI = reinterpret_cast<float*>(p.ws + R_WI);
  for (TileSched ts(130 * 17); ts.i < ts.end; ts.i += ts.step) {
    int mt, nt;
    tile_decode(ts.i, 130, 17, mt, nt);
    auto la = [=](int r, int k) -> uint4 { return ld16(HN + (size_t)(mt * 128 + r) * 1024 + k); };
    auto lb = [=](int nl, int k) -> uint4 { return ld16(W + (size_t)(nt * 128 + nl) * 1024 + k); };
    gemm_core(la, lb, KIdent(), 16, smem);
    const float* sC = reinterpret_cast<const float*>(smem);
    int r = threadIdx.x & 127, h = threadIdx.x >> 7;
    int cbase = nt * 128 + 64 * h;
    int row = mt * 128 + r;
    int pos, kvrow;
    if (row < NPR) { pos = row & 4095; kvrow = row; }
    else { int bs = (row - NPR) >> 5, t = (row - NPR) & 31; pos = 4096 + t; kvrow = NPR + bs * 4128 + 4096 + t; }
    if (cbase < 2112) {
      float v[64];
#pragma unroll
      for (int d = 0; d < 64; ++d) v[d] = sC[r * LDC + 64 * h + d];
      if (cbase < 1280) {
        float ss = 0.f;
#pragma unroll
        for (int d = 0; d < 64; ++d) ss += v[d] * v[d];
        float rs = rsqrtf(ss * (1.f / 64.f) + 1e-6f);
        const float* gw = cbase < 1024 ? p.q_norm : p.k_norm;
#pragma unroll
        for (int d = 0; d < 64; ++d) v[d] = v[d] * rs * gw[d];
      }
      if (cbase < 1280 || cbase >= 1536) rope16(v, pos);
      if (cbase < 1024) {
        store64_bf16(QB + (size_t)row * 1024 + cbase, v);
      } else if (cbase < 1280) {
        store64_bf16(KB + (size_t)kvrow * 256 + (cbase - 1024), v);
        float* o = row < NPR ? p.out + O_K_P + (size_t)row * 256 : p.out + O_K_S + (size_t)(row - NPR) * 256;
        store64_f32(o + (cbase - 1024), v);
      } else if (cbase < 1536) {
        store64_bf16(VB + (size_t)kvrow * 256 + (cbase - 1280), v);
        float* o = row < NPR ? p.out + O_V_P + (size_t)row * 256 : p.out + O_V_S + (size_t)(row - NPR) * 256;
        store64_f32(o + (cbase - 1280), v);
      } else if (cbase < 2048) {
        store64_bf16(QI + (size_t)row * 512 + (cbase - 1536), v);
      } else {
#pragma unroll
        for (int kc = 0; kc < 8; ++kc) {
          uint4 o = make_uint4(pack2(v[8 * kc], v[8 * kc + 1]), pack2(v[8 * kc + 2], v[8 * kc + 3]),
                               pack2(v[8 * kc + 4], v[8 * kc + 5]), pack2(v[8 * kc + 6], v[8 * kc + 7]));
          *reinterpret_cast<uint4*>(KI + ki_off(kvrow, kc)) = o;
        }
        float* o = row < NPR ? p.out + O_KI_P + (size_t)row * 64 : p.out + O_KI_S + (size_t)(row - NPR) * 64;
        store64_f32(o, v);
      }
    } else if (cbase == 2112) {
      float w[8];
#pragma unroll
      for (int d = 0; d < 8; ++d) w[d] = sC[r * LDC + 64 * h + d];
      *reinterpret_cast<float4*>(WI + (size_t)row * 8) = make_float4(w[0], w[1], w[2], w[3]);
      *reinterpret_cast<float4*>(WI + (size_t)row * 8 + 4) = make_float4(w[4], w[5], w[6], w[7]);
    }
  }
}

__device__ __forceinline__ unsigned f2key(float f) {
  unsigned u = __float_as_uint(f);
  return (u & 0x80000000u) ? ~u : (u | 0x80000000u);
}

__device__ __forceinline__ void phase_index(const Params& p, char* smem) {
  const u16* QI = reinterpret_cast<const u16*>(p.ws + R_QI);
  const u16* KI = reinterpret_cast<const u16*>(p.ws + R_KI);
  const float* WI = reinterpret_cast<const float*>(p.ws + R_WI);
  u16* SEL = reinterpret_cast<u16*>(p.ws + R_SEL);
  int* CNT = reinterpret_cast<int*>(p.ws + R_CNT);
  float* sc = reinterpret_cast<float*>(smem);
  unsigned* histall = reinterpret_cast<unsigned*>(smem + 66048);
  const int tid = threadIdx.x, lane = tid & 63, wave = tid >> 6;
  for (int item = blockIdx.x; item < 64 + 4096; item += gridDim.x) {
    int tok0, nk, seqbase;
    if (item < 64) {
      tok0 = NPR + item * 4;
      nk = 4128;
      seqbase = NPR + (item >> 3) * 4128;
    } else {
      int it = item - 64;
      int c = 63 - (it >> 6);
      int b = (it & 63) >> 4, q4 = it & 15;
      tok0 = b * 4096 + c * 64 + q4 * 4;
      nk = 64 * (c + 1);
      seqbase = b * 4096;
    }
    __syncthreads();
    if (nk > 256) {
      bf16x8 af[4];
      {
        int q = (lane & 31) >> 3, h = lane & 7;
        const u16* src = QI + (size_t)(tok0 + q) * 512 + h * 64 + 8 * (lane >> 5);
#pragma unroll
        for (int kk = 0; kk < 4; ++kk) {
          uint4 t = ld16(src + kk * 16);
          af[kk] = *reinterpret_cast<bf16x8*>(&t);
        }
      }
      float wsc[16];
#pragma unroll
      for (int q = 0; q < 4; ++q) {
        float4 t = *reinterpret_cast<const float4*>(WI + (size_t)(tok0 + q) * 8 + 4 * (lane >> 5));
        const float s = 0.125f * 0.35355339059327373f;
        wsc[4 * q] = t.x * s; wsc[4 * q + 1] = t.y * s; wsc[4 * q + 2] = t.z * s; wsc[4 * q + 3] = t.w * s;
      }
      int ntile = nk >> 5;
      const u16* kbase = KI + (size_t)seqbase * 64;
      for (int t0 = wave; t0 < ntile; t0 += 32) {
        uint4 kb[8][4];
#pragma unroll
        for (int j = 0; j < 8; ++j) {
          int tile = t0 + 4 * j;
          if (tile < ntile) {
            const u16* kr = kbase + ((size_t)(tile * 8 + (lane >> 5)) * 32 + (lane & 31)) * 8;
#pragma unroll
            for (int kk = 0; kk < 4; ++kk) kb[j][kk] = ld16(kr + kk * 2 * 256);
          }
        }
        __builtin_amdgcn_sched_barrier(0);
#pragma unroll
        for (int j = 0; j < 8; ++j) {
          int tile = t0 + 4 * j;
          if (tile < ntile) {
            f32x16 acc;
#pragma unroll
            for (int r = 0; r < 16; ++r) acc[r] = 0.f;
#pragma unroll
            for (int kk = 0; kk < 4; ++kk)
              acc = __builtin_amdgcn_mfma_f32_32x32x16_bf16(af[kk], *reinterpret_cast<bf16x8*>(&kb[j][kk]), acc, 0, 0, 0);
            float sq[4];
#pragma unroll
            for (int q = 0; q < 4; ++q) {
              float sv = 0.f;
#pragma unroll
              for (int rr = 0; rr < 4; ++rr) sv += fmaxf(acc[4 * q + rr], 0.f) * wsc[4 * q + rr];
              sv += __shfl_xor(sv, 32);
              sq[q] = sv;
            }
            if (lane < 32) {
#pragma unroll
              for (int q = 0; q < 4; ++q) sc[q * SC_LD + tile * 32 + lane] = sq[q];
            }
          }
        }
      }
    }
    __syncthreads();
    {
      int token = tok0 + wave;
      u16* sel = SEL + (size_t)token * 256;
      if (nk <= 256) {
        for (int i = lane; i < 256; i += 64) sel[i] = (u16)(i < nk ? i : 0);
        if (lane == 0) CNT[token] = nk;
      } else {
        const float* s = sc + wave * SC_LD;
        unsigned* hist = histall + wave * 256;
        unsigned prefix = 0, mask = 0;
        unsigned need = 256;
        for (int shift = 24; shift >= 0; shift -= 8) {
          for (int i = lane; i < 256; i += 64) hist[i] = 0;
          __builtin_amdgcn_s_waitcnt(0xc07f);
          for (int e0 = lane * 4; e0 < nk; e0 += 256) {
            float4 v4 = *reinterpret_cast<const float4*>(s + e0);
            unsigned u0 = f2key(v4.x), u1 = f2key(v4.y), u2 = f2key(v4.z), u3 = f2key(v4.w);
            if ((u0 & mask) == prefix) atomicAdd(&hist[(u0 >> shift) & 255u], 1u);
            if ((u1 & mask) == prefix) atomicAdd(&hist[(u1 >> shift) & 255u], 1u);
            if ((u2 & mask) == prefix) atomicAdd(&hist[(u2 >> shift) & 255u], 1u);
            if ((u3 & mask) == prefix) atomicAdd(&hist[(u3 >> shift) & 255u], 1u);
          }
          __builtin_amdgcn_s_waitcnt(0xc07f);
          __builtin_amdgcn_wave_barrier();
          unsigned h0 = hist[4 * lane], h1 = hist[4 * lane + 1], h2 = hist[4 * lane + 2], h3 = hist[4 * lane + 3];
          unsigned loc = h0 + h1 + h2 + h3;
          unsigned suf = loc;
#pragma unroll
          for (int d = 1; d < 64; d <<= 1) {
            unsigned t = __shfl_down(suf, d);
            if (lane + d < 64) suf += t;
          }
          unsigned above = suf - loc;
          bool cross = (above < need) && (need <= above + loc);
          unsigned long long bal = __ballot(cross);
          int src = __ffsll((long long)bal) - 1;
          unsigned binsel = 0, newneed = 0;
          if (cross) {
            unsigned cum = above;
            if (cum + h3 >= need) { binsel = 4 * lane + 3; newneed = need - cum; }
            else {
              cum += h3;
              if (cum + h2 >= need) { binsel = 4 * lane + 2; newneed = need - cum; }
              else {
                cum += h2;
                if (cum + h1 >= need) { binsel = 4 * lane + 1; newneed = need - cum; }
                else { cum += h1; binsel = 4 * lane; newneed = need - cum; }
              }
            }
          }
          binsel = __shfl(binsel, src);
          newneed = __shfl(newneed, src);
          prefix |= binsel << shift;
          mask |= 255u << shift;
          need = newneed;
          __builtin_amdgcn_wave_barrier();
        }
        const unsigned T = prefix;
        const unsigned long long lt = (1ull << lane) - 1ull;
        int base = 0, eqtaken = 0;
        for (int i0 = 0; i0 < nk; i0 += 256) {
          int e0 = i0 + lane * 4;
          bool in = e0 < nk;
          float4 v4 = in ? *reinterpret_cast<const float4*>(s + e0) : make_float4(0.f, 0.f, 0.f, 0.f);
          unsigned u[4] = {f2key(v4.x), f2key(v4.y), f2key(v4.z), f2key(v4.w)};
          bool eq[4], gt[4];
          int eqbefore = 0;
#pragma unroll
          for (int j = 0; j < 4; ++j) {
            gt[j] = in && (u[j] > T);
            eq[j] = in && (u[j] == T);
          }
          unsigned long long be[4];
          int eqtot = 0;
#pragma unroll
          for (int j = 0; j < 4; ++j) {
            be[j] = __ballot(eq[j]);
            eqbefore += __popcll(be[j] & lt);
            eqtot += __popcll(be[j]);
          }
          bool take[4];
          int mine_eq = 0;
#pragma unroll
          for (int j = 0; j < 4; ++j) {
            int eqrank = eqtaken + eqbefore + mine_eq;
            take[j] = gt[j] || (eq[j] && eqrank < (int)need);
            mine_eq += eq[j] ? 1 : 0;
          }
          int tkbefore = 0, tktot = 0;
#pragma unroll
          for (int j = 0; j < 4; ++j) {
            unsigned long long bt = __ballot(take[j]);
            tkbefore += __popcll(bt & lt);
            tktot += __popcll(bt);
          }
          int pos = base + tkbefore;
#pragma unroll
          for (int j = 0; j < 4; ++j) {
            if (take[j]) {
              if (pos < 256) sel[pos] = (u16)(e0 + j);
              ++pos;
            }
          }
          base += tktot;
          eqtaken += eqtot;
        }
        if (lane == 0) CNT[token] = 256;
      }
    }
  }
}

__device__ __forceinline__ void load_v_round(const u16* __restrict__ VB, const int* sidx, int rd, int kvh, int lane, uint4 (&vv)[8]) {
#pragma unroll
  for (int i = 0; i < 8; ++i) {
    int pid = lane + 64 * i;
    int rowl = pid >> 3, piece = pid & 7;
    int row = sidx[64 * rd + rowl];
    unsigned off = (unsigned)row * 512u + (unsigned)(kvh * 128 + piece * 16);
    vv[i] = ld16(reinterpret_cast<const char*>(VB) + off);
  }
}

template <int RD>
__device__ __forceinline__ void pv_round(const u16* __restrict__ VB, const int* sidx, int kvh, int lane, u16* Vs,
                                         uint4 (&vv)[8], f32x4 (&sacc)[16], float inv, f32x4 (&oacc)[4]) {
  const int g = lane >> 4, n = lane & 15;
  uint4 vn[8];
  if (RD < 3) load_v_round(VB, sidx, RD + 1, kvh, lane, vn);
  __builtin_amdgcn_sched_barrier(0);
  __builtin_amdgcn_wave_barrier();
#pragma unroll
  for (int i = 0; i < 8; ++i) {
    int pid = lane + 64 * i;
    int rowl = pid >> 3, piece = pid & 7;
    *reinterpret_cast<uint4*>(&Vs[rowl * LDSK + piece * 8]) = vv[i];
  }
  __builtin_amdgcn_s_waitcnt(0xc07f);
  __builtin_amdgcn_wave_barrier();
#pragma unroll
  for (int ch = 0; ch < 2; ++ch) {
    constexpr int tb = 4 * RD;
    const int t0 = tb + 2 * ch;
    uint4 pa;
    pa.x = pack2(sacc[t0][0] * inv, sacc[t0][1] * inv);
    pa.y = pack2(sacc[t0][2] * inv, sacc[t0][3] * inv);
    pa.z = pack2(sacc[t0 + 1][0] * inv, sacc[t0 + 1][1] * inv);
    pa.w = pack2(sacc[t0 + 1][2] * inv, sacc[t0 + 1][3] * inv);
    bf16x8 afrag = *reinterpret_cast<bf16x8*>(&pa);
    int qq = n >> 2, pp = n & 3;
    int lr0 = 32 * ch + 4 * g + qq;
#pragma unroll
    for (int nt = 0; nt < 4; ++nt) {
      typedef __attribute__((address_space(3))) s16x4* lds_s4p;
      s16x4 r0 = __builtin_amdgcn_ds_read_tr16_b64_v4i16((lds_s4p)(&Vs[lr0 * LDSK + 16 * nt + 4 * pp]));
      s16x4 r1 = __builtin_amdgcn_ds_read_tr16_b64_v4i16((lds_s4p)(&Vs[(lr0 + 16) * LDSK + 16 * nt + 4 * pp]));
      uint4 bw;
      bw.x = (unsigned)(u16)r0[0] | ((unsigned)(u16)r0[1] << 16);
      bw.y = (unsigned)(u16)r0[2] | ((unsigned)(u16)r0[3] << 16);
      bw.z = (unsigned)(u16)r1[0] | ((unsigned)(u16)r1[1] << 16);
      bw.w = (unsigned)(u16)r1[2] | ((unsigned)(u16)r1[3] << 16);
      oacc[nt] = __builtin_amdgcn_mfma_f32_16x16x32_bf16(afrag, *reinterpret_cast<bf16x8*>(&bw), oacc[nt], 0, 0, 0);
    }
  }
  __builtin_amdgcn_wave_barrier();
  __builtin_amdgcn_sched_barrier(0);
  if (RD < 3) {
#pragma unroll
    for (int i = 0; i < 8; ++i) vv[i] = vn[i];
  }
}

__device__ __forceinline__ void phase_attn(const Params& p, char* smem) {
  const u16* QB = reinterpret_cast<const u16*>(p.ws + R_QB);
  const u16* KB = reinterpret_cast<const u16*>(p.ws + R_KB);
  const u16* VB = reinterpret_cast<const u16*>(p.ws + R_VB);
  const u16* SEL = reinterpret_cast<const u16*>(p.ws + R_SEL);
  const int* CNT = reinterpret_cast<const int*>(p.ws + R_CNT);
  u16* OB = reinterpret_cast<u16*>(p.ws + R_OB);
  const int tid = threadIdx.x, lane = tid & 63, wave = tid >> 6;
  const int g = lane >> 4, n = lane & 15;
  u16* Vs = reinterpret_cast<u16*>(smem) + wave * (64 * LDSK);
  int* sidx2 = reinterpret_cast<int*>(smem + 4 * 64 * LDSK * 2);
  const int kvh = wave;
  auto seqbase_of = [](int token) -> int {
    return token < NPR ? (token >> 12) * 4096 : NPR + ((token - NPR) >> 5) * 4128;
  };
  const int xq = blockIdx.x & 7, lbq = blockIdx.x >> 3, nlq = gridDim.x >> 3;
  auto token_of = [=](int it) -> int {
    return it < 32 ? NPR + xq * 32 + it : (xq >> 1) * 4096 + 2 * (it - 32) + (xq & 1);
  };
  int cur = 0, cnt_cur = 0;
  __syncthreads();
  if (lbq < 2080) {
    int t0 = token_of(lbq);
    cnt_cur = CNT[t0];
    sidx2[tid] = seqbase_of(t0) + (int)SEL[(size_t)t0 * 256 + tid];
  }
  __syncthreads();
  for (int it = lbq; it < 2080; it += nlq) {
    const int token = token_of(it);
    const int* sidx = sidx2 + cur * 256;
    const int cnt = cnt_cur;
    const int itn = it + nlq;
    const int tnext = itn < 2080 ? token_of(itn) : -1;
    int nsel = 0, ncnt = 0;
    if (tnext >= 0) {
      nsel = (int)SEL[(size_t)tnext * 256 + tid];
      ncnt = CNT[tnext];
    }
    bf16x8 qf[2];
    {
      uint4 t0 = zero4(), t1 = zero4();
      if (n < 4) {
        const u16* q = QB + (size_t)token * 1024 + (kvh * 4 + n) * 64 + 8 * g;
        t0 = ld16(q);
        t1 = ld16(q + 32);
      }
      qf[0] = *reinterpret_cast<bf16x8*>(&t0);
      qf[1] = *reinterpret_cast<bf16x8*>(&t1);
    }
    f32x4 sacc[16];
#pragma unroll
    for (int hb = 0; hb < 2; ++hb) {
      uint4 ka[8][2];
#pragma unroll
      for (int t = 0; t < 8; ++t) {
        int row = sidx[16 * (hb * 8 + t) + n];
        unsigned off = (unsigned)row * 512u + (unsigned)(kvh * 128 + 16 * g);
        ka[t][0] = ld16(reinterpret_cast<const char*>(KB) + off);
        ka[t][1] = ld16(reinterpret_cast<const char*>(KB) + off + 64u);
      }
      __builtin_amdgcn_sched_barrier(0);
#pragma unroll
      for (int t = 0; t < 8; ++t) {
        f32x4 acc = {0.f, 0.f, 0.f, 0.f};
        acc = __builtin_amdgcn_mfma_f32_16x16x32_bf16(*reinterpret_cast<bf16x8*>(&ka[t][0]), qf[0], acc, 0, 0, 0);
        acc = __builtin_amdgcn_mfma_f32_16x16x32_bf16(*reinterpret_cast<bf16x8*>(&ka[t][1]), qf[1], acc, 0, 0, 0);
        sacc[hb * 8 + t] = acc;
      }
      __builtin_amdgcn_sched_barrier(0);
    }
    uint4 vv[8];
    load_v_round(VB, sidx, 0, kvh, lane, vv);
    __builtin_amdgcn_sched_barrier(0);
    float m = -3.0e38f;
    if (cnt < 256) {
#pragma unroll
      for (int t = 0; t < 16; ++t)
#pragma unroll
        for (int r = 0; r < 4; ++r) {
          int slot = 16 * t + 4 * g + r;
          if (slot >= cnt) sacc[t][r] = -3.0e38f;
        }
    }
#pragma unroll
    for (int t = 0; t < 16; ++t)
#pragma unroll
      for (int r = 0; r < 4; ++r) m = fmaxf(m, sacc[t][r]);
    m = fmaxf(m, __shfl_xor(m, 16));
    m = fmaxf(m, __shfl_xor(m, 32));
    const float cexp = 0.125f * 1.4426950408889634f;
    const float mc = -m * cexp;
    float sum = 0.f;
#pragma unroll
    for (int t = 0; t < 16; ++t)
#pragma unroll
      for (int r = 0; r < 4; ++r) {
        float e = __builtin_amdgcn_exp2f(fmaf(sacc[t][r], cexp, mc));
        sacc[t][r] = e;
        sum += e;
      }
    sum += __shfl_xor(sum, 16);
    sum += __shfl_xor(sum, 32);
    const float inv = 1.f / sum;
    f32x4 oacc[4];
#pragma unroll
    for (int nt = 0; nt < 4; ++nt) oacc[nt] = (f32x4){0.f, 0.f, 0.f, 0.f};
    pv_round<0>(VB, sidx, kvh, lane, Vs, vv, sacc, 1.f, oacc);
    pv_round<1>(VB, sidx, kvh, lane, Vs, vv, sacc, 1.f, oacc);
    pv_round<2>(VB, sidx, kvh, lane, Vs, vv, sacc, 1.f, oacc);
    pv_round<3>(VB, sidx, kvh, lane, Vs, vv, sacc, 1.f, oacc);
    {
      float i0 = __shfl(inv, 0), i1 = __shfl(inv, 1), i2 = __shfl(inv, 2), i3 = __shfl(inv, 3);
#pragma unroll
      for (int nt = 0; nt < 4; ++nt) {
        oacc[nt][0] *= i0; oacc[nt][1] *= i1; oacc[nt][2] *= i2; oacc[nt][3] *= i3;
      }
    }
    if (lane < 16) {
#pragma unroll
      for (int nt = 0; nt < 4; ++nt)
#pragma unroll
        for (int r = 0; r < 4; ++r)
          OB[(size_t)token * 1024 + (kvh * 4 + r) * 64 + 16 * nt + lane] = f2bf(oacc[nt][r]);
    }
    if (tnext >= 0) sidx2[(cur ^ 1) * 256 + tid] = seqbase_of(tnext) + nsel;
    cnt_cur = ncnt;
    cur ^= 1;
    __syncthreads();
  }
}


#define XB_TMO      128
#define XB_XCNT(j)  (256  + 64 * (j))
#define XB_XSUB(j)  (1280 + 64 * (j))
#define XB_XGEN(j)  (2304 + 64 * (j))
#define XB_TOP      3328
#define XB_TOPGEN   3392
#define XCD_BAR_WORDS 3456
#define XB_SPIN_CAP (1u << 18)
#define LAS __attribute__((address_space(3)))

__device__ __forceinline__ unsigned xb_ld(unsigned* p) { return __hip_atomic_load(p, __ATOMIC_RELAXED, __HIP_MEMORY_SCOPE_AGENT); }
__device__ __forceinline__ unsigned xb_add(unsigned* p, unsigned v) { return __hip_atomic_fetch_add(p, v, __ATOMIC_RELAXED, __HIP_MEMORY_SCOPE_AGENT); }
__device__ __forceinline__ unsigned xb_xcc_id() { return (unsigned)__builtin_amdgcn_s_getreg((3 << 11) | 20) & 0xFu; }
#define XB_SPIN(cond, bar) do { unsigned _sp = 0; while (cond) { __builtin_amdgcn_s_sleep(1); \
    if ((++_sp & 255u) == 0u) { if (xb_ld(&(bar)[XB_TMO])) break; if (_sp > XB_SPIN_CAP) { atomicAdd(&(bar)[XB_TMO], 1u); break; } } } } while (0)

struct XcdBarrier {
  unsigned* bar; unsigned x;
  volatile LAS unsigned* st;
};
__device__ __forceinline__ XcdBarrier xcd_barrier_post(unsigned* bar, volatile LAS unsigned* st) {
  XcdBarrier b; b.bar = bar; b.x = xb_xcc_id(); b.st = st;
  if (threadIdx.x == 0) (void)xb_add(&bar[XB_XCNT(b.x)], 1u);
  return b;
}
__device__ __forceinline__ void xcd_barrier_complete(unsigned* bar, unsigned x, unsigned& nloc, unsigned& nx) {
  const unsigned G = gridDim.x * gridDim.y * gridDim.z;
  unsigned sum, cnt, mine, sp = 0u;
  for (;;) {
    sum = 0u; cnt = 0u; mine = 0u;
#pragma unroll
    for (unsigned j = 0; j < 16; ++j) { const unsigned c = xb_ld(&bar[XB_XCNT(j)]); sum += c; cnt += (c > 0u) ? 1u : 0u; mine = (j == x) ? c : mine; }
    if (sum == G) break;
    __builtin_amdgcn_s_sleep(1);
    if ((++sp & 255u) == 0u) { if (xb_ld(&bar[XB_TMO])) break; if (sp > XB_SPIN_CAP) { atomicAdd(&bar[XB_TMO], 1u); break; } }
  }
  nloc = mine > 0u ? mine : 1u; nx = cnt > 0u ? cnt : 1u;
}
__device__ __forceinline__ void xcd_barrier(const XcdBarrier& b) {
  asm volatile("s_waitcnt vmcnt(0)" ::: "memory");
  __syncthreads();
  if (threadIdx.x == 0) {
    unsigned* bar = b.bar;
    __builtin_amdgcn_s_waitcnt(0);
    unsigned nloc = b.st[0], nx = b.st[1];
    if (nloc == 0u) { xcd_barrier_complete(bar, b.x, nloc, nx); b.st[0] = nloc; b.st[1] = nx; }
    const unsigned old = xb_add(&bar[XB_XSUB(b.x)], 1u);
    const unsigned gen = old / nloc;
    if (old + 1u == (gen + 1u) * nloc) {
      __builtin_amdgcn_fence(__ATOMIC_RELEASE, "agent");
      asm volatile("s_waitcnt vmcnt(0)" ::: "memory");
      const unsigned og = xb_add(&bar[XB_TOP], 1u);
      const unsigned tg = og / nx;
      if (og + 1u == (tg + 1u) * nx) xb_add(&bar[XB_TOPGEN], 1u);
      else XB_SPIN(xb_ld(&bar[XB_TOPGEN]) == tg, bar);
      __builtin_amdgcn_fence(__ATOMIC_ACQUIRE, "agent");
      xb_add(&bar[XB_XGEN(b.x)], 1u);
      asm volatile("s_waitcnt vmcnt(0)" ::: "memory");
    } else {
      XB_SPIN(xb_ld(&bar[XB_XGEN(b.x)]) == gen, bar);
      __builtin_amdgcn_fence(__ATOMIC_ACQUIRE, "agent");
      asm volatile("s_waitcnt vmcnt(0)" ::: "memory");
    }
  }
  __syncthreads();
}

__global__ void __launch_bounds__(256, 2) mega(Params p) {
  __shared__ __attribute__((aligned(16))) char smem[SMEM_BYTES];
  __shared__ uint4 xb_words;
  if (threadIdx.x == 0) xb_words = make_uint4(0u, 0u, 0u, 0u);
  __syncthreads();
  XcdBarrier xb = xcd_barrier_post(reinterpret_cast<unsigned*>(p.ws + R_BAR), (volatile LAS unsigned*)&xb_words);
  if (p.use_cg) cg::this_grid().sync();
  phase0(p, smem);
  xcd_barrier(xb);
  phase1(p, smem);
  xcd_barrier(xb);
  phase2(p);
  phase2_tables(p);
  xcd_barrier(xb);
  phase3(p, smem);
  xcd_barrier(xb);
  phase4(p, smem);
  xcd_barrier(xb);
  phase_norm(p, p.norm_ffn, false);
  xcd_barrier(xb);
  phase_up(p, 0, smem);
  xcd_barrier(xb);
  phase_resid_gemm(p, (const u16*)(p.ws + R_GT), (const u16*)(p.ws + W_DN), 2816, smem);
  xcd_barrier(xb);
  phase_norm(p, p.norm_mix + 1024, true);
  xcd_barrier(xb);
  phase_win(p, smem);
  xcd_barrier(xb);
  phase_index(p, smem);
  xcd_barrier(xb);
  phase_attn(p, smem);
  xcd_barrier(xb);
  phase_resid_gemm(p, (const u16*)(p.ws + R_OB), (const u16*)(p.ws + W_O), 1024, smem);
  xcd_barrier(xb);
  phase_norm(p, p.norm_ffn + 1024, false);
  xcd_barrier(xb);
  phase_up(p, 1, smem);
  xcd_barrier(xb);
  phase_resid_gemm(p, (const u16*)(p.ws + R_GT), (const u16*)(p.ws + W_DN) + (size_t)1024 * 2816, 2816, smem);
}

extern "C" void kernel_launch(void* const* d_in, const int* in_sizes, int n_in, void* d_out, int out_size, void* d_ws,
                              size_t ws_size, hipStream_t stream) {
  static int grid_blocks = 0;
  if (!grid_blocks) {
    int dev = 0, cus = 0, per_cu = 0;
    hipGetDevice(&dev);
    hipDeviceGetAttribute(&cus, hipDeviceAttributeMultiprocessorCount, dev);
    hipOccupancyMaxActiveBlocksPerMultiprocessor(&per_cu, mega, 256, 0);
    if (per_cu > 2) per_cu = 2;
    if (per_cu < 1) per_cu = 1;
    grid_blocks = cus * per_cu;
  }
  Params p{};
  const float** pf = reinterpret_cast<const float**>(&p);
  for (int i = 0; i < 28; ++i) pf[i] = reinterpret_cast<const float*>(d_in[i]);
  p.out = reinterpret_cast<float*>(d_out);
  p.ws = reinterpret_cast<char*>(d_ws);
  if (ws_size < WS_NEED) fprintf(stderr, "workspace too small: %zu < %zu\n", ws_size, (size_t)WS_NEED);
  p.use_cg = 0;
  p.pad0 = 0;
  hipMemsetAsync(reinterpret_cast<char*>(d_ws) + R_BAR, 0, 16384 + 4096, stream);
  void* args[] = {&p};
  hipError_t e = hipLaunchCooperativeKernel((void*)mega, dim3(grid_blocks), dim3(256), args, 0, stream);
  if (e != hipSuccess) fprintf(stderr, "cooperative launch failed: %s (grid %d)\n", hipGetErrorString(e), grid_blocks);
}
```

```cpp
#include <hip/hip_runtime.h>
#include <hip/hip_cooperative_groups.h>
#include <stdint.h>
#include <cstdio>
namespace cg = cooperative_groups;

typedef unsigned short u16;
typedef __attribute__((ext_vector_type(8))) __bf16 bf16x8;
typedef __attribute__((ext_vector_type(4))) short s16x4;
typedef __attribute__((ext_vector_type(16))) float f32x16;
typedef __attribute__((ext_vector_type(4))) float f32x4;

#define NTOK 16640
#define NPR 16384
#define LDSK 72
#define LDC 129
#define LDG 132
#define SC_LD 4128
#define SMEM_BYTES (73728)

#define O_SSM_RE_P 17039360
#define O_SSM_IM_P 17055744
#define O_SSM_RE_S 17072128
#define O_SSM_IM_S 17104896
#define O_K_P 17137664
#define O_V_P 21331968
#define O_KI_P 25526272
#define O_K_S 26574848
#define O_V_S 26640384
#define O_KI_S 26705920
#define O_CONV_P 26722304
#define O_CONV_S 26767360

constexpr size_t MB = 1ull << 20;
constexpr size_t W_GLU = 0;
constexpr size_t W_IN = W_GLU + 2048ull * 1024 * 2;
constexpr size_t W_O = W_IN + 2176ull * 1024 * 2;
constexpr size_t W_UP = W_O + 1024ull * 1024 * 2;
constexpr size_t W_DN = W_UP + 2ull * 5632 * 1024 * 2;
constexpr size_t R0 = W_DN + 2ull * 1024 * 2816 * 2;
constexpr size_t R_UG = R0;
constexpr size_t R_Z = R0 + 35 * MB;
constexpr size_t R_S = R0 + 70 * MB;
constexpr size_t R_HP = R0 + 88 * MB;
constexpr size_t R_W1 = R0 + 97 * MB;
constexpr size_t R_W3 = R0 + 106 * MB;
constexpr size_t R_KT = R0 + 115 * MB;
constexpr size_t R_AP = R0 + 117 * MB;
constexpr size_t R_BB = R0 + 119 * MB;
constexpr size_t R_HN = R0;
constexpr size_t R_GT = R0 + 35 * MB;
constexpr size_t R_OB = R0;
constexpr size_t R_QB = R0 + 35 * MB;
constexpr size_t R_KB = R0 + 70 * MB;
constexpr size_t R_VB = R0 + 96 * MB;
constexpr size_t R_QI = R0 + 122 * MB;
constexpr size_t R_KI = R0 + 140 * MB;
constexpr size_t R_WI = R0 + 147 * MB;
constexpr size_t R_SEL = R0 + 148 * MB;
constexpr size_t R_CNT = R0 + 157 * MB;
constexpr size_t R_BAR = R0 + 158 * MB;
constexpr size_t R_ZERO = R_BAR + 16384;
constexpr size_t WS_NEED = R0 + 159 * MB;

struct Params {
  const float *x_prompt, *x_sample, *st_re, *st_im, *cache_k, *cache_v, *cache_kidx, *cache_conv;
  const float *norm_mix, *norm_ffn, *lam_re, *lam_im, *log_dt, *b_re, *b_im, *c_re, *c_im, *ssm_d, *w_glu, *b_glu;
  const float *w_in, *q_norm, *k_norm, *w_o, *w_up, *conv_w, *conv_b, *w_down;
  float* out;
  char* ws;
  int use_cg;
  int pad0;
};

typedef __attribute__((ext_vector_type(2))) __bf16 bf16x2_t;
__device__ __forceinline__ u16 f2bf(float f) {
  __bf16 h = (__bf16)f;
  return __builtin_bit_cast(u16, h);
}
__device__ __forceinline__ float bf2f(u16 h) { return __uint_as_float(((unsigned)h) << 16); }
__device__ __forceinline__ unsigned pack2(float a, float b) {
  bf16x2_t v;
  v[0] = (__bf16)a;
  v[1] = (__bf16)b;
  return __builtin_bit_cast(unsigned, v);
}
__device__ __forceinline__ float gelu_tanh(float x) {
  const float k2 = -2.f * 0.7978845608028654f * 1.4426950408889634f;
  float x2 = x * x;
  float w = x * fmaf(x2, 0.044715f, 1.f);
  float e = __builtin_amdgcn_exp2f(w * k2);
  return x * __builtin_amdgcn_rcpf(1.f + e);
}
__device__ __forceinline__ float sigmoid_fast(float x) {
  return __builtin_amdgcn_rcpf(1.f + __builtin_amdgcn_exp2f(x * -1.4426950408889634f));
}

__device__ __forceinline__ float xsum32(float v) {
  auto r = __builtin_amdgcn_permlane32_swap(__float_as_uint(v), __float_as_uint(v), false, false);
  return __uint_as_float(r[0]) + __uint_as_float(r[1]);
}
__device__ __forceinline__ float xmax32(float v) {
  auto r = __builtin_amdgcn_permlane32_swap(__float_as_uint(v), __float_as_uint(v), false, false);
  return fmaxf(__uint_as_float(r[0]), __uint_as_float(r[1]));
}
__device__ __forceinline__ uint4 zero4() { return make_uint4(0u, 0u, 0u, 0u); }
__device__ __forceinline__ uint4 ld16(const void* p) { return *reinterpret_cast<const uint4*>(p); }

template <class LA, class LB, class KM>
__device__ __forceinline__ void gemm_core(LA la, LB lb, KM kmap, int nkt, char* smem) {
  u16* sA = reinterpret_cast<u16*>(smem);
  u16* sB = sA + 128 * LDSK;
  const int tid = threadIdx.x, lane = tid & 63, wave = tid >> 6;
  const int wm = wave >> 1, wn = wave & 1;
  const int lr = tid >> 3, kc = (tid & 7) * 8;
  f32x16 acc[2][2];
#pragma unroll
  for (int i = 0; i < 2; ++i)
#pragma unroll
    for (int j = 0; j < 2; ++j)
#pragma unroll
      for (int r = 0; r < 16; ++r) acc[i][j][r] = 0.f;
  uint4 ra[4], rb[4];
  {
    int k0 = kmap(0);
#pragma unroll
    for (int i = 0; i < 4; ++i) {
      ra[i] = la(lr + 32 * i, k0 + kc);
      rb[i] = lb(lr + 32 * i, k0 + kc);
    }
  }
#pragma unroll 1
  for (int kt = 0; kt < nkt; ++kt) {
    __syncthreads();
#pragma unroll
    for (int i = 0; i < 4; ++i) {
      *reinterpret_cast<uint4*>(&sA[(lr + 32 * i) * LDSK + kc]) = ra[i];
      *reinterpret_cast<uint4*>(&sB[(lr + 32 * i) * LDSK + kc]) = rb[i];
    }
    __syncthreads();
    if (kt + 1 < nkt) {
      int k1 = kmap(kt + 1);
#pragma unroll
      for (int i = 0; i < 4; ++i) {
        ra[i] = la(lr + 32 * i, k1 + kc);
        rb[i] = lb(lr + 32 * i, k1 + kc);
      }
    }
#pragma unroll
    for (int kk = 0; kk < 4; ++kk) {
      bf16x8 af[2], bfr[2];
#pragma unroll
      for (int mi = 0; mi < 2; ++mi)
        af[mi] = *reinterpret_cast<const bf16x8*>(&sA[(wm * 64 + mi * 32 + (lane & 31)) * LDSK + kk * 16 + (lane >> 5) * 8]);
#pragma unroll
      for (int ni = 0; ni < 2; ++ni)
        bfr[ni] = *reinterpret_cast<const bf16x8*>(&sB[(wn * 64 + ni * 32 + (lane & 31)) * LDSK + kk * 16 + (lane >> 5) * 8]);
#pragma unroll
      for (int mi = 0; mi < 2; ++mi)
#pragma unroll
        for (int ni = 0; ni < 2; ++ni)
          acc[mi][ni] = __builtin_amdgcn_mfma_f32_32x32x16_bf16(af[mi], bfr[ni], acc[mi][ni], 0, 0, 0);
    }
  }
  __syncthreads();
  float* sC = reinterpret_cast<float*>(smem);
#pragma unroll
  for (int mi = 0; mi < 2; ++mi)
#pragma unroll
    for (int ni = 0; ni < 2; ++ni)
#pragma unroll
      for (int r = 0; r < 16; ++r) {
        int row = wm * 64 + mi * 32 + (r & 3) + 8 * (r >> 2) + 4 * (lane >> 5);
        int col = wn * 64 + ni * 32 + (lane & 31);
        sC[row * LDC + col] = acc[mi][ni][r];
      }
  __syncthreads();
}


struct TileSched {
  int i, end, step;
  __device__ __forceinline__ TileSched(int T) {
    int nx = gridDim.x >> 3;
    int x = blockIdx.x & 7, lb = blockIdx.x >> 3;
    int c0 = (int)((long long)T * x / 8);
    end = (int)((long long)T * (x + 1) / 8);
    i = c0 + lb;
    step = nx;
  }
};
__device__ __forceinline__ void tile_decode(int i, int MT, int NT, int& mt, int& nt) {
  int gsz = 8 * NT;
  int g8 = i / gsz;
  int rem = i - g8 * gsz;
  int mrows = min(8, MT - 8 * g8);
  nt = rem / mrows;
  mt = 8 * g8 + (rem - nt * mrows);
}

struct KOff {
  int base;
  __device__ __forceinline__ int operator()(int kt) const { return base + kt * 64; }
};
struct KIdent {
  __device__ __forceinline__ int operator()(int kt) const { return kt * 64; }
};

__device__ __forceinline__ void transpose_job(const float* __restrict__ src, u16* __restrict__ dst, int K, int N, int kt, int nt, char* smem) {
  float* tile = reinterpret_cast<float*>(smem);
  const int tid = threadIdx.x;
  __syncthreads();
  {
    int c4 = (tid & 15) * 4;
    int n = nt * 64 + c4;
#pragma unroll
    for (int i = 0; i < 4; ++i) {
      int kr = (tid >> 4) + 16 * i;
      float4 v = make_float4(0.f, 0.f, 0.f, 0.f);
      if (n < N) v = *reinterpret_cast<const float4*>(src + (size_t)(kt * 64 + kr) * N + n);
      tile[kr * 65 + c4 + 0] = v.x;
      tile[kr * 65 + c4 + 1] = v.y;
      tile[kr * 65 + c4 + 2] = v.z;
      tile[kr * 65 + c4 + 3] = v.w;
    }
  }
  __syncthreads();
  {
    int nr = tid >> 2, kch = (tid & 3) * 16;
    unsigned w[8];
#pragma unroll
    for (int i = 0; i < 8; ++i) w[i] = pack2(tile[(kch + 2 * i) * 65 + nr], tile[(kch + 2 * i + 1) * 65 + nr]);
    u16* d = dst + (size_t)(nt * 64 + nr) * K + kt * 64 + kch;
    *reinterpret_cast<uint4*>(d) = make_uint4(w[0], w[1], w[2], w[3]);
    *reinterpret_cast<uint4*>(d + 8) = make_uint4(w[4], w[5], w[6], w[7]);
  }
}

__device__ __forceinline__ const float* xrow_in(const Params& p, int row) {
  return row < NPR ? p.x_prompt + (size_t)row * 1024 : p.x_sample + (size_t)(row - NPR) * 1024;
}

__device__ __forceinline__ void norm_ug_job(const Params& p, int job) {
  const int lane = threadIdx.x & 63, wave = threadIdx.x >> 6;
  int row = job * 4 + wave;
  if (row >= NTOK) return;
  const float* x = xrow_in(p, row) + lane * 16;
  float v[16];
#pragma unroll
  for (int i = 0; i < 4; ++i) {
    float4 t = *reinterpret_cast<const float4*>(x + 4 * i);
    v[4 * i] = t.x; v[4 * i + 1] = t.y; v[4 * i + 2] = t.z; v[4 * i + 3] = t.w;
  }
  float ss = 0.f;
#pragma unroll
  for (int i = 0; i < 16; ++i) ss += v[i] * v[i];
#pragma unroll
  for (int d = 32; d >= 1; d >>= 1) ss += __shfl_xor(ss, d);
  float rs = rsqrtf(ss * (1.f / 1024.f) + 1e-6f);
  const float* g = p.norm_mix + lane * 16;
  unsigned w[8];
#pragma unroll
  for (int i = 0; i < 8; ++i) w[i] = pack2(v[2 * i] * rs * g[2 * i], v[2 * i + 1] * rs * g[2 * i + 1]);
  u16* ug = reinterpret_cast<u16*>(p.ws + R_UG) + ((size_t)lane * NTOK + row) * 16;
  *reinterpret_cast<uint4*>(ug) = make_uint4(w[0], w[1], w[2], w[3]);
  *reinterpret_cast<uint4*>(ug + 8) = make_uint4(w[4], w[5], w[6], w[7]);
}

__device__ __forceinline__ void norm_hn_job(const Params& p, const float* __restrict__ X, const float* __restrict__ gw, int job) {
  const int lane = threadIdx.x & 63, wave = threadIdx.x >> 6;
  const int row0 = job * 16 + wave * 4;
  float4 t[4][4];
#pragma unroll
  for (int rr = 0; rr < 4; ++rr) {
    const float* x = X + (size_t)(row0 + rr) * 1024;
#pragma unroll
    for (int i = 0; i < 4; ++i) t[rr][i] = *reinterpret_cast<const float4*>(x + 4 * lane + 256 * i);
  }
  float4 g[4];
#pragma unroll
  for (int i = 0; i < 4; ++i) g[i] = *reinterpret_cast<const float4*>(gw + 4 * lane + 256 * i);
#pragma unroll
  for (int rr = 0; rr < 4; ++rr) {
    float ss = 0.f;
#pragma unroll
    for (int i = 0; i < 4; ++i) ss += t[rr][i].x * t[rr][i].x + t[rr][i].y * t[rr][i].y + t[rr][i].z * t[rr][i].z + t[rr][i].w * t[rr][i].w;
#pragma unroll
    for (int d = 32; d >= 1; d >>= 1) ss += __shfl_xor(ss, d);
    float rs = rsqrtf(ss * (1.f / 1024.f) + 1e-6f);
    u16* hn = reinterpret_cast<u16*>(p.ws + R_HN) + (size_t)(row0 + rr) * 1024;
#pragma unroll
    for (int i = 0; i < 4; ++i) {
      uint2 o;
      o.x = pack2(t[rr][i].x * rs * g[i].x, t[rr][i].y * rs * g[i].y);
      o.y = pack2(t[rr][i].z * rs * g[i].z, t[rr][i].w * rs * g[i].w);
      *reinterpret_cast<uint2*>(hn + 4 * lane + 256 * i) = o;
    }
  }
}

__device__ __forceinline__ void s5_table_job(const Params& p, int job) {
  int t = job * 256 + threadIdx.x;
  int c = t & 15, pp = (t >> 4) & 63, g = t >> 10;
  float lre = fminf(p.lam_re[g * 64 + pp], -1e-4f);
  float lim = p.lam_im[g * 64 + pp];
  float dt = expf(p.log_dt[g]);
  float mag = expf(lre * dt);
  float sn, cs;
  sincosf(lim * dt, &sn, &cs);
  float are = mag * cs, aim = mag * sn;
  float den = lre * lre + lim * lim;
  float nre = are - 1.f;
  float fre = (nre * lre + aim * lim) / den;
  float fim = (aim * lre - nre * lim) / den;
  float br = p.b_re[(g * 64 + pp) * 16 + c], bi = p.b_im[(g * 64 + pp) * 16 + c];
  float bbr = fre * br - fim * bi;
  float bbi = fre * bi + fim * br;
  float* bb = reinterpret_cast<float*>(p.ws + R_BB) + ((size_t)(g * 64 + pp) * 16 + c) * 2;
  bb[0] = bbr; bb[1] = bbi;
  u16* W1 = reinterpret_cast<u16*>(p.ws + R_W1) + (size_t)g * 128 * 512;
  float pr = 1.f, pi = 0.f;
  for (int n = 0; n < 32; ++n) {
    int i = 31 - n;
    W1[(size_t)pp * 512 + i * 16 + c] = f2bf(pr * bbr - pi * bbi);
    W1[(size_t)(64 + pp) * 512 + i * 16 + c] = f2bf(pr * bbi + pi * bbr);
    float nr = pr * are - pi * aim, ni = pr * aim + pi * are;
    pr = nr; pi = ni;
  }
  if (c == 0) {
    float* ap = reinterpret_cast<float*>(p.ws + R_AP) + (size_t)(g * 64 + pp) * 66;
    float qr = 1.f, qi = 0.f;
    for (int n = 0; n <= 32; ++n) {
      ap[2 * n] = qr; ap[2 * n + 1] = qi;
      float nr = qr * are - qi * aim, ni = qr * aim + qi * are;
      qr = nr; qi = ni;
    }
  }
}

__device__ __forceinline__ void phase0(const Params& p, char* smem) {
  const int NJ_T = 5536, NJ_N = 4160, NJ_S = 256;
  for (int job = blockIdx.x; job < NJ_S + NJ_N + NJ_T; job += gridDim.x) {
    if (job < NJ_S) {
      s5_table_job(p, job);
    } else if (job < NJ_S + NJ_N) {
      norm_ug_job(p, job - NJ_S);
    } else {
      int j = job - NJ_S - NJ_N;
      const float* src; u16* dst; int K, N, ntn;
      if (j < 512) { src = p.w_glu; dst = (u16*)(p.ws + W_GLU); K = 1024; N = 2048; ntn = 32; }
      else if (j < 1056) { j -= 512; src = p.w_in; dst = (u16*)(p.ws + W_IN); K = 1024; N = 2120; ntn = 34; }
      else if (j < 1312) { j -= 1056; src = p.w_o; dst = (u16*)(p.ws + W_O); K = 1024; N = 1024; ntn = 16; }
      else if (j < 2720) { j -= 1312; src = p.w_up; dst = (u16*)(p.ws + W_UP); K = 1024; N = 5632; ntn = 88; }
      else if (j < 4128) { j -= 2720; src = p.w_up + (size_t)1024 * 5632; dst = (u16*)(p.ws + W_UP) + (size_t)5632 * 1024; K = 1024; N = 5632; ntn = 88; }
      else if (j < 4832) { j -= 4128; src = p.w_down; dst = (u16*)(p.ws + W_DN); K = 2816; N = 1024; ntn = 16; }
      else { j -= 4832; src = p.w_down + (size_t)2816 * 1024; dst = (u16*)(p.ws + W_DN) + (size_t)1024 * 2816; K = 2816; N = 1024; ntn = 16; }
      transpose_job(src, dst, K, N, j / ntn, j % ntn, smem);
    }
  }
}

__device__ __forceinline__ void phase1(const Params& p, char* smem) {
  const int NT_G = 320, NJ_K = 2048, NJ_W = 8192;
  const u16* UG = reinterpret_cast<const u16*>(p.ws + R_UG);
  const u16* W1 = reinterpret_cast<const u16*>(p.ws + R_W1);
  float* S = reinterpret_cast<float*>(p.ws + R_S);
  const float* AP = reinterpret_cast<const float*>(p.ws + R_AP);
  const float* BB = reinterpret_cast<const float*>(p.ws + R_BB);
  for (int job = blockIdx.x; job < NT_G + NJ_K + NJ_W; job += gridDim.x) {
    if (job < NT_G) {
      int g = job / 5, mt = job % 5;
      const u16* ug = UG + (size_t)g * NTOK * 16;
      const u16* w1 = W1 + (size_t)g * 128 * 512;
      auto la = [=](int r, int k) -> uint4 {
        int col = mt * 128 + r;
        return col < 520 ? ld16(ug + (size_t)col * 512 + k) : zero4();
      };
      auto lb = [=](int n, int k) -> uint4 { return ld16(w1 + (size_t)n * 512 + k); };
      gemm_core(la, lb, KIdent(), 8, smem);
      const float* sC = reinterpret_cast<const float*>(smem);
      {
        const int cg = threadIdx.x & 31, r0 = threadIdx.x >> 5;
#pragma unroll
        for (int i = 0; i < 16; ++i) {
          int r = r0 + 8 * i;
          int col = mt * 128 + r;
          const float* c = sC + r * LDC + 4 * cg;
          if (col < 520) *reinterpret_cast<float4*>(&S[((size_t)col * 64 + g) * 128 + 4 * cg]) = make_float4(c[0], c[1], c[2], c[3]);
        }
      }
    } else if (job < NT_G + NJ_K) {
      int t = (job - NT_G) * 256 + threadIdx.x;
      int c = t & 15, cp = (t >> 4) & 15, tau = (t >> 8) & 31, g = t >> 13;
      float acc = 0.f;
#pragma unroll 16
      for (int pp = 0; pp < 64; ++pp) {
        float cr = p.c_re[(g * 16 + cp) * 64 + pp], ci = p.c_im[(g * 16 + cp) * 64 + pp];
        const float* bb = BB + ((size_t)(g * 64 + pp) * 16 + c) * 2;
        const float* ap = AP + (size_t)(g * 64 + pp) * 66 + 2 * tau;
        float br = bb[0], bi = bb[1];
        float ar = ap[0], ai = ap[1];
        float xr = br * ar - bi * ai, xi = br * ai + bi * ar;
        acc += cr * xr - ci * xi;
      }
      reinterpret_cast<u16*>(p.ws + R_KT)[t] = f2bf(acc);
    } else {
      int t = (job - NT_G - NJ_K) * 256 + threadIdx.x;
      int pp = t & 63, cp = (t >> 6) & 15, j = (t >> 10) & 31, g = t >> 15;
      float cr = p.c_re[(g * 16 + cp) * 64 + pp], ci = p.c_im[(g * 16 + cp) * 64 + pp];
      const float* ap = AP + (size_t)(g * 64 + pp) * 66 + 2 * (j + 1);
      float ar = ap[0], ai = ap[1];
      float vr = cr * ar - ci * ai, vi = cr * ai + ci * ar;
      u16* W3 = reinterpret_cast<u16*>(p.ws + R_W3) + ((size_t)g * 512 + j * 16 + cp) * 128;
      W3[pp] = f2bf(vr);
      W3[64 + pp] = f2bf(-vi);
    }
  }
}

__device__ __forceinline__ void phase2(const Params& p) {
  const float* S = reinterpret_cast<const float*>(p.ws + R_S);
  u16* HP = reinterpret_cast<u16*>(p.ws + R_HP);
  const float* AP = reinterpret_cast<const float*>(p.ws + R_AP);
  for (int job = blockIdx.x; job < 192; job += gridDim.x) {
    int t = job * 256 + threadIdx.x;
    if (t < 16384) {
      int pp = t & 63, g = (t >> 6) & 63, b = t >> 12;
      float ar = AP[(size_t)(g * 64 + pp) * 66 + 64], ai = AP[(size_t)(g * 64 + pp) * 66 + 65];
      float hr = 0.f, hi = 0.f;
      for (int c0 = 0; c0 < 128; c0 += 16) {
        float sr[16], si[16];
#pragma unroll
        for (int u = 0; u < 16; ++u) {
          size_t o = ((size_t)(b * 128 + c0 + u) * 64 + g) * 128 + pp;
          sr[u] = S[o]; si[u] = S[o + 64];
        }
#pragma unroll
        for (int u = 0; u < 16; ++u) {
          size_t o = ((size_t)(b * 128 + c0 + u) * 64 + g) * 128 + pp;
          HP[o] = f2bf(hr);
          HP[o + 64] = f2bf(hi);
          float nr = ar * hr - ai * hi + sr[u];
          float ni = ar * hi + ai * hr + si[u];
          hr = nr; hi = ni;
        }
      }
      p.out[O_SSM_RE_P + (b * 64 + g) * 64 + pp] = hr;
      p.out[O_SSM_IM_P + (b * 64 + g) * 64 + pp] = hi;
    } else {
      int u = t - 16384;
      int pp = u & 63, g = (u >> 6) & 63, b = u >> 12;
      float ar = AP[(size_t)(g * 64 + pp) * 66 + 64], ai = AP[(size_t)(g * 64 + pp) * 66 + 65];
      float hr = p.st_re[(b * 64 + g) * 64 + pp], hi = p.st_im[(b * 64 + g) * 64 + pp];
      size_t o = ((size_t)(512 + b) * 64 + g) * 128 + pp;
      HP[o] = f2bf(hr);
      HP[o + 64] = f2bf(hi);
      float nr = ar * hr - ai * hi + S[o];
      float ni = ar * hi + ai * hr + S[o + 64];
      p.out[O_SSM_RE_S + (b * 64 + g) * 64 + pp] = nr;
      p.out[O_SSM_IM_S + (b * 64 + g) * 64 + pp] = ni;
    }
  }
}

struct KMapS3 {
  int nlow;
  __device__ __forceinline__ int operator()(int kt) const { return kt < nlow ? kt * 64 : 512 + (kt - nlow) * 64; }
};

__device__ __forceinline__ void phase3(const Params& p, char* smem) {
  const u16* UG = reinterpret_cast<const u16*>(p.ws + R_UG);
  const u16* HP = reinterpret_cast<const u16*>(p.ws + R_HP);
  const u16* KT = reinterpret_cast<const u16*>(p.ws + R_KT);
  const u16* W3 = reinterpret_cast<const u16*>(p.ws + R_W3);
  u16* Z = reinterpret_cast<u16*>(p.ws + R_Z);
  for (int job = blockIdx.x; job < 1280; job += gridDim.x) {
    int nt = 3 - (job & 3);
    int mt = (job >> 2) % 5, g = job / 20;
    const u16* ug = UG + (size_t)g * NTOK * 16;
    auto la = [=](int r, int k) -> uint4 {
      int col = mt * 128 + r;
      if (col >= 520) return zero4();
      if (k < 512) return ld16(ug + (size_t)col * 512 + k);
      return ld16(HP + ((size_t)col * 64 + g) * 128 + (k - 512));
    };
    auto lb = [=](int nl, int k) -> uint4 {
      int n = nt * 128 + nl;
      if (k < 512) {
        int j = n >> 4, cp = n & 15, i = k >> 4, c0 = k & 15;
        if (j < i) return zero4();
        return ld16(KT + ((size_t)(g * 32 + (j - i)) * 16 + cp) * 16 + c0);
      }
      return ld16(W3 + ((size_t)g * 512 + n) * 128 + (k - 512));
    };
    KMapS3 km; km.nlow = 2 * (nt + 1);
    gemm_core(la, lb, km, km.nlow + 2, smem);
    const float* sC = reinterpret_cast<const float*>(smem);
    {
      const int cg = threadIdx.x & 31, r0 = threadIdx.x >> 5;
      const int n = nt * 128 + 4 * cg;
      const int j = n >> 4, cp = n & 15;
      const float4 dv = *reinterpret_cast<const float4*>(p.ssm_d + g * 16 + cp);
      uint2 uv[16];
#pragma unroll
      for (int i = 0; i < 16; ++i) {
        int col = mt * 128 + r0 + 8 * i;
        uv[i] = make_uint2(0u, 0u);
        if (col < 520) uv[i] = *reinterpret_cast<const uint2*>(ug + (size_t)(col * 32 + j) * 16 + cp);
      }
#pragma unroll
      for (int i = 0; i < 16; ++i) {
        int r = r0 + 8 * i;
        int col = mt * 128 + r;
        if (col < 520) {
          const float* c = sC + r * LDC + 4 * cg;
          float y0 = c[0] + dv.x * __uint_as_float(uv[i].x << 16);
          float y1 = c[1] + dv.y * __uint_as_float(uv[i].x & 0xffff0000u);
          float y2 = c[2] + dv.z * __uint_as_float(uv[i].y << 16);
          float y3 = c[3] + dv.w * __uint_as_float(uv[i].y & 0xffff0000u);
          uint2 o;
          o.x = pack2(gelu_tanh(y0), gelu_tanh(y1));
          o.y = pack2(gelu_tanh(y2), gelu_tanh(y3));
          *reinterpret_cast<uint2*>(Z + (size_t)(col * 32 + j) * 1024 + g * 16 + cp) = o;
        }
      }
    }
  }
}


#define LDK2 40
#define STAGE2 (384 * LDK2)
template <bool HALO, class LA, class LB, class EPI>
__device__ __forceinline__ void gemm256(LA la, LB lb, EPI epi, int nk, char* smem) {
  u16* sbuf = reinterpret_cast<u16*>(smem);
  const int tid = threadIdx.x, lane = tid & 63, wave = tid >> 6;
  const int wm = wave >> 1, wn = wave & 1;
  const int lrow = tid >> 2, kc = (tid & 3) * 8;
  f32x16 acc[4][2];
#pragma unroll
  for (int i = 0; i < 4; ++i)
#pragma unroll
    for (int j = 0; j < 2; ++j)
#pragma unroll
      for (int r = 0; r < 16; ++r) acc[i][j][r] = 0.f;
  uint4 ra[4], rb[2];
#pragma unroll
  for (int i = 0; i < 4; ++i) ra[i] = la(lrow + 64 * i, kc);
#pragma unroll
  for (int i = 0; i < 2; ++i) rb[i] = lb(lrow + 64 * i, kc);
  __syncthreads();
#pragma unroll
  for (int i = 0; i < 4; ++i) *reinterpret_cast<uint4*>(&sbuf[(lrow + 64 * i) * LDK2 + kc]) = ra[i];
#pragma unroll
  for (int i = 0; i < 2; ++i) *reinterpret_cast<uint4*>(&sbuf[(256 + lrow + 64 * i) * LDK2 + kc]) = rb[i];
  if (nk > 1) {
#pragma unroll
    for (int i = 0; i < 4; ++i) ra[i] = la(lrow + 64 * i, 32 + kc);
#pragma unroll
    for (int i = 0; i < 2; ++i) rb[i] = lb(lrow + 64 * i, 32 + kc);
  }
#pragma unroll 1
  for (int kt = 0; kt < nk; ++kt) {
    __syncthreads();
    const u16* cA = sbuf + (kt & 1) * STAGE2;
    const u16* cB = cA + 256 * LDK2;
    u16* nA = sbuf + ((kt + 1) & 1) * STAGE2;
    {
      bf16x8 af[4], bfr[2];
#pragma unroll
      for (int mi = 0; mi < 4; ++mi)
        af[mi] = *reinterpret_cast<const bf16x8*>(&cA[(wm * 128 + mi * 32 + (lane & 31)) * LDK2 + (lane >> 5) * 8]);
#pragma unroll
      for (int ni = 0; ni < 2; ++ni)
        bfr[ni] = *reinterpret_cast<const bf16x8*>(&cB[(wn * 64 + ni * 32 + (lane & 31)) * LDK2 + (lane >> 5) * 8]);
#pragma unroll
      for (int mi = 0; mi < 4; ++mi)
#pragma unroll
        for (int ni = 0; ni < 2; ++ni)
          acc[mi][ni] = __builtin_amdgcn_mfma_f32_32x32x16_bf16(af[mi], bfr[ni], acc[mi][ni], 0, 0, 0);
    }
    if (kt + 1 < nk) {
#pragma unroll
      for (int i = 0; i < 4; ++i) *reinterpret_cast<uint4*>(&nA[(lrow + 64 * i) * LDK2 + kc]) = ra[i];
#pragma unroll
      for (int i = 0; i < 2; ++i) *reinterpret_cast<uint4*>(&nA[(256 + lrow + 64 * i) * LDK2 + kc]) = rb[i];
      if (kt + 2 < nk) {
        int k2 = (kt + 2) * 32 + kc;
#pragma unroll
        for (int i = 0; i < 4; ++i) ra[i] = la(lrow + 64 * i, k2);
#pragma unroll
        for (int i = 0; i < 2; ++i) rb[i] = lb(lrow + 64 * i, k2);
      }
    }
    {
      bf16x8 af[4], bfr[2];
#pragma unroll
      for (int mi = 0; mi < 4; ++mi)
        af[mi] = *reinterpret_cast<const bf16x8*>(&cA[(wm * 128 + mi * 32 + (lane & 31)) * LDK2 + 16 + (lane >> 5) * 8]);
#pragma unroll
      for (int ni = 0; ni < 2; ++ni)
        bfr[ni] = *reinterpret_cast<const bf16x8*>(&cB[(wn * 64 + ni * 32 + (lane & 31)) * LDK2 + 16 + (lane >> 5) * 8]);
#pragma unroll
      for (int mi = 0; mi < 4; ++mi)
#pragma unroll
        for (int ni = 0; ni < 2; ++ni)
          acc[mi][ni] = __builtin_amdgcn_mfma_f32_32x32x16_bf16(af[mi], bfr[ni], acc[mi][ni], 0, 0, 0);
    }
  }
  float* sC = reinterpret_cast<float*>(smem);
#pragma unroll
  for (int h = 0; h < 2; ++h) {
    __syncthreads();
#pragma unroll
    for (int m2 = 0; m2 < 2; ++m2)
#pragma unroll
      for (int ni = 0; ni < 2; ++ni)
#pragma unroll
        for (int r = 0; r < 16; ++r) {
          int j = m2 * 32 + (r & 3) + 8 * (r >> 2) + 4 * (lane >> 5);
          int col = wn * 64 + ni * 32 + (lane & 31);
          sC[(wm * 66 + 2 + j) * LDC + col] = acc[2 * h + m2][ni][r];
        }
    if (HALO) {
      if (h == 0) {
        if (wm == 0 && lane >= 32) {
#pragma unroll
          for (int ni = 0; ni < 2; ++ni) {
            int col = wn * 64 + ni * 32 + (lane & 31);
            sC[(66 + 0) * LDC + col] = acc[3][ni][14];
            sC[(66 + 1) * LDC + col] = acc[3][ni][15];
          }
        }
      } else {
        if (lane >= 32) {
#pragma unroll
          for (int ni = 0; ni < 2; ++ni) {
            int col = wn * 64 + ni * 32 + (lane & 31);
            sC[(wm * 66 + 0) * LDC + col] = acc[1][ni][14];
            sC[(wm * 66 + 1) * LDC + col] = acc[1][ni][15];
          }
        }
      }
    }
    __syncthreads();
    epi(h, sC);
  }
}


#define GSTAGE_B (384 * 64)
#define WAITV(n) asm volatile("s_waitcnt vmcnt(%0)" ::"n"(n) : "memory")
#define RAWBAR() do { asm volatile("s_waitcnt lgkmcnt(0)" ::: "memory"); __builtin_amdgcn_s_barrier(); } while (0)
template <bool HALO, class PA, class PB, class EPI>
__device__ __forceinline__ void gemm256g(const u16* baseA, const u16* baseB, PA pa, PB pb, EPI epi, int nk, char* smem) {
  const int tid = threadIdx.x, lane = tid & 63, wave = tid >> 6;
  const int wm = wave >> 1, wn = wave & 1;
  const int lrow = tid >> 2, cpos = tid & 3;
  f32x16 acc[4][2];
#pragma unroll
  for (int i = 0; i < 4; ++i)
#pragma unroll
    for (int j = 0; j < 2; ++j)
#pragma unroll
      for (int r = 0; r < 16; ++r) acc[i][j][r] = 0.f;
  const int koff = 8 * (cpos ^ ((lrow >> 2) & 3));
  unsigned offA[4], offB[2];
#pragma unroll
  for (int i = 0; i < 4; ++i) offA[i] = (pa(lrow + 64 * i) + koff) * 2u;
#pragma unroll
  for (int i = 0; i < 2; ++i) offB[i] = (pb(lrow + 64 * i) + koff) * 2u;
  auto issue = [&](int kt, int st) {
    char* base = smem + st * GSTAGE_B;
    const unsigned kb = kt * 64;
#pragma unroll
    for (int i = 0; i < 4; ++i)
      __builtin_amdgcn_global_load_lds((const unsigned*)(reinterpret_cast<const char*>(baseA) + (size_t)(offA[i] + kb)),
                                       (unsigned*)(base + (lrow + 64 * i) * 64 + cpos * 16), 16, 0, 0);
#pragma unroll
    for (int i = 0; i < 2; ++i)
      __builtin_amdgcn_global_load_lds((const unsigned*)(reinterpret_cast<const char*>(baseB) + (size_t)(offB[i] + kb)),
                                       (unsigned*)(base + (256 + lrow + 64 * i) * 64 + cpos * 16), 16, 0, 0);
  };
  WAITV(0);
  __syncthreads();
  issue(0, 0);
  if (nk > 1) issue(1, 1);
  if (nk > 2) issue(2, 2);
  if (nk > 2) WAITV(12); else if (nk > 1) WAITV(6); else WAITV(0);
  RAWBAR();
  const int sw = ((lane & 31) >> 2) & 3;
  const unsigned lds0 = (unsigned)(size_t)((__attribute__((address_space(3))) char*)smem);
  const unsigned ra_off = lds0 + (wm * 128 + (lane & 31)) * 64;
  const unsigned rb_off = lds0 + (256 + wn * 64 + (lane & 31)) * 64;
  const unsigned ph0 = (((lane >> 5)) ^ sw) * 16, ph1 = ((2 + (lane >> 5)) ^ sw) * 16;
#define GR6(F, aA, aB)                                                                                              \
  asm volatile("ds_read_b128 %0, %6\n\tds_read_b128 %4, %7\n\tds_read_b128 %1, %6 offset:2048\n\t"                 \
               "ds_read_b128 %5, %7 offset:2048\n\tds_read_b128 %2, %6 offset:4096\n\tds_read_b128 %3, %6 offset:6144" \
               : "=&v"(F[0]), "=&v"(F[1]), "=&v"(F[2]), "=&v"(F[3]), "=&v"(F[4]), "=&v"(F[5])                       \
               : "v"(aA), "v"(aB)                                                                                   \
               : "memory")
#define GW(n, F)                                                                                                    \
  asm volatile("s_waitcnt lgkmcnt(" #n ")"                                                                          \
               : "+v"(F[0]), "+v"(F[1]), "+v"(F[2]), "+v"(F[3]), "+v"(F[4]), "+v"(F[5])::"memory")
#define GMMA(F)                                                                                                     \
  _Pragma("unroll") for (int mi = 0; mi < 4; ++mi) _Pragma("unroll") for (int ni = 0; ni < 2; ++ni)                 \
      acc[mi][ni] = __builtin_amdgcn_mfma_f32_32x32x16_bf16(F[mi], F[4 + ni], acc[mi][ni], 0, 0, 0)
  bf16x8 F0[6], F1[6];
  {
    const unsigned aA = ra_off + ph0, aB = rb_off + ph0;
    GR6(F0, aA, aB);
  }
  int st = 0;
#pragma unroll 1
  for (int kt = 0; kt < nk; ++kt) {
    const unsigned sb = st * GSTAGE_B;
    {
      const unsigned aA = sb + ra_off + ph1, aB = sb + rb_off + ph1;
      GR6(F1, aA, aB);
    }
    GW(6, F0);
    __builtin_amdgcn_sched_barrier(0);
    GMMA(F0);
    __builtin_amdgcn_sched_barrier(0);
    GW(0, F1);
    if (kt + 1 < nk) { if (kt + 2 < nk) WAITV(6); else WAITV(0); }
    __builtin_amdgcn_s_barrier();
    __builtin_amdgcn_sched_barrier(0);
    int st1 = st + 1; if (st1 >= 3) st1 = 0;
    if (kt + 1 < nk) {
      const unsigned aA = st1 * GSTAGE_B + ra_off + ph0, aB = st1 * GSTAGE_B + rb_off + ph0;
      GR6(F0, aA, aB);
    }
    if (kt + 3 < nk) issue(kt + 3, st);
    __builtin_amdgcn_sched_barrier(0);
    GMMA(F1);
    __builtin_amdgcn_sched_barrier(0);
    st = st1;
  }
  asm volatile("s_waitcnt lgkmcnt(0)" ::: "memory");
  float* sC = reinterpret_cast<float*>(smem);
#pragma unroll
  for (int h = 0; h < 2; ++h) {
    __syncthreads();
#pragma unroll
    for (int m2 = 0; m2 < 2; ++m2)
#pragma unroll
      for (int ni = 0; ni < 2; ++ni)
#pragma unroll
        for (int r = 0; r < 16; ++r) {
          int j = m2 * 32 + (r & 3) + 8 * (r >> 2) + 4 * (lane >> 5);
          int col = wn * 64 + ni * 32 + (lane & 31);
          sC[(wm * 66 + 2 + j) * LDG + col] = acc[2 * h + m2][ni][r];
        }
    if (HALO) {
      if (h == 0) {
        if (wm == 0 && lane >= 32) {
#pragma unroll
          for (int ni = 0; ni < 2; ++ni) {
            int col = wn * 64 + ni * 32 + (lane & 31);
            sC[(66 + 0) * LDG + col] = acc[3][ni][14];
            sC[(66 + 1) * LDG + col] = acc[3][ni][15];
          }
        }
      } else {
        if (lane >= 32) {
#pragma unroll
          for (int ni = 0; ni < 2; ++ni) {
            int col = wn * 64 + ni * 32 + (lane & 31);
            sC[(wm * 66 + 0) * LDG + col] = acc[1][ni][14];
            sC[(wm * 66 + 1) * LDG + col] = acc[1][ni][15];
          }
        }
      }
    }
    __syncthreads();
    epi(h, sC);
  }
}

__device__ __forceinline__ float4 ld4f(const float* p, bool vec) {
  if (vec) return *reinterpret_cast<const float4*>(p);
  return make_float4(p[0], p[1], p[2], p[3]);
}
template <bool SPLIT>
__device__ __forceinline__ int epi_srow(int v) { return SPLIT ? (v >> 6) * 66 + 2 + (v & 63) : v; }
template <bool SPLIT>
__device__ __forceinline__ int epi_grow(int v, int row0, int h) { return SPLIT ? row0 + 128 * (v >> 6) + 64 * h + (v & 63) : row0 + v; }

template <bool SPLIT>
__device__ __forceinline__ void glu_epi(const Params& p, const float* sC, int row0, int h, int n0) {
  float* X = p.out;
  const int cg = threadIdx.x & 15, r0 = threadIdx.x >> 4;
  const float4 b1 = *reinterpret_cast<const float4*>(p.b_glu + n0 + 4 * cg);
  const float4 b2 = *reinterpret_cast<const float4*>(p.b_glu + 1024 + n0 + 4 * cg);
#pragma unroll
  for (int hh = 0; hh < 2; ++hh) {
    float4 xv[4];
#pragma unroll
    for (int i = 0; i < 4; ++i) xv[i] = *reinterpret_cast<const float4*>(xrow_in(p, epi_grow<SPLIT>(r0 + 16 * (hh * 4 + i), row0, h)) + n0 + 4 * cg);
#pragma unroll
    for (int i = 0; i < 4; ++i) {
      int v = r0 + 16 * (hh * 4 + i);
      const float* c = sC + epi_srow<SPLIT>(v) * (SPLIT ? LDG : LDC) + 4 * cg;
      const float4 g1 = ld4f(c, SPLIT), g2 = ld4f(c + 64, SPLIT);
      float4 o;
      o.x = xv[i].x + (g1.x + b1.x) * sigmoid_fast(g2.x + b2.x);
      o.y = xv[i].y + (g1.y + b1.y) * sigmoid_fast(g2.y + b2.y);
      o.z = xv[i].z + (g1.z + b1.z) * sigmoid_fast(g2.z + b2.z);
      o.w = xv[i].w + (g1.w + b1.w) * sigmoid_fast(g2.w + b2.w);
      *reinterpret_cast<float4*>(X + (size_t)epi_grow<SPLIT>(v, row0, h) * 1024 + n0 + 4 * cg) = o;
    }
  }
}
template <bool SPLIT>
__device__ __forceinline__ void resid_epi(const Params& p, const float* sC, int row0, int h, int col0) {
  const int cg = threadIdx.x & 31, r0 = threadIdx.x >> 5;
  float* xb = p.out + col0 + 4 * cg;
#pragma unroll
  for (int half = 0; half < 2; ++half) {
    float4 xv[8];
#pragma unroll
    for (int i = 0; i < 8; ++i) xv[i] = *reinterpret_cast<const float4*>(xb + (size_t)epi_grow<SPLIT>(r0 + 8 * (half * 8 + i), row0, h) * 1024);
#pragma unroll
    for (int i = 0; i < 8; ++i) {
      int v = r0 + 8 * (half * 8 + i);
      const float4 cv = ld4f(sC + epi_srow<SPLIT>(v) * (SPLIT ? LDG : LDC) + 4 * cg, SPLIT);
      float4 o = make_float4(xv[i].x + cv.x, xv[i].y + cv.y, xv[i].z + cv.z, xv[i].w + cv.w);
      *reinterpret_cast<float4*>(xb + (size_t)epi_grow<SPLIT>(v, row0, h) * 1024) = o;
    }
  }
}

__device__ __forceinline__ void phase4(const Params& p, char* smem) {
  const u16* Z = reinterpret_cast<const u16*>(p.ws + R_Z);
  const u16* W = reinterpret_cast<const u16*>(p.ws + W_GLU);
  for (TileSched ts(64 * 16); ts.i < ts.end; ts.i += ts.step) {
    int mt, nt;
    tile_decode(ts.i, 64, 16, mt, nt);
    int n0 = nt * 64;
    auto la = [=](int r) -> unsigned { return (unsigned)(mt * 256 + r) * 1024u; };
    auto lb = [=](int nl) -> unsigned {
      int nrow = nl < 64 ? n0 + nl : 1024 + n0 + nl - 64;
      return (unsigned)nrow * 1024u;
    };
    auto epi = [&](int h, const float* sC) { glu_epi<true>(p, sC, mt * 256, h, n0); };
    gemm256g<false>(Z, W, la, lb, epi, 32, smem);
  }
  for (int job = blockIdx.x; job < 32; job += gridDim.x) {
    int mt = 128 + (job >> 4), nt = job & 15;
    int n0 = nt * 64;
    auto la = [=](int r, int k) -> uint4 { return ld16(Z + (size_t)(mt * 128 + r) * 1024 + k); };
    auto lb = [=](int nl, int k) -> uint4 {
      int nrow = nl < 64 ? n0 + nl : 1024 + n0 + nl - 64;
      return ld16(W + (size_t)nrow * 1024 + k);
    };
    gemm_core(la, lb, KIdent(), 16, smem);
    glu_epi<false>(p, reinterpret_cast<const float*>(smem), mt * 128, 0, n0);
  }
}


__device__ __forceinline__ size_t ki_off(int row, int kc) { return ((size_t)((row >> 5) * 8 + kc) * 32 + (row & 31)) * 8; }

__device__ __forceinline__ void phase_norm(const Params& p, const float* gw, bool conv_caches) {
  int nj = 1040 + (conv_caches ? (4096 + 4096 + 1024) : 0);
  if (blockIdx.x == 0 && threadIdx.x < 128) *reinterpret_cast<uint4*>(reinterpret_cast<u16*>(p.ws + R_HN) + (size_t)NTOK * 1024 + threadIdx.x * 8) = zero4();
  for (int job = blockIdx.x; job < nj; job += gridDim.x) {
    if (job < 1040) {
      norm_hn_job(p, p.out, gw, job);
    } else {
      int j = job - 1040;
      if (j < 8192) {
        const float* src = j < 4096 ? p.cache_k : p.cache_v;
        u16* dst = reinterpret_cast<u16*>(p.ws + (j < 4096 ? R_KB : R_VB));
        int jj = j & 4095;
        size_t e = ((size_t)jj * 256 + threadIdx.x) * 8;
        int b = (int)(e >> 20);
        size_t within = e & ((1u << 20) - 1);
        float4 a = *reinterpret_cast<const float4*>(src + e);
        float4 c = *reinterpret_cast<const float4*>(src + e + 4);
        uint4 o = make_uint4(pack2(a.x, a.y), pack2(a.z, a.w), pack2(c.x, c.y), pack2(c.z, c.w));
        *reinterpret_cast<uint4*>(dst + ((size_t)NPR + (size_t)b * 4128) * 256 + within) = o;
      } else {
        int jj = j - 8192;
        size_t e = ((size_t)jj * 256 + threadIdx.x) * 8;
        int b = (int)(e >> 18);
        size_t within = e & ((1u << 18) - 1);
        float4 a = *reinterpret_cast<const float4*>(p.cache_kidx + e);
        float4 c = *reinterpret_cast<const float4*>(p.cache_kidx + e + 4);
        uint4 o = make_uint4(pack2(a.x, a.y), pack2(a.z, a.w), pack2(c.x, c.y), pack2(c.z, c.w));
        {
          int row = NPR + b * 4128 + (int)(within >> 6), kc = (int)((within & 63) >> 3);
          *reinterpret_cast<uint4*>(reinterpret_cast<u16*>(p.ws + R_KI) + ki_off(row, kc)) = o;
        }
      }
    }
  }
}

__device__ __forceinline__ void phase_up(const Params& p, int layer, char* smem) {
  const u16* HN = reinterpret_cast<const u16*>(p.ws + R_HN);
  const u16* W = reinterpret_cast<const u16*>(p.ws + W_UP) + (size_t)layer * 5632 * 1024;
  u16* GT = reinterpret_cast<u16*>(p.ws + R_GT);
  const float* cw = p.conv_w + (size_t)layer * 3 * 2816;
  const float* cb = p.conv_b + (size_t)layer * 2816;
  for (TileSched ts(69 * 44); ts.i < ts.end; ts.i += ts.step) {
    int mt, nt;
    tile_decode(ts.i, 69, 44, mt, nt);
    const int n0 = nt * 64;
    const bool prompt = mt < 68;
    const int s = mt / 17, it = mt - s * 17;
    const int tbase = 254 * it - 2;
    const int rbase = prompt ? s * 4096 : NPR;
    auto la = [=](int r) -> unsigned {
      if (prompt) {
        int tp = tbase + r;
        if (tp < 0 || tp >= 4096) return (unsigned)NTOK * 1024u;
        return (unsigned)(rbase + tp) * 1024u;
      }
      return (unsigned)(rbase + r) * 1024u;
    };
    auto lb = [=](int nl) -> unsigned {
      int nrow = nl < 64 ? n0 + nl : 2816 + n0 + nl - 64;
      return (unsigned)nrow * 1024u;
    };
    auto epi = [&](int h, const float* sC) {
      const int cg = threadIdx.x & 15, r0 = threadIdx.x >> 4;
      const int col = n0 + 4 * cg;
      const float4 w0 = *reinterpret_cast<const float4*>(cw + col);
      const float4 w1 = *reinterpret_cast<const float4*>(cw + 2816 + col);
      const float4 w2 = *reinterpret_cast<const float4*>(cw + 2 * 2816 + col);
      const float4 bb = *reinterpret_cast<const float4*>(cb + col);
#pragma unroll 1
      for (int i = 0; i < 8; ++i) {
        const int v = r0 + 16 * i;
        const int r = 128 * (v >> 6) + 64 * h + (v & 63);
        const int sr = (v >> 6) * 66 + 2 + (v & 63);
        const float* c = sC + sr * LDG + 4 * cg;
        float4 a0 = *reinterpret_cast<const float4*>(c);
        float4 bv = *reinterpret_cast<const float4*>(c + 64);
        float4 a1 = *reinterpret_cast<const float4*>(c - LDG);
        float4 a2 = *reinterpret_cast<const float4*>(c - 2 * LDG);
        size_t orow;
        bool doit;
        if (prompt) {
          int tp = tbase + r;
          doit = (r >= 2 && tp < 4096);
          orow = (size_t)(rbase + tp);
          if (doit && tp >= 4094)
            *reinterpret_cast<float4*>(p.out + O_CONV_P + ((size_t)(layer * 4 + s) * 2 + (tp - 4094)) * 2816 + col) = a0;
        } else {
          doit = true;
          int b = r >> 5, t = r & 31;
          const float* cc = p.cache_conv + ((size_t)(layer * 8 + b) * 2) * 2816 + col;
          if (t < 1) a1 = *reinterpret_cast<const float4*>(cc + 2816);
          if (t < 2) a2 = *reinterpret_cast<const float4*>(cc + (size_t)t * 2816);
          orow = (size_t)(rbase + r);
          if (t >= 30) *reinterpret_cast<float4*>(p.out + O_CONV_S + ((size_t)(layer * 8 + b) * 2 + (t - 30)) * 2816 + col) = a0;
        }
        if (doit) {
          float c0 = bb.x + w0.x * a2.x + w1.x * a1.x + w2.x * a0.x;
          float c1v = bb.y + w0.y * a2.y + w1.y * a1.y + w2.y * a0.y;
          float c2v = bb.z + w0.z * a2.z + w1.z * a1.z + w2.z * a0.z;
          float c3v = bb.w + w0.w * a2.w + w1.w * a1.w + w2.w * a0.w;
          uint2 o;
          o.x = pack2(gelu_tanh(c0) * bv.x, gelu_tanh(c1v) * bv.y);
          o.y = pack2(gelu_tanh(c2v) * bv.z, gelu_tanh(c3v) * bv.w);
          *reinterpret_cast<uint2*>(GT + orow * 2816 + col) = o;
        }
      }
    };
    gemm256g<true>(HN, W, la, lb, epi, 32, smem);
  }
}

__device__ __forceinline__ void phase_resid_gemm(const Params& p, const u16* A, const u16* W, int K, char* smem) {
  {
    const int nsplit = K / 256;
    for (int job = blockIdx.x; job < 16 * nsplit; job += gridDim.x) {
      int sp = job / 16, tl = job % 16;
      int mt = 128 + (tl >> 3), nt = tl & 7;
      auto la = [=](int r, int k) -> uint4 { return ld16(A + (size_t)(mt * 128 + r) * K + k); };
      auto lb = [=](int nl, int k) -> uint4 { return ld16(W + (size_t)(nt * 128 + nl) * K + k); };
      KOff ko; ko.base = sp * 256;
      gemm_core(la, lb, ko, 4, smem);
      const float* sC = reinterpret_cast<const float*>(smem);
      float* xb = p.out + (size_t)(mt * 128) * 1024 + nt * 128;
      for (int idx = threadIdx.x; idx < 128 * 128; idx += 256) {
        int r = idx >> 7, n = idx & 127;
        unsafeAtomicAdd(xb + (size_t)r * 1024 + n, sC[r * LDC + n]);
      }
    }
  }
  for (TileSched ts(64 * 8); ts.i < ts.end; ts.i += ts.step) {
    int mt, nt;
    tile_decode(ts.i, 64, 8, mt, nt);
    auto la = [=](int r) -> unsigned { return (unsigned)(mt * 256 + r) * (unsigned)K; };
    auto lb = [=](int nl) -> unsigned { return (unsigned)(nt * 128 + nl) * (unsigned)K; };
    auto epi = [&](int h, const float* sC) { resid_epi<true>(p, sC, mt * 256, h, nt * 128); };
    gemm256g<false>(A, W, la, lb, epi, K / 32, smem);
  }
}

__device__ __forceinline__ void rope16(float* v, int pos) {
  const float inv[8] = {1.000000000e+00f, 1.939227432e-01f, 3.760603070e-02f, 7.292664610e-03f,
                        1.414213562e-03f, 2.742481884e-04f, 5.318296098e-05f, 1.031338616e-05f};
  float fp = (float)pos;
#pragma unroll
  for (int i = 0; i < 8; ++i) {
    float ang = fp * inv[i];
    float sn, cs;
    sincosf(ang, &sn, &cs);
    float x1 = v[i], x2 = v[8 + i];
    v[i] = x1 * cs - x2 * sn;
    v[8 + i] = x2 * cs + x1 * sn;
  }
}

__device__ __forceinline__ void store64_bf16(u16* dst, const float* v) {
#pragma unroll
  for (int i = 0; i < 8; ++i) {
    uint4 o = make_uint4(pack2(v[8 * i], v[8 * i + 1]), pack2(v[8 * i + 2], v[8 * i + 3]),
                         pack2(v[8 * i + 4], v[8 * i + 5]), pack2(v[8 * i + 6], v[8 * i + 7]));
    *reinterpret_cast<uint4*>(dst + 8 * i) = o;
  }
}
__device__ __forceinline__ void store64_f32(float* dst, const float* v) {
#pragma unroll
  for (int i = 0; i < 16; ++i) *reinterpret_cast<float4*>(dst + 4 * i) = make_float4(v[4 * i], v[4 * i + 1], v[4 * i + 2], v[4 * i + 3]);
}

__device__ __forceinline__ void phase_win(const Params& p, char* smem) {
  const u16* HN = reinterpret_cast<const u16*>(p.ws + R_HN);
  const u16* W = reinterpret_cast<const u16*>(p.ws + W_IN);
  u16* QB = reinterpret_cast<u16*>(p.ws + R_QB);
  u16* KB = reinterpret_cast<u16*>(p.ws + R_KB);
  u16* VB = reinterpret_cast<u16*>(p.ws + R_VB);
  u16* QI = reinterpret_cast<u16*>(p.ws + R_QI);
  u16* KI = reinterpret_cast<u16*>(p.ws + R_KI);
  float* WI = reinterpret_cast<float*>(p.ws + R_WI);
  for (TileSched ts(130 * 17); ts.i < ts.end; ts.i += ts.step) {
    int mt, nt;
    tile_decode(ts.i, 130, 17, mt, nt);
    auto la = [=](int r, int k) -> uint4 { return ld16(HN + (size_t)(mt * 128 + r) * 1024 + k); };
    auto lb = [=](int nl, int k) -> uint4 { return ld16(W + (size_t)(nt * 128 + nl) * 1024 + k); };
    gemm_core(la, lb, KIdent(), 16, smem);
    const float* sC = reinterpret_cast<const float*>(smem);
    int r = threadIdx.x & 127, h = threadIdx.x >> 7;
    int cbase = nt * 128 + 64 * h;
    int row = mt * 128 + r;
    int pos, kvrow;
    if (row < NPR) { pos = row & 4095; kvrow = row; }
    else { int bs = (row - NPR) >> 5, t = (row - NPR) & 31; pos = 4096 + t; kvrow = NPR + bs * 4128 + 4096 + t; }
    if (cbase < 2112) {
      float v[64];
#pragma unroll
      for (int d = 0; d < 64; ++d) v[d] = sC[r * LDC + 64 * h + d];
      if (cbase < 1280) {
        float ss = 0.f;
#pragma unroll
        for (int d = 0; d < 64; ++d) ss += v[d] * v[d];
        float rs = rsqrtf(ss * (1.f / 64.f) + 1e-6f);
        const float* gw = cbase < 1024 ? p.q_norm : p.k_norm;
#pragma unroll
        for (int d = 0; d < 64; ++d) v[d] = v[d] * rs * gw[d];
      }
      if (cbase < 1280 || cbase >= 1536) rope16(v, pos);
      if (cbase < 1024) {
        store64_bf16(QB + (size_t)row * 1024 + cbase, v);
      } else if (cbase < 1280) {
        store64_bf16(KB + (size_t)kvrow * 256 + (cbase - 1024), v);
        float* o = row < NPR ? p.out + O_K_P + (size_t)row * 256 : p.out + O_K_S + (size_t)(row - NPR) * 256;
        store64_f32(o + (cbase - 1024), v);
      } else if (cbase < 1536) {
        store64_bf16(VB + (size_t)kvrow * 256 + (cbase - 1280), v);
        float* o = row < NPR ? p.out + O_V_P + (size_t)row * 256 : p.out + O_V_S + (size_t)(row - NPR) * 256;
        store64_f32(o + (cbase - 1280), v);
      } else if (cbase < 2048) {
        store64_bf16(QI + (size_t)row * 512 + (cbase - 1536), v);
      } else {
#pragma unroll
        for (int kc = 0; kc < 8; ++kc) {
          uint4 o = make_uint4(pack2(v[8 * kc], v[8 * kc + 1]), pack2(v[8 * kc + 2], v[8 * kc + 3]),
                               pack2(v[8 * kc + 4], v[8 * kc + 5]), pack2(v[8 * kc + 6], v[8 * kc + 7]));
          *reinterpret_cast<uint4*>(KI + ki_off(kvrow, kc)) = o;
        }
        float* o = row < NPR ? p.out + O_KI_P + (size_t)row * 64 : p.out + O_KI_S + (size_t)(row - NPR) * 64;
        store64_f32(o, v);
      }
    } else if (cbase == 2112) {
      float w[8];
#pragma unroll
      for (int d = 0; d < 8; ++d) w[d] = sC[r * LDC + 64 * h + d];
      *reinterpret_cast<float4*>(WI + (size_t)row * 8) = make_float4(w[0], w[1], w[2], w[3]);
      *reinterpret_cast<float4*>(WI + (size_t)row * 8 + 4) = make_float4(w[4], w[5], w[6], w[7]);
    }
  }
}

__device__ __forceinline__ unsigned f2key(float f) {
  unsigned u = __float_as_uint(f);
  return (u & 0x80000000u) ? ~u : (u | 0x80000000u);
}

__device__ __forceinline__ void phase_index(const Params& p, char* smem) {
  const u16* QI = reinterpret_cast<const u16*>(p.ws + R_QI);
  const u16* KI = reinterpret_cast<const u16*>(p.ws + R_KI);
  const float* WI = reinterpret_cast<const float*>(p.ws + R_WI);
  u16* SEL = reinterpret_cast<u16*>(p.ws + R_SEL);
  int* CNT = reinterpret_cast<int*>(p.ws + R_CNT);
  float* sc = reinterpret_cast<float*>(smem);
  unsigned* histall = reinterpret_cast<unsigned*>(smem + 66048);
  const int tid = threadIdx.x, lane = tid & 63, wave = tid >> 6;
  for (int item = blockIdx.x; item < 64 + 4096; item += gridDim.x) {
    int tok0, nk, seqbase;
    if (item < 64) {
      tok0 = NPR + item * 4;
      nk = 4128;
      seqbase = NPR + (item >> 3) * 4128;
    } else {
      int it = item - 64;
      int c = 63 - (it >> 6);
      int b = (it & 63) >> 4, q4 = it & 15;
      tok0 = b * 4096 + c * 64 + q4 * 4;
      nk = 64 * (c + 1);
      seqbase = b * 4096;
    }
    __syncthreads();
    if (nk > 256) {
      bf16x8 af[4];
      {
        int q = (lane & 31) >> 3, h = lane & 7;
        const u16* src = QI + (size_t)(tok0 + q) * 512 + h * 64 + 8 * (lane >> 5);
#pragma unroll
        for (int kk = 0; kk < 4; ++kk) {
          uint4 t = ld16(src + kk * 16);
          af[kk] = *reinterpret_cast<bf16x8*>(&t);
        }
      }
      float wsc[16];
#pragma unroll
      for (int q = 0; q < 4; ++q) {
        float4 t = *reinterpret_cast<const float4*>(WI + (size_t)(tok0 + q) * 8 + 4 * (lane >> 5));
        const float s = 0.125f * 0.35355339059327373f;
        wsc[4 * q] = t.x * s; wsc[4 * q + 1] = t.y * s; wsc[4 * q + 2] = t.z * s; wsc[4 * q + 3] = t.w * s;
      }
      int ntile = nk >> 5;
      const u16* kbase = KI + (size_t)seqbase * 64;
      for (int t0 = wave; t0 < ntile; t0 += 32) {
        uint4 kb[8][4];
#pragma unroll
        for (int j = 0; j < 8; ++j) {
          int tile = t0 + 4 * j;
          if (tile < ntile) {
            const u16* kr = kbase + ((size_t)(tile * 8 + (lane >> 5)) * 32 + (lane & 31)) * 8;
#pragma unroll
            for (int kk = 0; kk < 4; ++kk) kb[j][kk] = ld16(kr + kk * 2 * 256);
          }
        }
        __builtin_amdgcn_sched_barrier(0);
#pragma unroll
        for (int j = 0; j < 8; ++j) {
          int tile = t0 + 4 * j;
          if (tile < ntile) {
            f32x16 acc;
#pragma unroll
            for (int r = 0; r < 16; ++r) acc[r] = 0.f;
#pragma unroll
            for (int kk = 0; kk < 4; ++kk)
              acc = __builtin_amdgcn_mfma_f32_32x32x16_bf16(af[kk], *reinterpret_cast<bf16x8*>(&kb[j][kk]), acc, 0, 0, 0);
            float sq[4];
#pragma unroll
            for (int q = 0; q < 4; ++q) {
              float sv = 0.f;
#pragma unroll
              for (int rr = 0; rr < 4; ++rr) sv += fmaxf(acc[4 * q + rr], 0.f) * wsc[4 * q + rr];
              sv = xsum32(sv);
              sq[q] = sv;
            }
            if (lane < 32) {
#pragma unroll
              for (int q = 0; q < 4; ++q) sc[q * SC_LD + tile * 32 + lane] = sq[q];
            }
          }
        }
      }
    }
    __syncthreads();
    {
      int token = tok0 + wave;
      u16* sel = SEL + (size_t)token * 256;
      if (nk <= 256) {
        for (int i = lane; i < 256; i += 64) sel[i] = (u16)(i < nk ? i : 0);
        if (lane == 0) CNT[token] = nk;
      } else {
        const float* s = sc + wave * SC_LD;
        unsigned* hist = histall + wave * 256;
        unsigned prefix = 0, mask = 0;
        unsigned need = 256;
        for (int shift = 24; shift >= 0; shift -= 8) {
          for (int i = lane; i < 256; i += 64) hist[i] = 0;
          __builtin_amdgcn_s_waitcnt(0xc07f);
          for (int e0 = lane * 4; e0 < nk; e0 += 256) {
            float4 v4 = *reinterpret_cast<const float4*>(s + e0);
            unsigned u0 = f2key(v4.x), u1 = f2key(v4.y), u2 = f2key(v4.z), u3 = f2key(v4.w);
            if ((u0 & mask) == prefix) atomicAdd(&hist[(u0 >> shift) & 255u], 1u);
            if ((u1 & mask) == prefix) atomicAdd(&hist[(u1 >> shift) & 255u], 1u);
            if ((u2 & mask) == prefix) atomicAdd(&hist[(u2 >> shift) & 255u], 1u);
            if ((u3 & mask) == prefix) atomicAdd(&hist[(u3 >> shift) & 255u], 1u);
          }
          __builtin_amdgcn_s_waitcnt(0xc07f);
          __builtin_amdgcn_wave_barrier();
          unsigned h0 = hist[4 * lane], h1 = hist[4 * lane + 1], h2 = hist[4 * lane + 2], h3 = hist[4 * lane + 3];
          unsigned loc = h0 + h1 + h2 + h3;
          unsigned suf = loc;
#pragma unroll
          for (int d = 1; d < 64; d <<= 1) {
            unsigned t = __shfl_down(suf, d);
            if (lane + d < 64) suf += t;
          }
          unsigned above = suf - loc;
          bool cross = (above < need) && (need <= above + loc);
          unsigned long long bal = __ballot(cross);
          int src = __ffsll((long long)bal) - 1;
          unsigned binsel = 0, newneed = 0;
          if (cross) {
            unsigned cum = above;
            if (cum + h3 >= need) { binsel = 4 * lane + 3; newneed = need - cum; }
            else {
              cum += h3;
              if (cum + h2 >= need) { binsel = 4 * lane + 2; newneed = need - cum; }
              else {
                cum += h2;
                if (cum + h1 >= need) { binsel = 4 * lane + 1; newneed = need - cum; }
                else { cum += h1; binsel = 4 * lane; newneed = need - cum; }
              }
            }
          }
          binsel = __shfl(binsel, src);
          newneed = __shfl(newneed, src);
          prefix |= binsel << shift;
          mask |= 255u << shift;
          need = newneed;
          __builtin_amdgcn_wave_barrier();
        }
        const unsigned T = prefix;
        const unsigned long long lt = (1ull << lane) - 1ull;
        int base = 0, eqtaken = 0;
        for (int i0 = 0; i0 < nk; i0 += 256) {
          int e0 = i0 + lane * 4;
          bool in = e0 < nk;
          float4 v4 = in ? *reinterpret_cast<const float4*>(s + e0) : make_float4(0.f, 0.f, 0.f, 0.f);
          unsigned u[4] = {f2key(v4.x), f2key(v4.y), f2key(v4.z), f2key(v4.w)};
          bool eq[4], gt[4];
          int eqbefore = 0;
#pragma unroll
          for (int j = 0; j < 4; ++j) {
            gt[j] = in && (u[j] > T);
            eq[j] = in && (u[j] == T);
          }
          unsigned long long be[4];
          int eqtot = 0;
#pragma unroll
          for (int j = 0; j < 4; ++j) {
            be[j] = __ballot(eq[j]);
            eqbefore += __popcll(be[j] & lt);
            eqtot += __popcll(be[j]);
          }
          bool take[4];
          int mine_eq = 0;
#pragma unroll
          for (int j = 0; j < 4; ++j) {
            int eqrank = eqtaken + eqbefore + mine_eq;
            take[j] = gt[j] || (eq[j] && eqrank < (int)need);
            mine_eq += eq[j] ? 1 : 0;
          }
          int tkbefore = 0, tktot = 0;
#pragma unroll
          for (int j = 0; j < 4; ++j) {
            unsigned long long bt = __ballot(take[j]);
            tkbefore += __popcll(bt & lt);
            tktot += __popcll(bt);
          }
          int pos = base + tkbefore;
#pragma unroll
          for (int j = 0; j < 4; ++j) {
            if (take[j]) {
              if (pos < 256) sel[pos] = (u16)(e0 + j);
              ++pos;
            }
          }
          base += tktot;
          eqtaken += eqtot;
        }
        if (lane == 0) CNT[token] = 256;
      }
    }
  }
}

__device__ __forceinline__ void load_v_round(const u16* __restrict__ VB, const int* sidx, int rd, int kvh, int lane, uint4 (&vv)[8]) {
#pragma unroll
  for (int i = 0; i < 8; ++i) {
    int pid = lane + 64 * i;
    int rowl = pid >> 3, piece = pid & 7;
    int row = sidx[64 * rd + rowl];
    unsigned off = (unsigned)row * 512u + (unsigned)(kvh * 128 + piece * 16);
    vv[i] = ld16(reinterpret_cast<const char*>(VB) + off);
  }
}

template <int RD>
__device__ __forceinline__ void pv_round(const u16* __restrict__ VB, const int* sidx, int kvh, int lane, u16* Vs,
                                         uint4 (&vv)[8], f32x4 (&sacc)[16], float inv, f32x4 (&oacc)[4]) {
  const int g = lane >> 4, n = lane & 15;
  uint4 vn[8];
  if (RD < 3) load_v_round(VB, sidx, RD + 1, kvh, lane, vn);
  __builtin_amdgcn_sched_barrier(0);
  __builtin_amdgcn_wave_barrier();
#pragma unroll
  for (int i = 0; i < 8; ++i) {
    int pid = lane + 64 * i;
    int rowl = pid >> 3, piece = pid & 7;
    *reinterpret_cast<uint4*>(&Vs[rowl * LDSK + piece * 8]) = vv[i];
  }
  __builtin_amdgcn_s_waitcnt(0xc07f);
  __builtin_amdgcn_wave_barrier();
#pragma unroll
  for (int ch = 0; ch < 2; ++ch) {
    constexpr int tb = 4 * RD;
    const int t0 = tb + 2 * ch;
    uint4 pa;
    pa.x = pack2(sacc[t0][0] * inv, sacc[t0][1] * inv);
    pa.y = pack2(sacc[t0][2] * inv, sacc[t0][3] * inv);
    pa.z = pack2(sacc[t0 + 1][0] * inv, sacc[t0 + 1][1] * inv);
    pa.w = pack2(sacc[t0 + 1][2] * inv, sacc[t0 + 1][3] * inv);
    bf16x8 afrag = *reinterpret_cast<bf16x8*>(&pa);
    int qq = n >> 2, pp = n & 3;
    int lr0 = 32 * ch + 4 * g + qq;
#pragma unroll
    for (int nt = 0; nt < 4; ++nt) {
      typedef __attribute__((address_space(3))) s16x4* lds_s4p;
      s16x4 r0 = __builtin_amdgcn_ds_read_tr16_b64_v4i16((lds_s4p)(&Vs[lr0 * LDSK + 16 * nt + 4 * pp]));
      s16x4 r1 = __builtin_amdgcn_ds_read_tr16_b64_v4i16((lds_s4p)(&Vs[(lr0 + 16) * LDSK + 16 * nt + 4 * pp]));
      uint4 bw;
      bw.x = (unsigned)(u16)r0[0] | ((unsigned)(u16)r0[1] << 16);
      bw.y = (unsigned)(u16)r0[2] | ((unsigned)(u16)r0[3] << 16);
      bw.z = (unsigned)(u16)r1[0] | ((unsigned)(u16)r1[1] << 16);
      bw.w = (unsigned)(u16)r1[2] | ((unsigned)(u16)r1[3] << 16);
      oacc[nt] = __builtin_amdgcn_mfma_f32_16x16x32_bf16(afrag, *reinterpret_cast<bf16x8*>(&bw), oacc[nt], 0, 0, 0);
    }
  }
  __builtin_amdgcn_wave_barrier();
  __builtin_amdgcn_sched_barrier(0);
  if (RD < 3) {
#pragma unroll
    for (int i = 0; i < 8; ++i) vv[i] = vn[i];
  }
}

__device__ __forceinline__ void phase_attn(const Params& p, char* smem) {
  const u16* QB = reinterpret_cast<const u16*>(p.ws + R_QB);
  const u16* KB = reinterpret_cast<const u16*>(p.ws + R_KB);
  const u16* VB = reinterpret_cast<const u16*>(p.ws + R_VB);
  const u16* SEL = reinterpret_cast<const u16*>(p.ws + R_SEL);
  const int* CNT = reinterpret_cast<const int*>(p.ws + R_CNT);
  u16* OB = reinterpret_cast<u16*>(p.ws + R_OB);
  const int tid = threadIdx.x, lane = tid & 63, wave = tid >> 6;
  const int g = lane >> 4, n = lane & 15;
  u16* Vs = reinterpret_cast<u16*>(smem) + wave * (64 * LDSK);
  int* sidx2 = reinterpret_cast<int*>(smem + 4 * 64 * LDSK * 2);
  const int kvh = wave;
  auto seqbase_of = [](int token) -> int {
    return token < NPR ? (token >> 12) * 4096 : NPR + ((token - NPR) >> 5) * 4128;
  };
  const int xq = blockIdx.x & 7, lbq = blockIdx.x >> 3, nlq = gridDim.x >> 3;
  auto token_of = [=](int it) -> int {
    return it < 32 ? NPR + xq * 32 + it : (xq >> 1) * 4096 + 2 * (it - 32) + (xq & 1);
  };
  int cur = 0, cnt_cur = 0;
  __syncthreads();
  if (lbq < 2080) {
    int t0 = token_of(lbq);
    cnt_cur = CNT[t0];
    sidx2[tid] = seqbase_of(t0) + (int)SEL[(size_t)t0 * 256 + tid];
  }
  __syncthreads();
  for (int it = lbq; it < 2080; it += nlq) {
    const int token = token_of(it);
    const int* sidx = sidx2 + cur * 256;
    const int cnt = cnt_cur;
    const int itn = it + nlq;
    const int tnext = itn < 2080 ? token_of(itn) : -1;
    int nsel = 0, ncnt = 0;
    if (tnext >= 0) {
      nsel = (int)SEL[(size_t)tnext * 256 + tid];
      ncnt = CNT[tnext];
    }
    bf16x8 qf[2];
    {
      uint4 t0 = zero4(), t1 = zero4();
      if (n < 4) {
        const u16* q = QB + (size_t)token * 1024 + (kvh * 4 + n) * 64 + 8 * g;
        t0 = ld16(q);
        t1 = ld16(q + 32);
      }
      qf[0] = *reinterpret_cast<bf16x8*>(&t0);
      qf[1] = *reinterpret_cast<bf16x8*>(&t1);
    }
    f32x4 sacc[16];
#pragma unroll
    for (int hb = 0; hb < 2; ++hb) {
      uint4 ka[8][2];
#pragma unroll
      for (int t = 0; t < 8; ++t) {
        int row = sidx[16 * (hb * 8 + t) + n];
        unsigned off = (unsigned)row * 512u + (unsigned)(kvh * 128 + 16 * g);
        ka[t][0] = ld16(reinterpret_cast<const char*>(KB) + off);
        ka[t][1] = ld16(reinterpret_cast<const char*>(KB) + off + 64u);
      }
      __builtin_amdgcn_sched_barrier(0);
#pragma unroll
      for (int t = 0; t < 8; ++t) {
        f32x4 acc = {0.f, 0.f, 0.f, 0.f};
        acc = __builtin_amdgcn_mfma_f32_16x16x32_bf16(*reinterpret_cast<bf16x8*>(&ka[t][0]), qf[0], acc, 0, 0, 0);
        acc = __builtin_amdgcn_mfma_f32_16x16x32_bf16(*reinterpret_cast<bf16x8*>(&ka[t][1]), qf[1], acc, 0, 0, 0);
        sacc[hb * 8 + t] = acc;
      }
      __builtin_amdgcn_sched_barrier(0);
    }
    uint4 vv[8];
    load_v_round(VB, sidx, 0, kvh, lane, vv);
    __builtin_amdgcn_sched_barrier(0);
    float m = -3.0e38f;
    if (cnt < 256) {
#pragma unroll
      for (int t = 0; t < 16; ++t)
#pragma unroll
        for (int r = 0; r < 4; ++r) {
          int slot = 16 * t + 4 * g + r;
          if (slot >= cnt) sacc[t][r] = -3.0e38f;
        }
    }
#pragma unroll
    for (int t = 0; t < 16; ++t)
#pragma unroll
      for (int r = 0; r < 4; ++r) m = fmaxf(m, sacc[t][r]);
    m = fmaxf(m, __shfl_xor(m, 16));
    m = xmax32(m);
    const float cexp = 0.125f * 1.4426950408889634f;
    const float mc = -m * cexp;
    float sum = 0.f;
#pragma unroll
    for (int t = 0; t < 16; ++t)
#pragma unroll
      for (int r = 0; r < 4; ++r) {
        float e = __builtin_amdgcn_exp2f(fmaf(sacc[t][r], cexp, mc));
        sacc[t][r] = e;
        sum += e;
      }
    sum += __shfl_xor(sum, 16);
    sum = xsum32(sum);
    const float inv = 1.f / sum;
    f32x4 oacc[4];
#pragma unroll
    for (int nt = 0; nt < 4; ++nt) oacc[nt] = (f32x4){0.f, 0.f, 0.f, 0.f};
    pv_round<0>(VB, sidx, kvh, lane, Vs, vv, sacc, 1.f, oacc);
    pv_round<1>(VB, sidx, kvh, lane, Vs, vv, sacc, 1.f, oacc);
    pv_round<2>(VB, sidx, kvh, lane, Vs, vv, sacc, 1.f, oacc);
    pv_round<3>(VB, sidx, kvh, lane, Vs, vv, sacc, 1.f, oacc);
    {
      float i0 = __shfl(inv, 0), i1 = __shfl(inv, 1), i2 = __shfl(inv, 2), i3 = __shfl(inv, 3);
#pragma unroll
      for (int nt = 0; nt < 4; ++nt) {
        oacc[nt][0] *= i0; oacc[nt][1] *= i1; oacc[nt][2] *= i2; oacc[nt][3] *= i3;
      }
    }
    if (lane < 16) {
#pragma unroll
      for (int nt = 0; nt < 4; ++nt)
#pragma unroll
        for (int r = 0; r < 4; ++r)
          OB[(size_t)token * 1024 + (kvh * 4 + r) * 64 + 16 * nt + lane] = f2bf(oacc[nt][r]);
    }
    if (tnext >= 0) sidx2[(cur ^ 1) * 256 + tid] = seqbase_of(tnext) + nsel;
    cnt_cur = ncnt;
    cur ^= 1;
    __syncthreads();
  }
}


#define XB_TMO      128
#define XB_XCNT(j)  (256  + 64 * (j))
#define XB_XSUB(j)  (1280 + 64 * (j))
#define XB_XGEN(j)  (2304 + 64 * (j))
#define XB_TOP      3328
#define XB_TOPGEN   3392
#define XCD_BAR_WORDS 3456
#define XB_SPIN_CAP (1u << 18)
#define LAS __attribute__((address_space(3)))

__device__ __forceinline__ unsigned xb_ld(unsigned* p) { return __hip_atomic_load(p, __ATOMIC_RELAXED, __HIP_MEMORY_SCOPE_AGENT); }
__device__ __forceinline__ unsigned xb_add(unsigned* p, unsigned v) { return __hip_atomic_fetch_add(p, v, __ATOMIC_RELAXED, __HIP_MEMORY_SCOPE_AGENT); }
__device__ __forceinline__ unsigned xb_xcc_id() { return (unsigned)__builtin_amdgcn_s_getreg((3 << 11) | 20) & 0xFu; }
#define XB_SPIN(cond, bar) do { unsigned _sp = 0; while (cond) { __builtin_amdgcn_s_sleep(1); \
    if ((++_sp & 255u) == 0u) { if (xb_ld(&(bar)[XB_TMO])) break; if (_sp > XB_SPIN_CAP) { atomicAdd(&(bar)[XB_TMO], 1u); break; } } } } while (0)

struct XcdBarrier {
  unsigned* bar; unsigned x;
  volatile LAS unsigned* st;
};
__device__ __forceinline__ XcdBarrier xcd_barrier_post(unsigned* bar, volatile LAS unsigned* st) {
  XcdBarrier b; b.bar = bar; b.x = xb_xcc_id(); b.st = st;
  if (threadIdx.x == 0) (void)xb_add(&bar[XB_XCNT(b.x)], 1u);
  return b;
}
__device__ __forceinline__ void xcd_barrier_complete(unsigned* bar, unsigned x, unsigned& nloc, unsigned& nx) {
  const unsigned G = gridDim.x * gridDim.y * gridDim.z;
  unsigned sum, cnt, mine, sp = 0u;
  for (;;) {
    sum = 0u; cnt = 0u; mine = 0u;
#pragma unroll
    for (unsigned j = 0; j < 16; ++j) { const unsigned c = xb_ld(&bar[XB_XCNT(j)]); sum += c; cnt += (c > 0u) ? 1u : 0u; mine = (j == x) ? c : mine; }
    if (sum == G) break;
    __builtin_amdgcn_s_sleep(1);
    if ((++sp & 255u) == 0u) { if (xb_ld(&bar[XB_TMO])) break; if (sp > XB_SPIN_CAP) { atomicAdd(&bar[XB_TMO], 1u); break; } }
  }
  nloc = mine > 0u ? mine : 1u; nx = cnt > 0u ? cnt : 1u;
}
__device__ __forceinline__ void xcd_barrier(const XcdBarrier& b) {
  asm volatile("s_waitcnt vmcnt(0)" ::: "memory");
  __syncthreads();
  if (threadIdx.x == 0) {
    unsigned* bar = b.bar;
    __builtin_amdgcn_s_waitcnt(0);
    unsigned nloc = b.st[0], nx = b.st[1];
    if (nloc == 0u) { xcd_barrier_complete(bar, b.x, nloc, nx); b.st[0] = nloc; b.st[1] = nx; }
    const unsigned old = xb_add(&bar[XB_XSUB(b.x)], 1u);
    const unsigned gen = old / nloc;
    if (old + 1u == (gen + 1u) * nloc) {
      __builtin_amdgcn_fence(__ATOMIC_RELEASE, "agent");
      asm volatile("s_waitcnt vmcnt(0)" ::: "memory");
      const unsigned og = xb_add(&bar[XB_TOP], 1u);
      const unsigned tg = og / nx;
      if (og + 1u == (tg + 1u) * nx) xb_add(&bar[XB_TOPGEN], 1u);
      else XB_SPIN(xb_ld(&bar[XB_TOPGEN]) == tg, bar);
      __builtin_amdgcn_fence(__ATOMIC_ACQUIRE, "agent");
      xb_add(&bar[XB_XGEN(b.x)], 1u);
      asm volatile("s_waitcnt vmcnt(0)" ::: "memory");
    } else {
      XB_SPIN(xb_ld(&bar[XB_XGEN(b.x)]) == gen, bar);
      __builtin_amdgcn_fence(__ATOMIC_ACQUIRE, "agent");
      asm volatile("s_waitcnt vmcnt(0)" ::: "memory");
    }
  }
  __syncthreads();
}

__global__ void __launch_bounds__(256, 2) mega(Params p) {
  __shared__ __attribute__((aligned(16))) char smem[SMEM_BYTES];
  __shared__ uint4 xb_words;
  if (threadIdx.x == 0) xb_words = make_uint4(0u, 0u, 0u, 0u);
  __syncthreads();
  XcdBarrier xb = xcd_barrier_post(reinterpret_cast<unsigned*>(p.ws + R_BAR), (volatile LAS unsigned*)&xb_words);
  if (p.use_cg) cg::this_grid().sync();
  phase0(p, smem);
  xcd_barrier(xb);
  phase1(p, smem);
  xcd_barrier(xb);
  phase2(p);
  xcd_barrier(xb);
  phase3(p, smem);
  xcd_barrier(xb);
  phase4(p, smem);
  xcd_barrier(xb);
  phase_norm(p, p.norm_ffn, false);
  xcd_barrier(xb);
  phase_up(p, 0, smem);
  xcd_barrier(xb);
  phase_resid_gemm(p, (const u16*)(p.ws + R_GT), (const u16*)(p.ws + W_DN), 2816, smem);
  xcd_barrier(xb);
  phase_norm(p, p.norm_mix + 1024, true);
  xcd_barrier(xb);
  phase_win(p, smem);
  xcd_barrier(xb);
  phase_index(p, smem);
  xcd_barrier(xb);
  phase_attn(p, smem);
  xcd_barrier(xb);
  phase_resid_gemm(p, (const u16*)(p.ws + R_OB), (const u16*)(p.ws + W_O), 1024, smem);
  xcd_barrier(xb);
  phase_norm(p, p.norm_ffn + 1024, false);
  xcd_barrier(xb);
  phase_up(p, 1, smem);
  xcd_barrier(xb);
  phase_resid_gemm(p, (const u16*)(p.ws + R_GT), (const u16*)(p.ws + W_DN) + (size_t)1024 * 2816, 2816, smem);
}

extern "C" void kernel_launch(void* const* d_in, const int* in_sizes, int n_in, void* d_out, int out_size, void* d_ws,
                              size_t ws_size, hipStream_t stream) {
  static int grid_blocks = 0;
  if (!grid_blocks) {
    int dev = 0, cus = 0, per_cu = 0;
    hipGetDevice(&dev);
    hipDeviceGetAttribute(&cus, hipDeviceAttributeMultiprocessorCount, dev);
    hipOccupancyMaxActiveBlocksPerMultiprocessor(&per_cu, mega, 256, 0);
    if (per_cu > 2) per_cu = 2;
    if (per_cu < 1) per_cu = 1;
    grid_blocks = cus * per_cu;
  }
  Params p{};
  const float** pf = reinterpret_cast<const float**>(&p);
  for (int i = 0; i < 28; ++i) pf[i] = reinterpret_cast<const float*>(d_in[i]);
  p.out = reinterpret_cast<float*>(d_out);
  p.ws = reinterpret_cast<char*>(d_ws);
  if (ws_size < WS_NEED) fprintf(stderr, "workspace too small: %zu < %zu\n", ws_size, (size_t)WS_NEED);
  p.use_cg = 0;
  p.pad0 = 0;
  hipMemsetAsync(reinterpret_cast<char*>(d_ws) + R_BAR, 0, 16384 + 4096, stream);
  void* args[] = {&p};
  hipError_t e = hipLaunchCooperativeKernel((void*)mega, dim3(grid_blocks), dim3(256), args, 0, stream);
  if (e != hipSuccess) fprintf(stderr, "cooperative launch failed: %s (grid %d)\n", hipGetErrorString(e), grid_blocks);
}
```

```cpp
#include <hip/hip_runtime.h>
#include <hip/hip_cooperative_groups.h>
#include <stdint.h>
#include <cstdio>
namespace cg = cooperative_groups;

typedef unsigned short u16;
typedef __attribute__((ext_vector_type(8))) __bf16 bf16x8;
typedef __attribute__((ext_vector_type(4))) short s16x4;
typedef __attribute__((ext_vector_type(16))) float f32x16;
typedef __attribute__((ext_vector_type(4))) float f32x4;

#define NTOK 16640
#define NPR 16384
#define LDSK 72
#define LDV 80
#define LDC 129
#define LDG 132
#define SC_LD 4128
#define SMEM_BYTES (73728)

#define O_SSM_RE_P 17039360
#define O_SSM_IM_P 17055744
#define O_SSM_RE_S 17072128
#define O_SSM_IM_S 17104896
#define O_K_P 17137664
#define O_V_P 21331968
#define O_KI_P 25526272
#define O_K_S 26574848
#define O_V_S 26640384
#define O_KI_S 26705920
#define O_CONV_P 26722304
#define O_CONV_S 26767360

constexpr size_t MB = 1ull << 20;
constexpr size_t W_GLU = 0;
constexpr size_t W_IN = W_GLU + 2048ull * 1024 * 2;
constexpr size_t W_O = W_IN + 2176ull * 1024 * 2;
constexpr size_t W_UP = W_O + 1024ull * 1024 * 2;
constexpr size_t W_DN = W_UP + 2ull * 5632 * 1024 * 2;
constexpr size_t R0 = W_DN + 2ull * 1024 * 2816 * 2;
constexpr size_t R_UG = R0;
constexpr size_t R_Z = R0 + 35 * MB;
constexpr size_t R_S = R0 + 70 * MB;
constexpr size_t R_HP = R0 + 88 * MB;
constexpr size_t R_W1 = R0 + 97 * MB;
constexpr size_t R_W3 = R0 + 106 * MB;
constexpr size_t R_KT = R0 + 115 * MB;
constexpr size_t R_AP = R0 + 117 * MB;
constexpr size_t R_BB = R0 + 119 * MB;
constexpr size_t R_HN = R0;
constexpr size_t R_GT = R0 + 35 * MB;
constexpr size_t R_OB = R0;
constexpr size_t R_QB = R0 + 35 * MB;
constexpr size_t R_KB = R0 + 70 * MB;
constexpr size_t R_VB = R0 + 96 * MB;
constexpr size_t R_QI = R0 + 122 * MB;
constexpr size_t R_KI = R0 + 140 * MB;
constexpr size_t R_WI = R0 + 147 * MB;
constexpr size_t R_SEL = R0 + 148 * MB;
constexpr size_t R_CNT = R0 + 157 * MB;
constexpr size_t R_BAR = R0 + 158 * MB;
constexpr size_t R_ZERO = R_BAR + 16384;
constexpr size_t WS_NEED = R0 + 159 * MB;

struct Params {
  const float *x_prompt, *x_sample, *st_re, *st_im, *cache_k, *cache_v, *cache_kidx, *cache_conv;
  const float *norm_mix, *norm_ffn, *lam_re, *lam_im, *log_dt, *b_re, *b_im, *c_re, *c_im, *ssm_d, *w_glu, *b_glu;
  const float *w_in, *q_norm, *k_norm, *w_o, *w_up, *conv_w, *conv_b, *w_down;
  float* out;
  char* ws;
  int use_cg;
  int pad0;
};

typedef __attribute__((ext_vector_type(2))) __bf16 bf16x2_t;
__device__ __forceinline__ u16 f2bf(float f) {
  __bf16 h = (__bf16)f;
  return __builtin_bit_cast(u16, h);
}
__device__ __forceinline__ float bf2f(u16 h) { return __uint_as_float(((unsigned)h) << 16); }
__device__ __forceinline__ unsigned pack2(float a, float b) {
  bf16x2_t v;
  v[0] = (__bf16)a;
  v[1] = (__bf16)b;
  return __builtin_bit_cast(unsigned, v);
}
__device__ __forceinline__ float gelu_tanh(float x) {
  const float k2 = -2.f * 0.7978845608028654f * 1.4426950408889634f;
  float x2 = x * x;
  float w = x * fmaf(x2, 0.044715f, 1.f);
  float e = __builtin_amdgcn_exp2f(w * k2);
  return x * __builtin_amdgcn_rcpf(1.f + e);
}
__device__ __forceinline__ float sigmoid_fast(float x) {
  return __builtin_amdgcn_rcpf(1.f + __builtin_amdgcn_exp2f(x * -1.4426950408889634f));
}
__device__ __forceinline__ uint4 zero4() { return make_uint4(0u, 0u, 0u, 0u); }
__device__ __forceinline__ uint4 ld16(const void* p) { return *reinterpret_cast<const uint4*>(p); }

template <class LA, class LB, class KM>
__device__ __forceinline__ void gemm_core(LA la, LB lb, KM kmap, int nkt, char* smem) {
  u16* sA = reinterpret_cast<u16*>(smem);
  u16* sB = sA + 128 * LDSK;
  const int tid = threadIdx.x, lane = tid & 63, wave = tid >> 6;
  const int wm = wave >> 1, wn = wave & 1;
  const int lr = tid >> 3, kc = (tid & 7) * 8;
  f32x16 acc[2][2];
#pragma unroll
  for (int i = 0; i < 2; ++i)
#pragma unroll
    for (int j = 0; j < 2; ++j)
#pragma unroll
      for (int r = 0; r < 16; ++r) acc[i][j][r] = 0.f;
  uint4 ra[4], rb[4];
  {
    int k0 = kmap(0);
#pragma unroll
    for (int i = 0; i < 4; ++i) {
      ra[i] = la(lr + 32 * i, k0 + kc);
      rb[i] = lb(lr + 32 * i, k0 + kc);
    }
  }
#pragma unroll 1
  for (int kt = 0; kt < nkt; ++kt) {
    __syncthreads();
#pragma unroll
    for (int i = 0; i < 4; ++i) {
      *reinterpret_cast<uint4*>(&sA[(lr + 32 * i) * LDSK + kc]) = ra[i];
      *reinterpret_cast<uint4*>(&sB[(lr + 32 * i) * LDSK + kc]) = rb[i];
    }
    __syncthreads();
    if (kt + 1 < nkt) {
      int k1 = kmap(kt + 1);
#pragma unroll
      for (int i = 0; i < 4; ++i) {
        ra[i] = la(lr + 32 * i, k1 + kc);
        rb[i] = lb(lr + 32 * i, k1 + kc);
      }
    }
#pragma unroll
    for (int kk = 0; kk < 4; ++kk) {
      bf16x8 af[2], bfr[2];
#pragma unroll
      for (int mi = 0; mi < 2; ++mi)
        af[mi] = *reinterpret_cast<const bf16x8*>(&sA[(wm * 64 + mi * 32 + (lane & 31)) * LDSK + kk * 16 + (lane >> 5) * 8]);
#pragma unroll
      for (int ni = 0; ni < 2; ++ni)
        bfr[ni] = *reinterpret_cast<const bf16x8*>(&sB[(wn * 64 + ni * 32 + (lane & 31)) * LDSK + kk * 16 + (lane >> 5) * 8]);
#pragma unroll
      for (int mi = 0; mi < 2; ++mi)
#pragma unroll
        for (int ni = 0; ni < 2; ++ni)
          acc[mi][ni] = __builtin_amdgcn_mfma_f32_32x32x16_bf16(af[mi], bfr[ni], acc[mi][ni], 0, 0, 0);
    }
  }
  __syncthreads();
  float* sC = reinterpret_cast<float*>(smem);
#pragma unroll
  for (int mi = 0; mi < 2; ++mi)
#pragma unroll
    for (int ni = 0; ni < 2; ++ni)
#pragma unroll
      for (int r = 0; r < 16; ++r) {
        int row = wm * 64 + mi * 32 + (r & 3) + 8 * (r >> 2) + 4 * (lane >> 5);
        int col = wn * 64 + ni * 32 + (lane & 31);
        sC[row * LDC + col] = acc[mi][ni][r];
      }
  __syncthreads();
}


struct TileSched {
  int i, end, step;
  __device__ __forceinline__ TileSched(int T) {
    int nx = gridDim.x >> 3;
    int x = blockIdx.x & 7, lb = blockIdx.x >> 3;
    int c0 = (int)((long long)T * x / 8);
    end = (int)((long long)T * (x + 1) / 8);
    i = c0 + lb;
    step = nx;
  }
};
__device__ __forceinline__ void tile_decode(int i, int MT, int NT, int& mt, int& nt) {
  int gsz = 8 * NT;
  int g8 = i / gsz;
  int rem = i - g8 * gsz;
  int mrows = min(8, MT - 8 * g8);
  nt = rem / mrows;
  mt = 8 * g8 + (rem - nt * mrows);
}

struct KOff {
  int base;
  __device__ __forceinline__ int operator()(int kt) const { return base + kt * 64; }
};
struct KIdent {
  __device__ __forceinline__ int operator()(int kt) const { return kt * 64; }
};

__device__ __forceinline__ void transpose_job(const float* __restrict__ src, u16* __restrict__ dst, int K, int N, int kt, int nt, char* smem) {
  float* tile = reinterpret_cast<float*>(smem);
  const int tid = threadIdx.x;
  __syncthreads();
  {
    int c4 = (tid & 15) * 4;
    int n = nt * 64 + c4;
#pragma unroll
    for (int i = 0; i < 4; ++i) {
      int kr = (tid >> 4) + 16 * i;
      float4 v = make_float4(0.f, 0.f, 0.f, 0.f);
      if (n < N) v = *reinterpret_cast<const float4*>(src + (size_t)(kt * 64 + kr) * N + n);
      tile[kr * 65 + c4 + 0] = v.x;
      tile[kr * 65 + c4 + 1] = v.y;
      tile[kr * 65 + c4 + 2] = v.z;
      tile[kr * 65 + c4 + 3] = v.w;
    }
  }
  __syncthreads();
  {
    int nr = tid >> 2, kch = (tid & 3) * 16;
    unsigned w[8];
#pragma unroll
    for (int i = 0; i < 8; ++i) w[i] = pack2(tile[(kch + 2 * i) * 65 + nr], tile[(kch + 2 * i + 1) * 65 + nr]);
    u16* d = dst + (size_t)(nt * 64 + nr) * K + kt * 64 + kch;
    *reinterpret_cast<uint4*>(d) = make_uint4(w[0], w[1], w[2], w[3]);
    *reinterpret_cast<uint4*>(d + 8) = make_uint4(w[4], w[5], w[6], w[7]);
  }
}

__device__ __forceinline__ const float* xrow_in(const Params& p, int row) {
  return row < NPR ? p.x_prompt + (size_t)row * 1024 : p.x_sample + (size_t)(row - NPR) * 1024;
}

__device__ __forceinline__ void norm_ug_job(const Params& p, int job) {
  const int lane = threadIdx.x & 63, wave = threadIdx.x >> 6;
  int row = job * 4 + wave;
  if (row >= NTOK) return;
  const float* x = xrow_in(p, row) + lane * 16;
  float v[16];
#pragma unroll
  for (int i = 0; i < 4; ++i) {
    float4 t = *reinterpret_cast<const float4*>(x + 4 * i);
    v[4 * i] = t.x; v[4 * i + 1] = t.y; v[4 * i + 2] = t.z; v[4 * i + 3] = t.w;
  }
  float ss = 0.f;
#pragma unroll
  for (int i = 0; i < 16; ++i) ss += v[i] * v[i];
#pragma unroll
  for (int d = 32; d >= 1; d >>= 1) ss += __shfl_xor(ss, d);
  float rs = rsqrtf(ss * (1.f / 1024.f) + 1e-6f);
  const float* g = p.norm_mix + lane * 16;
  unsigned w[8];
#pragma unroll
  for (int i = 0; i < 8; ++i) w[i] = pack2(v[2 * i] * rs * g[2 * i], v[2 * i + 1] * rs * g[2 * i + 1]);
  u16* ug = reinterpret_cast<u16*>(p.ws + R_UG) + ((size_t)lane * NTOK + row) * 16;
  *reinterpret_cast<uint4*>(ug) = make_uint4(w[0], w[1], w[2], w[3]);
  *reinterpret_cast<uint4*>(ug + 8) = make_uint4(w[4], w[5], w[6], w[7]);
}

__device__ __forceinline__ void norm_hn_job(const Params& p, const float* __restrict__ X, const float* __restrict__ gw, int job) {
  const int lane = threadIdx.x & 63, wave = threadIdx.x >> 6;
  const int row0 = job * 16 + wave * 4;
  float4 t[4][4];
#pragma unroll
  for (int rr = 0; rr < 4; ++rr) {
    const float* x = X + (size_t)(row0 + rr) * 1024;
#pragma unroll
    for (int i = 0; i < 4; ++i) t[rr][i] = *reinterpret_cast<const float4*>(x + 4 * lane + 256 * i);
  }
  float4 g[4];
#pragma unroll
  for (int i = 0; i < 4; ++i) g[i] = *reinterpret_cast<const float4*>(gw + 4 * lane + 256 * i);
#pragma unroll
  for (int rr = 0; rr < 4; ++rr) {
    float ss = 0.f;
#pragma unroll
    for (int i = 0; i < 4; ++i) ss += t[rr][i].x * t[rr][i].x + t[rr][i].y * t[rr][i].y + t[rr][i].z * t[rr][i].z + t[rr][i].w * t[rr][i].w;
#pragma unroll
    for (int d = 32; d >= 1; d >>= 1) ss += __shfl_xor(ss, d);
    float rs = rsqrtf(ss * (1.f / 1024.f) + 1e-6f);
    u16* hn = reinterpret_cast<u16*>(p.ws + R_HN) + (size_t)(row0 + rr) * 1024;
#pragma unroll
    for (int i = 0; i < 4; ++i) {
      uint2 o;
      o.x = pack2(t[rr][i].x * rs * g[i].x, t[rr][i].y * rs * g[i].y);
      o.y = pack2(t[rr][i].z * rs * g[i].z, t[rr][i].w * rs * g[i].w);
      *reinterpret_cast<uint2*>(hn + 4 * lane + 256 * i) = o;
    }
  }
}

__device__ __forceinline__ void s5_table_job(const Params& p, int job) {
  int t = job * 256 + threadIdx.x;
  int c = t & 15, pp = (t >> 4) & 63, g = t >> 10;
  float lre = fminf(p.lam_re[g * 64 + pp], -1e-4f);
  float lim = p.lam_im[g * 64 + pp];
  float dt = expf(p.log_dt[g]);
  float mag = expf(lre * dt);
  float sn, cs;
  sincosf(lim * dt, &sn, &cs);
  float are = mag * cs, aim = mag * sn;
  float den = lre * lre + lim * lim;
  float nre = are - 1.f;
  float fre = (nre * lre + aim * lim) / den;
  float fim = (aim * lre - nre * lim) / den;
  float br = p.b_re[(g * 64 + pp) * 16 + c], bi = p.b_im[(g * 64 + pp) * 16 + c];
  float bbr = fre * br - fim * bi;
  float bbi = fre * bi + fim * br;
  float* bb = reinterpret_cast<float*>(p.ws + R_BB) + ((size_t)(g * 64 + pp) * 16 + c) * 2;
  bb[0] = bbr; bb[1] = bbi;
  u16* W1 = reinterpret_cast<u16*>(p.ws + R_W1) + (size_t)g * 128 * 512;
  float pr = 1.f, pi = 0.f;
  for (int n = 0; n < 32; ++n) {
    int i = 31 - n;
    W1[(size_t)pp * 512 + i * 16 + c] = f2bf(pr * bbr - pi * bbi);
    W1[(size_t)(64 + pp) * 512 + i * 16 + c] = f2bf(pr * bbi + pi * bbr);
    float nr = pr * are - pi * aim, ni = pr * aim + pi * are;
    pr = nr; pi = ni;
  }
  if (c == 0) {
    float* ap = reinterpret_cast<float*>(p.ws + R_AP) + (size_t)(g * 64 + pp) * 66;
    float qr = 1.f, qi = 0.f;
    for (int n = 0; n <= 32; ++n) {
      ap[2 * n] = qr; ap[2 * n + 1] = qi;
      float nr = qr * are - qi * aim, ni = qr * aim + qi * are;
      qr = nr; qi = ni;
    }
  }
}

__device__ __forceinline__ void phase0(const Params& p, char* smem) {
  const int NJ_T = 5536, NJ_N = 4160, NJ_S = 256;
  for (int job = blockIdx.x; job < NJ_S + NJ_N + NJ_T; job += gridDim.x) {
    if (job < NJ_S) {
      s5_table_job(p, job);
    } else if (job < NJ_S + NJ_N) {
      norm_ug_job(p, job - NJ_S);
    } else {
      int j = job - NJ_S - NJ_N;
      const float* src; u16* dst; int K, N, ntn;
      if (j < 512) { src = p.w_glu; dst = (u16*)(p.ws + W_GLU); K = 1024; N = 2048; ntn = 32; }
      else if (j < 1056) { j -= 512; src = p.w_in; dst = (u16*)(p.ws + W_IN); K = 1024; N = 2120; ntn = 34; }
      else if (j < 1312) { j -= 1056; src = p.w_o; dst = (u16*)(p.ws + W_O); K = 1024; N = 1024; ntn = 16; }
      else if (j < 2720) { j -= 1312; src = p.w_up; dst = (u16*)(p.ws + W_UP); K = 1024; N = 5632; ntn = 88; }
      else if (j < 4128) { j -= 2720; src = p.w_up + (size_t)1024 * 5632; dst = (u16*)(p.ws + W_UP) + (size_t)5632 * 1024; K = 1024; N = 5632; ntn = 88; }
      else if (j < 4832) { j -= 4128; src = p.w_down; dst = (u16*)(p.ws + W_DN); K = 2816; N = 1024; ntn = 16; }
      else { j -= 4832; src = p.w_down + (size_t)2816 * 1024; dst = (u16*)(p.ws + W_DN) + (size_t)1024 * 2816; K = 2816; N = 1024; ntn = 16; }
      transpose_job(src, dst, K, N, j / ntn, j % ntn, smem);
    }
  }
}

__device__ __forceinline__ void phase1(const Params& p, char* smem) {
  const int NT_G = 320, NJ_K = 2048, NJ_W = 8192;
  const u16* UG = reinterpret_cast<const u16*>(p.ws + R_UG);
  const u16* W1 = reinterpret_cast<const u16*>(p.ws + R_W1);
  float* S = reinterpret_cast<float*>(p.ws + R_S);
  const float* AP = reinterpret_cast<const float*>(p.ws + R_AP);
  const float* BB = reinterpret_cast<const float*>(p.ws + R_BB);
  for (int job = blockIdx.x; job < NT_G + NJ_K + NJ_W; job += gridDim.x) {
    if (job < NT_G) {
      int g = job / 5, mt = job % 5;
      const u16* ug = UG + (size_t)g * NTOK * 16;
      const u16* w1 = W1 + (size_t)g * 128 * 512;
      auto la = [=](int r, int k) -> uint4 {
        int col = mt * 128 + r;
        return col < 520 ? ld16(ug + (size_t)col * 512 + k) : zero4();
      };
      auto lb = [=](int n, int k) -> uint4 { return ld16(w1 + (size_t)n * 512 + k); };
      gemm_core(la, lb, KIdent(), 8, smem);
      const float* sC = reinterpret_cast<const float*>(smem);
      {
        const int cg = threadIdx.x & 31, r0 = threadIdx.x >> 5;
#pragma unroll
        for (int i = 0; i < 16; ++i) {
          int r = r0 + 8 * i;
          int col = mt * 128 + r;
          const float* c = sC + r * LDC + 4 * cg;
          if (col < 520) *reinterpret_cast<float4*>(&S[((size_t)col * 64 + g) * 128 + 4 * cg]) = make_float4(c[0], c[1], c[2], c[3]);
        }
      }
    } else if (job < NT_G + NJ_K) {
      int t = (job - NT_G) * 256 + threadIdx.x;
      int c = t & 15, cp = (t >> 4) & 15, tau = (t >> 8) & 31, g = t >> 13;
      float acc = 0.f;
#pragma unroll 16
      for (int pp = 0; pp < 64; ++pp) {
        float cr = p.c_re[(g * 16 + cp) * 64 + pp], ci = p.c_im[(g * 16 + cp) * 64 + pp];
        const float* bb = BB + ((size_t)(g * 64 + pp) * 16 + c) * 2;
        const float* ap = AP + (size_t)(g * 64 + pp) * 66 + 2 * tau;
        float br = bb[0], bi = bb[1];
        float ar = ap[0], ai = ap[1];
        float xr = br * ar - bi * ai, xi = br * ai + bi * ar;
        acc += cr * xr - ci * xi;
      }
      reinterpret_cast<u16*>(p.ws + R_KT)[t] = f2bf(acc);
    } else {
      int t = (job - NT_G - NJ_K) * 256 + threadIdx.x;
      int pp = t & 63, cp = (t >> 6) & 15, j = (t >> 10) & 31, g = t >> 15;
      float cr = p.c_re[(g * 16 + cp) * 64 + pp], ci = p.c_im[(g * 16 + cp) * 64 + pp];
      const float* ap = AP + (size_t)(g * 64 + pp) * 66 + 2 * (j + 1);
      float ar = ap[0], ai = ap[1];
      float vr = cr * ar - ci * ai, vi = cr * ai + ci * ar;
      u16* W3 = reinterpret_cast<u16*>(p.ws + R_W3) + ((size_t)g * 512 + j * 16 + cp) * 128;
      W3[pp] = f2bf(vr);
      W3[64 + pp] = f2bf(-vi);
    }
  }
}

__device__ __forceinline__ void phase2(const Params& p) {
  const float* S = reinterpret_cast<const float*>(p.ws + R_S);
  u16* HP = reinterpret_cast<u16*>(p.ws + R_HP);
  const float* AP = reinterpret_cast<const float*>(p.ws + R_AP);
  for (int job = blockIdx.x; job < 192; job += gridDim.x) {
    int t = job * 256 + threadIdx.x;
    if (t < 16384) {
      int pp = t & 63, g = (t >> 6) & 63, b = t >> 12;
      float ar = AP[(size_t)(g * 64 + pp) * 66 + 64], ai = AP[(size_t)(g * 64 + pp) * 66 + 65];
      float hr = 0.f, hi = 0.f;
      for (int c0 = 0; c0 < 128; c0 += 16) {
        float sr[16], si[16];
#pragma unroll
        for (int u = 0; u < 16; ++u) {
          size_t o = ((size_t)(b * 128 + c0 + u) * 64 + g) * 128 + pp;
          sr[u] = S[o]; si[u] = S[o + 64];
        }
#pragma unroll
        for (int u = 0; u < 16; ++u) {
          size_t o = ((size_t)(b * 128 + c0 + u) * 64 + g) * 128 + pp;
          HP[o] = f2bf(hr);
          HP[o + 64] = f2bf(hi);
          float nr = ar * hr - ai * hi + sr[u];
          float ni = ar * hi + ai * hr + si[u];
          hr = nr; hi = ni;
        }
      }
      p.out[O_SSM_RE_P + (b * 64 + g) * 64 + pp] = hr;
      p.out[O_SSM_IM_P + (b * 64 + g) * 64 + pp] = hi;
    } else {
      int u = t - 16384;
      int pp = u & 63, g = (u >> 6) & 63, b = u >> 12;
      float ar = AP[(size_t)(g * 64 + pp) * 66 + 64], ai = AP[(size_t)(g * 64 + pp) * 66 + 65];
      float hr = p.st_re[(b * 64 + g) * 64 + pp], hi = p.st_im[(b * 64 + g) * 64 + pp];
      size_t o = ((size_t)(512 + b) * 64 + g) * 128 + pp;
      HP[o] = f2bf(hr);
      HP[o + 64] = f2bf(hi);
      float nr = ar * hr - ai * hi + S[o];
      float ni = ar * hi + ai * hr + S[o + 64];
      p.out[O_SSM_RE_S + (b * 64 + g) * 64 + pp] = nr;
      p.out[O_SSM_IM_S + (b * 64 + g) * 64 + pp] = ni;
    }
  }
}

struct KMapS3 {
  int nlow;
  __device__ __forceinline__ int operator()(int kt) const { return kt < nlow ? kt * 64 : 512 + (kt - nlow) * 64; }
};

__device__ __forceinline__ void phase3(const Params& p, char* smem) {
  const u16* UG = reinterpret_cast<const u16*>(p.ws + R_UG);
  const u16* HP = reinterpret_cast<const u16*>(p.ws + R_HP);
  const u16* KT = reinterpret_cast<const u16*>(p.ws + R_KT);
  const u16* W3 = reinterpret_cast<const u16*>(p.ws + R_W3);
  u16* Z = reinterpret_cast<u16*>(p.ws + R_Z);
  for (int job = blockIdx.x; job < 1280; job += gridDim.x) {
    int nt = 3 - (job & 3);
    int mt = (job >> 2) % 5, g = job / 20;
    const u16* ug = UG + (size_t)g * NTOK * 16;
    auto la = [=](int r, int k) -> uint4 {
      int col = mt * 128 + r;
      if (col >= 520) return zero4();
      if (k < 512) return ld16(ug + (size_t)col * 512 + k);
      return ld16(HP + ((size_t)col * 64 + g) * 128 + (k - 512));
    };
    auto lb = [=](int nl, int k) -> uint4 {
      int n = nt * 128 + nl;
      if (k < 512) {
        int j = n >> 4, cp = n & 15, i = k >> 4, c0 = k & 15;
        if (j < i) return zero4();
        return ld16(KT + ((size_t)(g * 32 + (j - i)) * 16 + cp) * 16 + c0);
      }
      return ld16(W3 + ((size_t)g * 512 + n) * 128 + (k - 512));
    };
    KMapS3 km; km.nlow = 2 * (nt + 1);
    gemm_core(la, lb, km, km.nlow + 2, smem);
    const float* sC = reinterpret_cast<const float*>(smem);
    {
      const int cg = threadIdx.x & 31, r0 = threadIdx.x >> 5;
      const int n = nt * 128 + 4 * cg;
      const int j = n >> 4, cp = n & 15;
      const float4 dv = *reinterpret_cast<const float4*>(p.ssm_d + g * 16 + cp);
      uint2 uv[16];
#pragma unroll
      for (int i = 0; i < 16; ++i) {
        int col = mt * 128 + r0 + 8 * i;
        uv[i] = make_uint2(0u, 0u);
        if (col < 520) uv[i] = *reinterpret_cast<const uint2*>(ug + (size_t)(col * 32 + j) * 16 + cp);
      }
#pragma unroll
      for (int i = 0; i < 16; ++i) {
        int r = r0 + 8 * i;
        int col = mt * 128 + r;
        if (col < 520) {
          const float* c = sC + r * LDC + 4 * cg;
          float y0 = c[0] + dv.x * __uint_as_float(uv[i].x << 16);
          float y1 = c[1] + dv.y * __uint_as_float(uv[i].x & 0xffff0000u);
          float y2 = c[2] + dv.z * __uint_as_float(uv[i].y << 16);
          float y3 = c[3] + dv.w * __uint_as_float(uv[i].y & 0xffff0000u);
          uint2 o;
          o.x = pack2(gelu_tanh(y0), gelu_tanh(y1));
          o.y = pack2(gelu_tanh(y2), gelu_tanh(y3));
          *reinterpret_cast<uint2*>(Z + (size_t)(col * 32 + j) * 1024 + g * 16 + cp) = o;
        }
      }
    }
  }
}


#define LDK2 40
#define STAGE2 (384 * LDK2)
template <bool HALO, class LA, class LB, class EPI>
__device__ __forceinline__ void gemm256(LA la, LB lb, EPI epi, int nk, char* smem) {
  u16* sbuf = reinterpret_cast<u16*>(smem);
  const int tid = threadIdx.x, lane = tid & 63, wave = tid >> 6;
  const int wm = wave >> 1, wn = wave & 1;
  const int lrow = tid >> 2, kc = (tid & 3) * 8;
  f32x16 acc[4][2];
#pragma unroll
  for (int i = 0; i < 4; ++i)
#pragma unroll
    for (int j = 0; j < 2; ++j)
#pragma unroll
      for (int r = 0; r < 16; ++r) acc[i][j][r] = 0.f;
  uint4 ra[4], rb[2];
#pragma unroll
  for (int i = 0; i < 4; ++i) ra[i] = la(lrow + 64 * i, kc);
#pragma unroll
  for (int i = 0; i < 2; ++i) rb[i] = lb(lrow + 64 * i, kc);
  __syncthreads();
#pragma unroll
  for (int i = 0; i < 4; ++i) *reinterpret_cast<uint4*>(&sbuf[(lrow + 64 * i) * LDK2 + kc]) = ra[i];
#pragma unroll
  for (int i = 0; i < 2; ++i) *reinterpret_cast<uint4*>(&sbuf[(256 + lrow + 64 * i) * LDK2 + kc]) = rb[i];
  if (nk > 1) {
#pragma unroll
    for (int i = 0; i < 4; ++i) ra[i] = la(lrow + 64 * i, 32 + kc);
#pragma unroll
    for (int i = 0; i < 2; ++i) rb[i] = lb(lrow + 64 * i, 32 + kc);
  }
#pragma unroll 1
  for (int kt = 0; kt < nk; ++kt) {
    __syncthreads();
    const u16* cA = sbuf + (kt & 1) * STAGE2;
    const u16* cB = cA + 256 * LDK2;
    u16* nA = sbuf + ((kt + 1) & 1) * STAGE2;
    {
      bf16x8 af[4], bfr[2];
#pragma unroll
      for (int mi = 0; mi < 4; ++mi)
        af[mi] = *reinterpret_cast<const bf16x8*>(&cA[(wm * 128 + mi * 32 + (lane & 31)) * LDK2 + (lane >> 5) * 8]);
#pragma unroll
      for (int ni = 0; ni < 2; ++ni)
        bfr[ni] = *reinterpret_cast<const bf16x8*>(&cB[(wn * 64 + ni * 32 + (lane & 31)) * LDK2 + (lane >> 5) * 8]);
#pragma unroll
      for (int mi = 0; mi < 4; ++mi)
#pragma unroll
        for (int ni = 0; ni < 2; ++ni)
          acc[mi][ni] = __builtin_amdgcn_mfma_f32_32x32x16_bf16(af[mi], bfr[ni], acc[mi][ni], 0, 0, 0);
    }
    if (kt + 1 < nk) {
#pragma unroll
      for (int i = 0; i < 4; ++i) *reinterpret_cast<uint4*>(&nA[(lrow + 64 * i) * LDK2 + kc]) = ra[i];
#pragma unroll
      for (int i = 0; i < 2; ++i) *reinterpret_cast<uint4*>(&nA[(256 + lrow + 64 * i) * LDK2 + kc]) = rb[i];
      if (kt + 2 < nk) {
        int k2 = (kt + 2) * 32 + kc;
#pragma unroll
        for (int i = 0; i < 4; ++i) ra[i] = la(lrow + 64 * i, k2);
#pragma unroll
        for (int i = 0; i < 2; ++i) rb[i] = lb(lrow + 64 * i, k2);
      }
    }
    {
      bf16x8 af[4], bfr[2];
#pragma unroll
      for (int mi = 0; mi < 4; ++mi)
        af[mi] = *reinterpret_cast<const bf16x8*>(&cA[(wm * 128 + mi * 32 + (lane & 31)) * LDK2 + 16 + (lane >> 5) * 8]);
#pragma unroll
      for (int ni = 0; ni < 2; ++ni)
        bfr[ni] = *reinterpret_cast<const bf16x8*>(&cB[(wn * 64 + ni * 32 + (lane & 31)) * LDK2 + 16 + (lane >> 5) * 8]);
#pragma unroll
      for (int mi = 0; mi < 4; ++mi)
#pragma unroll
        for (int ni = 0; ni < 2; ++ni)
          acc[mi][ni] = __builtin_amdgcn_mfma_f32_32x32x16_bf16(af[mi], bfr[ni], acc[mi][ni], 0, 0, 0);
    }
  }
  float* sC = reinterpret_cast<float*>(smem);
#pragma unroll
  for (int h = 0; h < 2; ++h) {
    __syncthreads();
#pragma unroll
    for (int m2 = 0; m2 < 2; ++m2)
#pragma unroll
      for (int ni = 0; ni < 2; ++ni)
#pragma unroll
        for (int r = 0; r < 16; ++r) {
          int j = m2 * 32 + (r & 3) + 8 * (r >> 2) + 4 * (lane >> 5);
          int col = wn * 64 + ni * 32 + (lane & 31);
          sC[(wm * 66 + 2 + j) * LDC + col] = acc[2 * h + m2][ni][r];
        }
    if (HALO) {
      if (h == 0) {
        if (wm == 0 && lane >= 32) {
#pragma unroll
          for (int ni = 0; ni < 2; ++ni) {
            int col = wn * 64 + ni * 32 + (lane & 31);
            sC[(66 + 0) * LDC + col] = acc[3][ni][14];
            sC[(66 + 1) * LDC + col] = acc[3][ni][15];
          }
        }
      } else {
        if (lane >= 32) {
#pragma unroll
          for (int ni = 0; ni < 2; ++ni) {
            int col = wn * 64 + ni * 32 + (lane & 31);
            sC[(wm * 66 + 0) * LDC + col] = acc[1][ni][14];
            sC[(wm * 66 + 1) * LDC + col] = acc[1][ni][15];
          }
        }
      }
    }
    __syncthreads();
    epi(h, sC);
  }
}


#define GSTAGE_B (384 * 64)
#define WAITV(n) asm volatile("s_waitcnt vmcnt(%0)" ::"n"(n) : "memory")
#define RAWBAR() do { asm volatile("s_waitcnt lgkmcnt(0)" ::: "memory"); __builtin_amdgcn_s_barrier(); } while (0)
template <bool HALO, class PA, class PB, class EPI>
__device__ __forceinline__ void gemm256g(const u16* baseA, const u16* baseB, PA pa, PB pb, EPI epi, int nk, char* smem) {
  const int tid = threadIdx.x, lane = tid & 63, wave = tid >> 6;
  const int wm = wave >> 1, wn = wave & 1;
  const int lrow = tid >> 2, cpos = tid & 3;
  f32x16 acc[4][2];
#pragma unroll
  for (int i = 0; i < 4; ++i)
#pragma unroll
    for (int j = 0; j < 2; ++j)
#pragma unroll
      for (int r = 0; r < 16; ++r) acc[i][j][r] = 0.f;
  const int koff = 8 * (cpos ^ ((lrow >> 2) & 3));
  unsigned offA[4], offB[2];
#pragma unroll
  for (int i = 0; i < 4; ++i) offA[i] = (pa(lrow + 64 * i) + koff) * 2u;
#pragma unroll
  for (int i = 0; i < 2; ++i) offB[i] = (pb(lrow + 64 * i) + koff) * 2u;
  auto issue = [&](int kt, int st) {
    char* base = smem + st * GSTAGE_B;
    const unsigned kb = kt * 64;
#pragma unroll
    for (int i = 0; i < 4; ++i)
      __builtin_amdgcn_global_load_lds((const unsigned*)(reinterpret_cast<const char*>(baseA) + (size_t)(offA[i] + kb)),
                                       (unsigned*)(base + (lrow + 64 * i) * 64 + cpos * 16), 16, 0, 0);
#pragma unroll
    for (int i = 0; i < 2; ++i)
      __builtin_amdgcn_global_load_lds((const unsigned*)(reinterpret_cast<const char*>(baseB) + (size_t)(offB[i] + kb)),
                                       (unsigned*)(base + (256 + lrow + 64 * i) * 64 + cpos * 16), 16, 0, 0);
  };
  WAITV(0);
  __syncthreads();
  issue(0, 0);
  if (nk > 1) issue(1, 1);
  if (nk > 2) issue(2, 2);
  if (nk > 2) WAITV(12); else if (nk > 1) WAITV(6); else WAITV(0);
  RAWBAR();
  const int sw = ((lane & 31) >> 2) & 3;
  const unsigned lds0 = (unsigned)(size_t)((__attribute__((address_space(3))) char*)smem);
  const unsigned ra_off = lds0 + (wm * 128 + (lane & 31)) * 64;
  const unsigned rb_off = lds0 + (256 + wn * 64 + (lane & 31)) * 64;
  const unsigned ph0 = (((lane >> 5)) ^ sw) * 16, ph1 = ((2 + (lane >> 5)) ^ sw) * 16;
#define GR6(F, aA, aB)                                                                                              \
  asm volatile("ds_read_b128 %0, %6\n\tds_read_b128 %4, %7\n\tds_read_b128 %1, %6 offset:2048\n\t"                 \
               "ds_read_b128 %5, %7 offset:2048\n\tds_read_b128 %2, %6 offset:4096\n\tds_read_b128 %3, %6 offset:6144" \
               : "=&v"(F[0]), "=&v"(F[1]), "=&v"(F[2]), "=&v"(F[3]), "=&v"(F[4]), "=&v"(F[5])                       \
               : "v"(aA), "v"(aB)                                                                                   \
               : "memory")
#define GW(n, F)                                                                                                    \
  asm volatile("s_waitcnt lgkmcnt(" #n ")"                                                                          \
               : "+v"(F[0]), "+v"(F[1]), "+v"(F[2]), "+v"(F[3]), "+v"(F[4]), "+v"(F[5])::"memory")
#define GMMA(F)                                                                                                     \
  _Pragma("unroll") for (int mi = 0; mi < 4; ++mi) _Pragma("unroll") for (int ni = 0; ni < 2; ++ni)                 \
      acc[mi][ni] = __builtin_amdgcn_mfma_f32_32x32x16_bf16(F[mi], F[4 + ni], acc[mi][ni], 0, 0, 0)
  bf16x8 F0[6], F1[6];
  {
    const unsigned aA = ra_off + ph0, aB = rb_off + ph0;
    GR6(F0, aA, aB);
  }
  int st = 0;
#pragma unroll 1
  for (int kt = 0; kt < nk; ++kt) {
    const unsigned sb = st * GSTAGE_B;
    {
      const unsigned aA = sb + ra_off + ph1, aB = sb + rb_off + ph1;
      GR6(F1, aA, aB);
    }
    GW(6, F0);
    __builtin_amdgcn_sched_barrier(0);
    GMMA(F0);
    __builtin_amdgcn_sched_barrier(0);
    GW(0, F1);
    if (kt + 1 < nk) { if (kt + 2 < nk) WAITV(6); else WAITV(0); }
    __builtin_amdgcn_s_barrier();
    __builtin_amdgcn_sched_barrier(0);
    int st1 = st + 1; if (st1 >= 3) st1 = 0;
    if (kt + 1 < nk) {
      const unsigned aA = st1 * GSTAGE_B + ra_off + ph0, aB = st1 * GSTAGE_B + rb_off + ph0;
      GR6(F0, aA, aB);
    }
    if (kt + 3 < nk) issue(kt + 3, st);
    __builtin_amdgcn_sched_barrier(0);
    GMMA(F1);
    __builtin_amdgcn_sched_barrier(0);
    st = st1;
  }
  asm volatile("s_waitcnt lgkmcnt(0)" ::: "memory");
  float* sC = reinterpret_cast<float*>(smem);
#pragma unroll
  for (int h = 0; h < 2; ++h) {
    __syncthreads();
#pragma unroll
    for (int m2 = 0; m2 < 2; ++m2)
#pragma unroll
      for (int ni = 0; ni < 2; ++ni)
#pragma unroll
        for (int r = 0; r < 16; ++r) {
          int j = m2 * 32 + (r & 3) + 8 * (r >> 2) + 4 * (lane >> 5);
          int col = wn * 64 + ni * 32 + (lane & 31);
          sC[(wm * 66 + 2 + j) * LDG + col] = acc[2 * h + m2][ni][r];
        }
    if (HALO) {
      if (h == 0) {
        if (wm == 0 && lane >= 32) {
#pragma unroll
          for (int ni = 0; ni < 2; ++ni) {
            int col = wn * 64 + ni * 32 + (lane & 31);
            sC[(66 + 0) * LDG + col] = acc[3][ni][14];
            sC[(66 + 1) * LDG + col] = acc[3][ni][15];
          }
        }
      } else {
        if (lane >= 32) {
#pragma unroll
          for (int ni = 0; ni < 2; ++ni) {
            int col = wn * 64 + ni * 32 + (lane & 31);
            sC[(wm * 66 + 0) * LDG + col] = acc[1][ni][14];
            sC[(wm * 66 + 1) * LDG + col] = acc[1][ni][15];
          }
        }
      }
    }
    __syncthreads();
    epi(h, sC);
  }
}

__device__ __forceinline__ float4 ld4f(const float* p, bool vec) {
  if (vec) return *reinterpret_cast<const float4*>(p);
  return make_float4(p[0], p[1], p[2], p[3]);
}
template <bool SPLIT>
__device__ __forceinline__ int epi_srow(int v) { return SPLIT ? (v >> 6) * 66 + 2 + (v & 63) : v; }
template <bool SPLIT>
__device__ __forceinline__ int epi_grow(int v, int row0, int h) { return SPLIT ? row0 + 128 * (v >> 6) + 64 * h + (v & 63) : row0 + v; }

template <bool SPLIT>
__device__ __forceinline__ void glu_epi(const Params& p, const float* sC, int row0, int h, int n0) {
  float* X = p.out;
  const int cg = threadIdx.x & 15, r0 = threadIdx.x >> 4;
  const float4 b1 = *reinterpret_cast<const float4*>(p.b_glu + n0 + 4 * cg);
  const float4 b2 = *reinterpret_cast<const float4*>(p.b_glu + 1024 + n0 + 4 * cg);
#pragma unroll
  for (int hh = 0; hh < 2; ++hh) {
    float4 xv[4];
#pragma unroll
    for (int i = 0; i < 4; ++i) xv[i] = *reinterpret_cast<const float4*>(xrow_in(p, epi_grow<SPLIT>(r0 + 16 * (hh * 4 + i), row0, h)) + n0 + 4 * cg);
#pragma unroll
    for (int i = 0; i < 4; ++i) {
      int v = r0 + 16 * (hh * 4 + i);
      const float* c = sC + epi_srow<SPLIT>(v) * (SPLIT ? LDG : LDC) + 4 * cg;
      const float4 g1 = ld4f(c, SPLIT), g2 = ld4f(c + 64, SPLIT);
      float4 o;
      o.x = xv[i].x + (g1.x + b1.x) * sigmoid_fast(g2.x + b2.x);
      o.y = xv[i].y + (g1.y + b1.y) * sigmoid_fast(g2.y + b2.y);
      o.z = xv[i].z + (g1.z + b1.z) * sigmoid_fast(g2.z + b2.z);
      o.w = xv[i].w + (g1.w + b1.w) * sigmoid_fast(g2.w + b2.w);
      *reinterpret_cast<float4*>(X + (size_t)epi_grow<SPLIT>(v, row0, h) * 1024 + n0 + 4 * cg) = o;
    }
  }
}
template <bool SPLIT>
__device__ __forceinline__ void resid_epi(const Params& p, const float* sC, int row0, int h, int col0) {
  const int cg = threadIdx.x & 31, r0 = threadIdx.x >> 5;
  float* xb = p.out + col0 + 4 * cg;
#pragma unroll
  for (int half = 0; half < 2; ++half) {
    float4 xv[8];
#pragma unroll
    for (int i = 0; i < 8; ++i) xv[i] = *reinterpret_cast<const float4*>(xb + (size_t)epi_grow<SPLIT>(r0 + 8 * (half * 8 + i), row0, h) * 1024);
#pragma unroll
    for (int i = 0; i < 8; ++i) {
      int v = r0 + 8 * (half * 8 + i);
      const float4 cv = ld4f(sC + epi_srow<SPLIT>(v) * (SPLIT ? LDG : LDC) + 4 * cg, SPLIT);
      float4 o = make_float4(xv[i].x + cv.x, xv[i].y + cv.y, xv[i].z + cv.z, xv[i].w + cv.w);
      *reinterpret_cast<float4*>(xb + (size_t)epi_grow<SPLIT>(v, row0, h) * 1024) = o;
    }
  }
}

__device__ __forceinline__ void phase4(const Params& p, char* smem) {
  const u16* Z = reinterpret_cast<const u16*>(p.ws + R_Z);
  const u16* W = reinterpret_cast<const u16*>(p.ws + W_GLU);
  for (TileSched ts(64 * 16); ts.i < ts.end; ts.i += ts.step) {
    int mt, nt;
    tile_decode(ts.i, 64, 16, mt, nt);
    int n0 = nt * 64;
    auto la = [=](int r) -> unsigned { return (unsigned)(mt * 256 + r) * 1024u; };
    auto lb = [=](int nl) -> unsigned {
      int nrow = nl < 64 ? n0 + nl : 1024 + n0 + nl - 64;
      return (unsigned)nrow * 1024u;
    };
    auto epi = [&](int h, const float* sC) { glu_epi<true>(p, sC, mt * 256, h, n0); };
    gemm256g<false>(Z, W, la, lb, epi, 32, smem);
  }
  for (int job = blockIdx.x; job < 32; job += gridDim.x) {
    int mt = 128 + (job >> 4), nt = job & 15;
    int n0 = nt * 64;
    auto la = [=](int r, int k) -> uint4 { return ld16(Z + (size_t)(mt * 128 + r) * 1024 + k); };
    auto lb = [=](int nl, int k) -> uint4 {
      int nrow = nl < 64 ? n0 + nl : 1024 + n0 + nl - 64;
      return ld16(W + (size_t)nrow * 1024 + k);
    };
    gemm_core(la, lb, KIdent(), 16, smem);
    glu_epi<false>(p, reinterpret_cast<const float*>(smem), mt * 128, 0, n0);
  }
}


__device__ __forceinline__ size_t ki_off(int row, int kc) { return ((size_t)((row >> 5) * 8 + kc) * 32 + (row & 31)) * 8; }

__device__ __forceinline__ void phase_norm(const Params& p, const float* gw, bool conv_caches) {
  int nj = 1040 + (conv_caches ? (4096 + 4096 + 1024) : 0);
  if (blockIdx.x == 0 && threadIdx.x < 128) *reinterpret_cast<uint4*>(reinterpret_cast<u16*>(p.ws + R_HN) + (size_t)NTOK * 1024 + threadIdx.x * 8) = zero4();
  for (int job = blockIdx.x; job < nj; job += gridDim.x) {
    if (job < 1040) {
      norm_hn_job(p, p.out, gw, job);
    } else {
      int j = job - 1040;
      if (j < 8192) {
        const float* src = j < 4096 ? p.cache_k : p.cache_v;
        u16* dst = reinterpret_cast<u16*>(p.ws + (j < 4096 ? R_KB : R_VB));
        int jj = j & 4095;
        size_t e = ((size_t)jj * 256 + threadIdx.x) * 8;
        int b = (int)(e >> 20);
        size_t within = e & ((1u << 20) - 1);
        float4 a = *reinterpret_cast<const float4*>(src + e);
        float4 c = *reinterpret_cast<const float4*>(src + e + 4);
        uint4 o = make_uint4(pack2(a.x, a.y), pack2(a.z, a.w), pack2(c.x, c.y), pack2(c.z, c.w));
        *reinterpret_cast<uint4*>(dst + ((size_t)NPR + (size_t)b * 4128) * 256 + within) = o;
      } else {
        int jj = j - 8192;
        size_t e = ((size_t)jj * 256 + threadIdx.x) * 8;
        int b = (int)(e >> 18);
        size_t within = e & ((1u << 18) - 1);
        float4 a = *reinterpret_cast<const float4*>(p.cache_kidx + e);
        float4 c = *reinterpret_cast<const float4*>(p.cache_kidx + e + 4);
        uint4 o = make_uint4(pack2(a.x, a.y), pack2(a.z, a.w), pack2(c.x, c.y), pack2(c.z, c.w));
        {
          int row = NPR + b * 4128 + (int)(within >> 6), kc = (int)((within & 63) >> 3);
          *reinterpret_cast<uint4*>(reinterpret_cast<u16*>(p.ws + R_KI) + ki_off(row, kc)) = o;
        }
      }
    }
  }
}

__device__ __forceinline__ void phase_up(const Params& p, int layer, char* smem) {
  const u16* HN = reinterpret_cast<const u16*>(p.ws + R_HN);
  const u16* W = reinterpret_cast<const u16*>(p.ws + W_UP) + (size_t)layer * 5632 * 1024;
  u16* GT = reinterpret_cast<u16*>(p.ws + R_GT);
  const float* cw = p.conv_w + (size_t)layer * 3 * 2816;
  const float* cb = p.conv_b + (size_t)layer * 2816;
  for (TileSched ts(69 * 44); ts.i < ts.end; ts.i += ts.step) {
    int mt, nt;
    tile_decode(ts.i, 69, 44, mt, nt);
    const int n0 = nt * 64;
    const bool prompt = mt < 68;
    const int s = mt / 17, it = mt - s * 17;
    const int tbase = 254 * it - 2;
    const int rbase = prompt ? s * 4096 : NPR;
    auto la = [=](int r) -> unsigned {
      if (prompt) {
        int tp = tbase + r;
        if (tp < 0 || tp >= 4096) return (unsigned)NTOK * 1024u;
        return (unsigned)(rbase + tp) * 1024u;
      }
      return (unsigned)(rbase + r) * 1024u;
    };
    auto lb = [=](int nl) -> unsigned {
      int nrow = nl < 64 ? n0 + nl : 2816 + n0 + nl - 64;
      return (unsigned)nrow * 1024u;
    };
    auto epi = [&](int h, const float* sC) {
      const int cg = threadIdx.x & 15, r0 = threadIdx.x >> 4;
      const int col = n0 + 4 * cg;
      const float4 w0 = *reinterpret_cast<const float4*>(cw + col);
      const float4 w1 = *reinterpret_cast<const float4*>(cw + 2816 + col);
      const float4 w2 = *reinterpret_cast<const float4*>(cw + 2 * 2816 + col);
      const float4 bb = *reinterpret_cast<const float4*>(cb + col);
#pragma unroll 1
      for (int i = 0; i < 8; ++i) {
        const int v = r0 + 16 * i;
        const int r = 128 * (v >> 6) + 64 * h + (v & 63);
        const int sr = (v >> 6) * 66 + 2 + (v & 63);
        const float* c = sC + sr * LDG + 4 * cg;
        float4 a0 = *reinterpret_cast<const float4*>(c);
        float4 bv = *reinterpret_cast<const float4*>(c + 64);
        float4 a1 = *reinterpret_cast<const float4*>(c - LDG);
        float4 a2 = *reinterpret_cast<const float4*>(c - 2 * LDG);
        size_t orow;
        bool doit;
        if (prompt) {
          int tp = tbase + r;
          doit = (r >= 2 && tp < 4096);
          orow = (size_t)(rbase + tp);
          if (doit && tp >= 4094)
            *reinterpret_cast<float4*>(p.out + O_CONV_P + ((size_t)(layer * 4 + s) * 2 + (tp - 4094)) * 2816 + col) = a0;
        } else {
          doit = true;
          int b = r >> 5, t = r & 31;
          const float* cc = p.cache_conv + ((size_t)(layer * 8 + b) * 2) * 2816 + col;
          if (t < 1) a1 = *reinterpret_cast<const float4*>(cc + 2816);
          if (t < 2) a2 = *reinterpret_cast<const float4*>(cc + (size_t)t * 2816);
          orow = (size_t)(rbase + r);
          if (t >= 30) *reinterpret_cast<float4*>(p.out + O_CONV_S + ((size_t)(layer * 8 + b) * 2 + (t - 30)) * 2816 + col) = a0;
        }
        if (doit) {
          float c0 = bb.x + w0.x * a2.x + w1.x * a1.x + w2.x * a0.x;
          float c1v = bb.y + w0.y * a2.y + w1.y * a1.y + w2.y * a0.y;
          float c2v = bb.z + w0.z * a2.z + w1.z * a1.z + w2.z * a0.z;
          float c3v = bb.w + w0.w * a2.w + w1.w * a1.w + w2.w * a0.w;
          uint2 o;
          o.x = pack2(gelu_tanh(c0) * bv.x, gelu_tanh(c1v) * bv.y);
          o.y = pack2(gelu_tanh(c2v) * bv.z, gelu_tanh(c3v) * bv.w);
          *reinterpret_cast<uint2*>(GT + orow * 2816 + col) = o;
        }
      }
    };
    gemm256g<true>(HN, W, la, lb, epi, 32, smem);
  }
}

__device__ __forceinline__ void phase_resid_gemm(const Params& p, const u16* A, const u16* W, int K, char* smem) {
  {
    const int nsplit = K / 256;
    for (int job = blockIdx.x; job < 16 * nsplit; job += gridDim.x) {
      int sp = job / 16, tl = job % 16;
      int mt = 128 + (tl >> 3), nt = tl & 7;
      auto la = [=](int r, int k) -> uint4 { return ld16(A + (size_t)(mt * 128 + r) * K + k); };
      auto lb = [=](int nl, int k) -> uint4 { return ld16(W + (size_t)(nt * 128 + nl) * K + k); };
      KOff ko; ko.base = sp * 256;
      gemm_core(la, lb, ko, 4, smem);
      const float* sC = reinterpret_cast<const float*>(smem);
      float* xb = p.out + (size_t)(mt * 128) * 1024 + nt * 128;
      for (int idx = threadIdx.x; idx < 128 * 128; idx += 256) {
        int r = idx >> 7, n = idx & 127;
        unsafeAtomicAdd(xb + (size_t)r * 1024 + n, sC[r * LDC + n]);
      }
    }
  }
  for (TileSched ts(64 * 8); ts.i < ts.end; ts.i += ts.step) {
    int mt, nt;
    tile_decode(ts.i, 64, 8, mt, nt);
    auto la = [=](int r) -> unsigned { return (unsigned)(mt * 256 + r) * (unsigned)K; };
    auto lb = [=](int nl) -> unsigned { return (unsigned)(nt * 128 + nl) * (unsigned)K; };
    auto epi = [&](int h, const float* sC) { resid_epi<true>(p, sC, mt * 256, h, nt * 128); };
    gemm256g<false>(A, W, la, lb, epi, K / 32, smem);
  }
}

__device__ __forceinline__ void rope16(float* v, int pos) {
  const float inv[8] = {1.000000000e+00f, 1.939227432e-01f, 3.760603070e-02f, 7.292664610e-03f,
                        1.414213562e-03f, 2.742481884e-04f, 5.318296098e-05f, 1.031338616e-05f};
  float fp = (float)pos;
#pragma unroll
  for (int i = 0; i < 8; ++i) {
    float ang = fp * inv[i];
    float sn, cs;
    sincosf(ang, &sn, &cs);
    float x1 = v[i], x2 = v[8 + i];
    v[i] = x1 * cs - x2 * sn;
    v[8 + i] = x2 * cs + x1 * sn;
  }
}

__device__ __forceinline__ void store64_bf16(u16* dst, const float* v) {
#pragma unroll
  for (int i = 0; i < 8; ++i) {
    uint4 o = make_uint4(pack2(v[8 * i], v[8 * i + 1]), pack2(v[8 * i + 2], v[8 * i + 3]),
                         pack2(v[8 * i + 4], v[8 * i + 5]), pack2(v[8 * i + 6], v[8 * i + 7]));
    *reinterpret_cast<uint4*>(dst + 8 * i) = o;
  }
}
__device__ __forceinline__ void store64_f32(float* dst, const float* v) {
#pragma unroll
  for (int i = 0; i < 16; ++i) *reinterpret_cast<float4*>(dst + 4 * i) = make_float4(v[4 * i], v[4 * i + 1], v[4 * i + 2], v[4 * i + 3]);
}

__device__ __forceinline__ void phase_win(const Params& p, char* smem) {
  const u16* HN = reinterpret_cast<const u16*>(p.ws + R_HN);
  const u16* W = reinterpret_cast<const u16*>(p.ws + W_IN);
  u16* QB = reinterpret_cast<u16*>(p.ws + R_QB);
  u16* KB = reinterpret_cast<u16*>(p.ws + R_KB);
  u16* VB = reinterpret_cast<u16*>(p.ws + R_VB);
  u16* QI = reinterpret_cast<u16*>(p.ws + R_QI);
  u16* KI = reinterpret_cast<u16*>(p.ws + R_KI);
  float* WI = reinterpret_cast<float*>(p.ws + R_WI);
  for (TileSched ts(130 * 17); ts.i < ts.end; ts.i += ts.step) {
    int mt, nt;
    tile_decode(ts.i, 130, 17, mt, nt);
    auto la = [=](int r, int k) -> uint4 { return ld16(HN + (size_t)(mt * 128 + r) * 1024 + k); };
    auto lb = [=](int nl, int k) -> uint4 { return ld16(W + (size_t)(nt * 128 + nl) * 1024 + k); };
    gemm_core(la, lb, KIdent(), 16, smem);
    const float* sC = reinterpret_cast<const float*>(smem);
    int r = threadIdx.x & 127, h = threadIdx.x >> 7;
    int cbase = nt * 128 + 64 * h;
    int row = mt * 128 + r;
    int pos, kvrow;
    if (row < NPR) { pos = row & 4095; kvrow = row; }
    else { int bs = (row - NPR) >> 5, t = (row - NPR) & 31; pos = 4096 + t; kvrow = NPR + bs * 4128 + 4096 + t; }
    if (cbase < 2112) {
      float v[64];
#pragma unroll
      for (int d = 0; d < 64; ++d) v[d] = sC[r * LDC + 64 * h + d];
      if (cbase < 1280) {
        float ss = 0.f;
#pragma unroll
        for (int d = 0; d < 64; ++d) ss += v[d] * v[d];
        float rs = rsqrtf(ss * (1.f / 64.f) + 1e-6f);
        const float* gw = cbase < 1024 ? p.q_norm : p.k_norm;
#pragma unroll
        for (int d = 0; d < 64; ++d) v[d] = v[d] * rs * gw[d];
      }
      if (cbase < 1280 || cbase >= 1536) rope16(v, pos);
      if (cbase < 1024) {
        store64_bf16(QB + (size_t)row * 1024 + cbase, v);
      } else if (cbase < 1280) {
        store64_bf16(KB + (size_t)kvrow * 256 + (cbase - 1024), v);
        float* o = row < NPR ? p.out + O_K_P + (size_t)row * 256 : p.out + O_K_S + (size_t)(row - NPR) * 256;
        store64_f32(o + (cbase - 1024), v);
      } else if (cbase < 1536) {
        store64_bf16(VB + (size_t)kvrow * 256 + (cbase - 1280), v);
        float* o = row < NPR ? p.out + O_V_P + (size_t)row * 256 : p.out + O_V_S + (size_t)(row - NPR) * 256;
        store64_f32(o + (cbase - 1280), v);
      } else if (cbase < 2048) {
        store64_bf16(QI + (size_t)row * 512 + (cbase - 1536), v);
      } else {
#pragma unroll
        for (int kc = 0; kc < 8; ++kc) {
          uint4 o = make_uint4(pack2(v[8 * kc], v[8 * kc + 1]), pack2(v[8 * kc + 2], v[8 * kc + 3]),
                               pack2(v[8 * kc + 4], v[8 * kc + 5]), pack2(v[8 * kc + 6], v[8 * kc + 7]));
          *reinterpret_cast<uint4*>(KI + ki_off(kvrow, kc)) = o;
        }
        float* o = row < NPR ? p.out + O_KI_P + (size_t)row * 64 : p.out + O_KI_S + (size_t)(row - NPR) * 64;
        store64_f32(o, v);
      }
    } else if (cbase == 2112) {
      float w[8];
#pragma unroll
      for (int d = 0; d < 8; ++d) w[d] = sC[r * LDC + 64 * h + d];
      *reinterpret_cast<float4*>(WI + (size_t)row * 8) = make_float4(w[0], w[1], w[2], w[3]);
      *reinterpret_cast<float4*>(WI + (size_t)row * 8 + 4) = make_float4(w[4], w[5], w[6], w[7]);
    }
  }
}

__device__ __forceinline__ unsigned f2key(float f) {
  unsigned u = __float_as_uint(f);
  return (u & 0x80000000u) ? ~u : (u | 0x80000000u);
}

__device__ __forceinline__ void phase_index(const Params& p, char* smem) {
  const u16* QI = reinterpret_cast<const u16*>(p.ws + R_QI);
  const u16* KI = reinterpret_cast<const u16*>(p.ws + R_KI);
  const float* WI = reinterpret_cast<const float*>(p.ws + R_WI);
  u16* SEL = reinterpret_cast<u16*>(p.ws + R_SEL);
  int* CNT = reinterpret_cast<int*>(p.ws + R_CNT);
  float* sc = reinterpret_cast<float*>(smem);
  unsigned* histall = reinterpret_cast<unsigned*>(smem + 66048);
  const int tid = threadIdx.x, lane = tid & 63, wave = tid >> 6;
  for (int item = blockIdx.x; item < 64 + 4096; item += gridDim.x) {
    int tok0, nk, seqbase;
    if (item < 64) {
      tok0 = NPR + item * 4;
      nk = 4128;
      seqbase = NPR + (item >> 3) * 4128;
    } else {
      int it = item - 64;
      int c = 63 - (it >> 6);
      int b = (it & 63) >> 4, q4 = it & 15;
      tok0 = b * 4096 + c * 64 + q4 * 4;
      nk = 64 * (c + 1);
      seqbase = b * 4096;
    }
    __syncthreads();
    if (nk > 256) {
      bf16x8 af[4];
      {
        int q = (lane & 31) >> 3, h = lane & 7;
        const u16* src = QI + (size_t)(tok0 + q) * 512 + h * 64 + 8 * (lane >> 5);
#pragma unroll
        for (int kk = 0; kk < 4; ++kk) {
          uint4 t = ld16(src + kk * 16);
          af[kk] = *reinterpret_cast<bf16x8*>(&t);
        }
      }
      float wsc[16];
#pragma unroll
      for (int q = 0; q < 4; ++q) {
        float4 t = *reinterpret_cast<const float4*>(WI + (size_t)(tok0 + q) * 8 + 4 * (lane >> 5));
        const float s = 0.125f * 0.35355339059327373f;
        wsc[4 * q] = t.x * s; wsc[4 * q + 1] = t.y * s; wsc[4 * q + 2] = t.z * s; wsc[4 * q + 3] = t.w * s;
      }
      int ntile = nk >> 5;
      const u16* kbase = KI + (size_t)seqbase * 64;
      for (int t0 = wave; t0 < ntile; t0 += 32) {
        uint4 kb[8][4];
#pragma unroll
        for (int j = 0; j < 8; ++j) {
          int tile = t0 + 4 * j;
          if (tile < ntile) {
            const u16* kr = kbase + ((size_t)(tile * 8 + (lane >> 5)) * 32 + (lane & 31)) * 8;
#pragma unroll
            for (int kk = 0; kk < 4; ++kk) kb[j][kk] = ld16(kr + kk * 2 * 256);
          }
        }
        __builtin_amdgcn_sched_barrier(0);
#pragma unroll
        for (int j = 0; j < 8; ++j) {
          int tile = t0 + 4 * j;
          if (tile < ntile) {
            f32x16 acc;
#pragma unroll
            for (int r = 0; r < 16; ++r) acc[r] = 0.f;
#pragma unroll
            for (int kk = 0; kk < 4; ++kk)
              acc = __builtin_amdgcn_mfma_f32_32x32x16_bf16(af[kk], *reinterpret_cast<bf16x8*>(&kb[j][kk]), acc, 0, 0, 0);
            float sq[4];
#pragma unroll
            for (int q = 0; q < 4; ++q) {
              float sv = 0.f;
#pragma unroll
              for (int rr = 0; rr < 4; ++rr) sv += fmaxf(acc[4 * q + rr], 0.f) * wsc[4 * q + rr];
              sv += __shfl_xor(sv, 32);
              sq[q] = sv;
            }
            if (lane < 32) {
#pragma unroll
              for (int q = 0; q < 4; ++q) sc[q * SC_LD + tile * 32 + lane] = sq[q];
            }
          }
        }
      }
    }
    __syncthreads();
    {
      int token = tok0 + wave;
      u16* sel = SEL + (size_t)token * 256;
      if (nk <= 256) {
        for (int i = lane; i < 256; i += 64) sel[i] = (u16)(i < nk ? i : 0);
        if (lane == 0) CNT[token] = nk;
      } else {
        const float* s = sc + wave * SC_LD;
        unsigned* hist = histall + wave * 256;
        unsigned prefix = 0, mask = 0;
        unsigned need = 256;
        for (int shift = 24; shift >= 0; shift -= 8) {
          for (int i = lane; i < 256; i += 64) hist[i] = 0;
          __builtin_amdgcn_s_waitcnt(0xc07f);
          for (int e0 = lane * 4; e0 < nk; e0 += 256) {
            float4 v4 = *reinterpret_cast<const float4*>(s + e0);
            unsigned u0 = f2key(v4.x), u1 = f2key(v4.y), u2 = f2key(v4.z), u3 = f2key(v4.w);
            if ((u0 & mask) == prefix) atomicAdd(&hist[(u0 >> shift) & 255u], 1u);
            if ((u1 & mask) == prefix) atomicAdd(&hist[(u1 >> shift) & 255u], 1u);
            if ((u2 & mask) == prefix) atomicAdd(&hist[(u2 >> shift) & 255u], 1u);
            if ((u3 & mask) == prefix) atomicAdd(&hist[(u3 >> shift) & 255u], 1u);
          }
          __builtin_amdgcn_s_waitcnt(0xc07f);
          __builtin_amdgcn_wave_barrier();
          unsigned h0 = hist[4 * lane], h1 = hist[4 * lane + 1], h2 = hist[4 * lane + 2], h3 = hist[4 * lane + 3];
          unsigned loc = h0 + h1 + h2 + h3;
          unsigned suf = loc;
#pragma unroll
          for (int d = 1; d < 64; d <<= 1) {
            unsigned t = __shfl_down(suf, d);
            if (lane + d < 64) suf += t;
          }
          unsigned above = suf - loc;
          bool cross = (above < need) && (need <= above + loc);
          unsigned long long bal = __ballot(cross);
          int src = __ffsll((long long)bal) - 1;
          unsigned binsel = 0, newneed = 0;
          if (cross) {
            unsigned cum = above;
            if (cum + h3 >= need) { binsel = 4 * lane + 3; newneed = need - cum; }
            else {
              cum += h3;
              if (cum + h2 >= need) { binsel = 4 * lane + 2; newneed = need - cum; }
              else {
                cum += h2;
                if (cum + h1 >= need) { binsel = 4 * lane + 1; newneed = need - cum; }
                else { cum += h1; binsel = 4 * lane; newneed = need - cum; }
              }
            }
          }
          binsel = __shfl(binsel, src);
          newneed = __shfl(newneed, src);
          prefix |= binsel << shift;
          mask |= 255u << shift;
          need = newneed;
          __builtin_amdgcn_wave_barrier();
        }
        const unsigned T = prefix;
        const unsigned long long lt = (1ull << lane) - 1ull;
        int base = 0, eqtaken = 0;
        for (int i0 = 0; i0 < nk; i0 += 256) {
          int e0 = i0 + lane * 4;
          bool in = e0 < nk;
          float4 v4 = in ? *reinterpret_cast<const float4*>(s + e0) : make_float4(0.f, 0.f, 0.f, 0.f);
          unsigned u[4] = {f2key(v4.x), f2key(v4.y), f2key(v4.z), f2key(v4.w)};
          bool eq[4], gt[4];
          int eqbefore = 0;
#pragma unroll
          for (int j = 0; j < 4; ++j) {
            gt[j] = in && (u[j] > T);
            eq[j] = in && (u[j] == T);
          }
          unsigned long long be[4];
          int eqtot = 0;
#pragma unroll
          for (int j = 0; j < 4; ++j) {
            be[j] = __ballot(eq[j]);
            eqbefore += __popcll(be[j] & lt);
            eqtot += __popcll(be[j]);
          }
          bool take[4];
          int mine_eq = 0;
#pragma unroll
          for (int j = 0; j < 4; ++j) {
            int eqrank = eqtaken + eqbefore + mine_eq;
            take[j] = gt[j] || (eq[j] && eqrank < (int)need);
            mine_eq += eq[j] ? 1 : 0;
          }
          int tkbefore = 0, tktot = 0;
#pragma unroll
          for (int j = 0; j < 4; ++j) {
            unsigned long long bt = __ballot(take[j]);
            tkbefore += __popcll(bt & lt);
            tktot += __popcll(bt);
          }
          int pos = base + tkbefore;
#pragma unroll
          for (int j = 0; j < 4; ++j) {
            if (take[j]) {
              if (pos < 256) sel[pos] = (u16)(e0 + j);
              ++pos;
            }
          }
          base += tktot;
          eqtaken += eqtot;
        }
        if (lane == 0) CNT[token] = 256;
      }
    }
  }
}

__device__ __forceinline__ void load_v_round(const u16* __restrict__ VB, const int* sidx, int rd, int kvh, int lane, uint4 (&vv)[8]) {
#pragma unroll
  for (int i = 0; i < 8; ++i) {
    int pid = lane + 64 * i;
    int rowl = pid >> 3, piece = pid & 7;
    int row = sidx[64 * rd + rowl];
    unsigned off = (unsigned)row * 512u + (unsigned)(kvh * 128 + piece * 16);
    vv[i] = ld16(reinterpret_cast<const char*>(VB) + off);
  }
}

template <int RD>
__device__ __forceinline__ void pv_round(const u16* __restrict__ VB, const int* sidx, int kvh, int lane, u16* Vs,
                                         uint4 (&vv)[8], f32x4 (&sacc)[16], float inv, f32x4 (&oacc)[4]) {
  const int g = lane >> 4, n = lane & 15;
  uint4 vn[8];
  if (RD < 3) load_v_round(VB, sidx, RD + 1, kvh, lane, vn);
  __builtin_amdgcn_sched_barrier(0);
  __builtin_amdgcn_wave_barrier();
#pragma unroll
  for (int i = 0; i < 8; ++i) {
    int pid = lane + 64 * i;
    int rowl = pid >> 3, piece = pid & 7;
    *reinterpret_cast<uint4*>(&Vs[rowl * LDV + piece * 8]) = vv[i];
  }
  __builtin_amdgcn_s_waitcnt(0xc07f);
  __builtin_amdgcn_wave_barrier();
#pragma unroll
  for (int ch = 0; ch < 2; ++ch) {
    constexpr int tb = 4 * RD;
    const int t0 = tb + 2 * ch;
    uint4 pa;
    pa.x = pack2(sacc[t0][0] * inv, sacc[t0][1] * inv);
    pa.y = pack2(sacc[t0][2] * inv, sacc[t0][3] * inv);
    pa.z = pack2(sacc[t0 + 1][0] * inv, sacc[t0 + 1][1] * inv);
    pa.w = pack2(sacc[t0 + 1][2] * inv, sacc[t0 + 1][3] * inv);
    bf16x8 afrag = *reinterpret_cast<bf16x8*>(&pa);
    int qq = n >> 2, pp = n & 3;
    int lr0 = 32 * ch + 4 * g + qq;
#pragma unroll
    for (int nt = 0; nt < 4; ++nt) {
      typedef __attribute__((address_space(3))) s16x4* lds_s4p;
      s16x4 r0 = __builtin_amdgcn_ds_read_tr16_b64_v4i16((lds_s4p)(&Vs[lr0 * LDV + 16 * nt + 4 * pp]));
      s16x4 r1 = __builtin_amdgcn_ds_read_tr16_b64_v4i16((lds_s4p)(&Vs[(lr0 + 16) * LDV + 16 * nt + 4 * pp]));
      uint4 bw;
      bw.x = (unsigned)(u16)r0[0] | ((unsigned)(u16)r0[1] << 16);
      bw.y = (unsigned)(u16)r0[2] | ((unsigned)(u16)r0[3] << 16);
      bw.z = (unsigned)(u16)r1[0] | ((unsigned)(u16)r1[1] << 16);
      bw.w = (unsigned)(u16)r1[2] | ((unsigned)(u16)r1[3] << 16);
      oacc[nt] = __builtin_amdgcn_mfma_f32_16x16x32_bf16(afrag, *reinterpret_cast<bf16x8*>(&bw), oacc[nt], 0, 0, 0);
    }
  }
  __builtin_amdgcn_wave_barrier();
  __builtin_amdgcn_sched_barrier(0);
  if (RD < 3) {
#pragma unroll
    for (int i = 0; i < 8; ++i) vv[i] = vn[i];
  }
}

__device__ __forceinline__ void phase_attn(const Params& p, char* smem) {
  const u16* QB = reinterpret_cast<const u16*>(p.ws + R_QB);
  const u16* KB = reinterpret_cast<const u16*>(p.ws + R_KB);
  const u16* VB = reinterpret_cast<const u16*>(p.ws + R_VB);
  const u16* SEL = reinterpret_cast<const u16*>(p.ws + R_SEL);
  const int* CNT = reinterpret_cast<const int*>(p.ws + R_CNT);
  u16* OB = reinterpret_cast<u16*>(p.ws + R_OB);
  const int tid = threadIdx.x, lane = tid & 63, wave = tid >> 6;
  const int g = lane >> 4, n = lane & 15;
  u16* Vs = reinterpret_cast<u16*>(smem) + wave * (64 * LDV);
  int* sidx2 = reinterpret_cast<int*>(smem + 4 * 64 * LDV * 2);
  const int kvh = wave;
  auto seqbase_of = [](int token) -> int {
    return token < NPR ? (token >> 12) * 4096 : NPR + ((token - NPR) >> 5) * 4128;
  };
  const int xq = blockIdx.x & 7, lbq = blockIdx.x >> 3, nlq = gridDim.x >> 3;
  auto token_of = [=](int it) -> int {
    return it < 32 ? NPR + xq * 32 + it : (xq >> 1) * 4096 + 2 * (it - 32) + (xq & 1);
  };
  int cur = 0, cnt_cur = 0;
  __syncthreads();
  if (lbq < 2080) {
    int t0 = token_of(lbq);
    cnt_cur = CNT[t0];
    sidx2[tid] = seqbase_of(t0) + (int)SEL[(size_t)t0 * 256 + tid];
  }
  __syncthreads();
  for (int it = lbq; it < 2080; it += nlq) {
    const int token = token_of(it);
    const int* sidx = sidx2 + cur * 256;
    const int cnt = cnt_cur;
    const int itn = it + nlq;
    const int tnext = itn < 2080 ? token_of(itn) : -1;
    int nsel = 0, ncnt = 0;
    if (tnext >= 0) {
      nsel = (int)SEL[(size_t)tnext * 256 + tid];
      ncnt = CNT[tnext];
    }
    bf16x8 qf[2];
    {
      uint4 t0 = zero4(), t1 = zero4();
      if (n < 4) {
        const u16* q = QB + (size_t)token * 1024 + (kvh * 4 + n) * 64 + 8 * g;
        t0 = ld16(q);
        t1 = ld16(q + 32);
      }
      qf[0] = *reinterpret_cast<bf16x8*>(&t0);
      qf[1] = *reinterpret_cast<bf16x8*>(&t1);
    }
    f32x4 sacc[16];
#pragma unroll
    for (int hb = 0; hb < 2; ++hb) {
      uint4 ka[8][2];
#pragma unroll
      for (int t = 0; t < 8; ++t) {
        int row = sidx[16 * (hb * 8 + t) + n];
        unsigned off = (unsigned)row * 512u + (unsigned)(kvh * 128 + 16 * g);
        ka[t][0] = ld16(reinterpret_cast<const char*>(KB) + off);
        ka[t][1] = ld16(reinterpret_cast<const char*>(KB) + off + 64u);
      }
      __builtin_amdgcn_sched_barrier(0);
#pragma unroll
      for (int t = 0; t < 8; ++t) {
        f32x4 acc = {0.f, 0.f, 0.f, 0.f};
        acc = __builtin_amdgcn_mfma_f32_16x16x32_bf16(*reinterpret_cast<bf16x8*>(&ka[t][0]), qf[0], acc, 0, 0, 0);
        acc = __builtin_amdgcn_mfma_f32_16x16x32_bf16(*reinterpret_cast<bf16x8*>(&ka[t][1]), qf[1], acc, 0, 0, 0);
        sacc[hb * 8 + t] = acc;
      }
      __builtin_amdgcn_sched_barrier(0);
    }
    uint4 vv[8];
    load_v_round(VB, sidx, 0, kvh, lane, vv);
    __builtin_amdgcn_sched_barrier(0);
    float m = -3.0e38f;
    if (cnt < 256) {
#pragma unroll
      for (int t = 0; t < 16; ++t)
#pragma unroll
        for (int r = 0; r < 4; ++r) {
          int slot = 16 * t + 4 * g + r;
          if (slot >= cnt) sacc[t][r] = -3.0e38f;
        }
    }
#pragma unroll
    for (int t = 0; t < 16; ++t)
#pragma unroll
      for (int r = 0; r < 4; ++r) m = fmaxf(m, sacc[t][r]);
    m = fmaxf(m, __shfl_xor(m, 16));
    m = fmaxf(m, __shfl_xor(m, 32));
    const float cexp = 0.125f * 1.4426950408889634f;
    const float mc = -m * cexp;
    float sum = 0.f;
#pragma unroll
    for (int t = 0; t < 16; ++t)
#pragma unroll
      for (int r = 0; r < 4; ++r) {
        float e = __builtin_amdgcn_exp2f(fmaf(sacc[t][r], cexp, mc));
        sacc[t][r] = e;
        sum += e;
      }
    sum += __shfl_xor(sum, 16);
    sum += __shfl_xor(sum, 32);
    const float inv = 1.f / sum;
    f32x4 oacc[4];
#pragma unroll
    for (int nt = 0; nt < 4; ++nt) oacc[nt] = (f32x4){0.f, 0.f, 0.f, 0.f};
    pv_round<0>(VB, sidx, kvh, lane, Vs, vv, sacc, 1.f, oacc);
    pv_round<1>(VB, sidx, kvh, lane, Vs, vv, sacc, 1.f, oacc);
    pv_round<2>(VB, sidx, kvh, lane, Vs, vv, sacc, 1.f, oacc);
    pv_round<3>(VB, sidx, kvh, lane, Vs, vv, sacc, 1.f, oacc);
    {
      float i0 = __shfl(inv, 0), i1 = __shfl(inv, 1), i2 = __shfl(inv, 2), i3 = __shfl(inv, 3);
#pragma unroll
      for (int nt = 0; nt < 4; ++nt) {
        oacc[nt][0] *= i0; oacc[nt][1] *= i1; oacc[nt][2] *= i2; oacc[nt][3] *= i3;
      }
    }
    if (lane < 16) {
#pragma unroll
      for (int nt = 0; nt < 4; ++nt)
#pragma unroll
        for (int r = 0; r < 4; ++r)
          OB[(size_t)token * 1024 + (kvh * 4 + r) * 64 + 16 * nt + lane] = f2bf(oacc[nt][r]);
    }
    if (tnext >= 0) sidx2[(cur ^ 1) * 256 + tid] = seqbase_of(tnext) + nsel;
    cnt_cur = ncnt;
    cur ^= 1;
    __syncthreads();
  }
}


#define XB_TMO      128
#define XB_XCNT(j)  (256  + 64 * (j))
#define XB_XSUB(j)  (1280 + 64 * (j))
#define XB_XGEN(j)  (2304 + 64 * (j))
#define XB_TOP      3328
#define XB_TOPGEN   3392
#define XCD_BAR_WORDS 3456
#define XB_SPIN_CAP (1u << 18)
#define LAS __attribute__((address_space(3)))

__device__ __forceinline__ unsigned xb_ld(unsigned* p) { return __hip_atomic_load(p, __ATOMIC_RELAXED, __HIP_MEMORY_SCOPE_AGENT); }
__device__ __forceinline__ unsigned xb_add(unsigned* p, unsigned v) { return __hip_atomic_fetch_add(p, v, __ATOMIC_RELAXED, __HIP_MEMORY_SCOPE_AGENT); }
__device__ __forceinline__ unsigned xb_xcc_id() { return (unsigned)__builtin_amdgcn_s_getreg((3 << 11) | 20) & 0xFu; }
#define XB_SPIN(cond, bar) do { unsigned _sp = 0; while (cond) { __builtin_amdgcn_s_sleep(1); \
    if ((++_sp & 255u) == 0u) { if (xb_ld(&(bar)[XB_TMO])) break; if (_sp > XB_SPIN_CAP) { atomicAdd(&(bar)[XB_TMO], 1u); break; } } } } while (0)

struct XcdBarrier {
  unsigned* bar; unsigned x;
  volatile LAS unsigned* st;
};
__device__ __forceinline__ XcdBarrier xcd_barrier_post(unsigned* bar, volatile LAS unsigned* st) {
  XcdBarrier b; b.bar = bar; b.x = xb_xcc_id(); b.st = st;
  if (threadIdx.x == 0) (void)xb_add(&bar[XB_XCNT(b.x)], 1u);
  return b;
}
__device__ __forceinline__ void xcd_barrier_complete(unsigned* bar, unsigned x, unsigned& nloc, unsigned& nx) {
  const unsigned G = gridDim.x * gridDim.y * gridDim.z;
  unsigned sum, cnt, mine, sp = 0u;
  for (;;) {
    sum = 0u; cnt = 0u; mine = 0u;
#pragma unroll
    for (unsigned j = 0; j < 16; ++j) { const unsigned c = xb_ld(&bar[XB_XCNT(j)]); sum += c; cnt += (c > 0u) ? 1u : 0u; mine = (j == x) ? c : mine; }
    if (sum == G) break;
    __builtin_amdgcn_s_sleep(1);
    if ((++sp & 255u) == 0u) { if (xb_ld(&bar[XB_TMO])) break; if (sp > XB_SPIN_CAP) { atomicAdd(&bar[XB_TMO], 1u); break; } }
  }
  nloc = mine > 0u ? mine : 1u; nx = cnt > 0u ? cnt : 1u;
}
__device__ __forceinline__ void xcd_barrier(const XcdBarrier& b) {
  asm volatile("s_waitcnt vmcnt(0)" ::: "memory");
  __syncthreads();
  if (threadIdx.x == 0) {
    unsigned* bar = b.bar;
    __builtin_amdgcn_s_waitcnt(0);
    unsigned nloc = b.st[0], nx = b.st[1];
    if (nloc == 0u) { xcd_barrier_complete(bar, b.x, nloc, nx); b.st[0] = nloc; b.st[1] = nx; }
    const unsigned old = xb_add(&bar[XB_XSUB(b.x)], 1u);
    const unsigned gen = old / nloc;
    if (old + 1u == (gen + 1u) * nloc) {
      __builtin_amdgcn_fence(__ATOMIC_RELEASE, "agent");
      asm volatile("s_waitcnt vmcnt(0)" ::: "memory");
      const unsigned og = xb_add(&bar[XB_TOP], 1u);
      const unsigned tg = og / nx;
      if (og + 1u == (tg + 1u) * nx) xb_add(&bar[XB_TOPGEN], 1u);
      else XB_SPIN(xb_ld(&bar[XB_TOPGEN]) == tg, bar);
      __builtin_amdgcn_fence(__ATOMIC_ACQUIRE, "agent");
      xb_add(&bar[XB_XGEN(b.x)], 1u);
      asm volatile("s_waitcnt vmcnt(0)" ::: "memory");
    } else {
      XB_SPIN(xb_ld(&bar[XB_XGEN(b.x)]) == gen, bar);
      __builtin_amdgcn_fence(__ATOMIC_ACQUIRE, "agent");
      asm volatile("s_waitcnt vmcnt(0)" ::: "memory");
    }
  }
  __syncthreads();
}

__global__ void __launch_bounds__(256, 2) mega(Params p) {
  __shared__ __attribute__((aligned(16))) char smem[SMEM_BYTES];
  __shared__ uint4 xb_words;
  if (threadIdx.x == 0) xb_words = make_uint4(0u, 0u, 0u, 0u);
  __syncthreads();
  XcdBarrier xb = xcd_barrier_post(reinterpret_cast<unsigned*>(p.ws + R_BAR), (volatile LAS unsigned*)&xb_words);
  if (p.use_cg) cg::this_grid().sync();
  phase0(p, smem);
  xcd_barrier(xb);
  phase1(p, smem);
  xcd_barrier(xb);
  phase2(p);
  xcd_barrier(xb);
  phase3(p, smem);
  xcd_barrier(xb);
  phase4(p, smem);
  xcd_barrier(xb);
  phase_norm(p, p.norm_ffn, false);
  xcd_barrier(xb);
  phase_up(p, 0, smem);
  xcd_barrier(xb);
  phase_resid_gemm(p, (const u16*)(p.ws + R_GT), (const u16*)(p.ws + W_DN), 2816, smem);
  xcd_barrier(xb);
  phase_norm(p, p.norm_mix + 1024, true);
  xcd_barrier(xb);
  phase_win(p, smem);
  xcd_barrier(xb);
  phase_index(p, smem);
  xcd_barrier(xb);
  phase_attn(p, smem);
  xcd_barrier(xb);
  phase_resid_gemm(p, (const u16*)(p.ws + R_OB), (const u16*)(p.ws + W_O), 1024, smem);
  xcd_barrier(xb);
  phase_norm(p, p.norm_ffn + 1024, false);
  xcd_barrier(xb);
  phase_up(p, 1, smem);
  xcd_barrier(xb);
  phase_resid_gemm(p, (const u16*)(p.ws + R_GT), (const u16*)(p.ws + W_DN) + (size_t)1024 * 2816, 2816, smem);
}

extern "C" void kernel_launch(void* const* d_in, const int* in_sizes, int n_in, void* d_out, int out_size, void* d_ws,
                              size_t ws_size, hipStream_t stream) {
  static int grid_blocks = 0;
  if (!grid_blocks) {
    int dev = 0, cus = 0, per_cu = 0;
    hipGetDevice(&dev);
    hipDeviceGetAttribute(&cus, hipDeviceAttributeMultiprocessorCount, dev);
    hipOccupancyMaxActiveBlocksPerMultiprocessor(&per_cu, mega, 256, 0);
    if (per_cu > 2) per_cu = 2;
    if (per_cu < 1) per_cu = 1;
    grid_blocks = cus * per_cu;
  }
  Params p{};
  const float** pf = reinterpret_cast<const float**>(&p);
  for (int i = 0; i < 28; ++i) pf[i] = reinterpret_cast<const float*>(d_in[i]);
  p.out = reinterpret_cast<float*>(d_out);
  p.ws = reinterpret_cast<char*>(d_ws);
  if (ws_size < WS_NEED) fprintf(stderr, "workspace too small: %zu < %zu\n", ws_size, (size_t)WS_NEED);
  p.use_cg = 0;
  p.pad0 = 0;
  hipMemsetAsync(reinterpret_cast<char*>(d_ws) + R_BAR, 0, 16384 + 4096, stream);
  void* args[] = {&p};
  hipError_t e = hipLaunchCooperativeKernel((void*)mega, dim3(grid_blocks), dim3(256), args, 0, stream);
  if (e != hipSuccess) fprintf(stderr, "cooperative launch failed: %s (grid %d)\n", hipGetErrorString(e), grid_blocks);
}
```

```cpp
#include <hip/hip_runtime.h>
#include <hip/hip_cooperative_groups.h>
#include <stdint.h>
#include <cstdio>
namespace cg = cooperative_groups;

typedef unsigned short u16;
typedef __attribute__((ext_vector_type(8))) __bf16 bf16x8;
typedef __attribute__((ext_vector_type(4))) short s16x4;
typedef __attribute__((ext_vector_type(16))) float f32x16;
typedef __attribute__((ext_vector_type(4))) float f32x4;

#define NTOK 16640
#define NPR 16384
#define LDSK 72
#define LDC 129
#define LDG 132
#define SC_LD 4128
#define SMEM_BYTES (73728)

#define O_SSM_RE_P 17039360
#define O_SSM_IM_P 17055744
#define O_SSM_RE_S 17072128
#define O_SSM_IM_S 17104896
#define O_K_P 17137664
#define O_V_P 21331968
#define O_KI_P 25526272
#define O_K_S 26574848
#define O_V_S 26640384
#define O_KI_S 26705920
#define O_CONV_P 26722304
#define O_CONV_S 26767360

constexpr size_t MB = 1ull << 20;
constexpr size_t W_GLU = 0;
constexpr size_t W_IN = W_GLU + 2048ull * 1024 * 2;
constexpr size_t W_O = W_IN + 2176ull * 1024 * 2;
constexpr size_t W_UP = W_O + 1024ull * 1024 * 2;
constexpr size_t W_DN = W_UP + 2ull * 5632 * 1024 * 2;
constexpr size_t R0 = W_DN + 2ull * 1024 * 2816 * 2;
constexpr size_t R_UG = R0;
constexpr size_t R_Z = R0 + 35 * MB;
constexpr size_t R_S = R0 + 70 * MB;
constexpr size_t R_HP = R0 + 88 * MB;
constexpr size_t R_W1 = R0 + 97 * MB;
constexpr size_t R_W3 = R0 + 106 * MB;
constexpr size_t R_KT = R0 + 115 * MB;
constexpr size_t R_AP = R0 + 117 * MB;
constexpr size_t R_BB = R0 + 119 * MB;
constexpr size_t R_HN = R0;
constexpr size_t R_GT = R0 + 35 * MB;
constexpr size_t R_OB = R0;
constexpr size_t R_QB = R0 + 35 * MB;
constexpr size_t R_KB = R0 + 70 * MB;
constexpr size_t R_VB = R0 + 96 * MB;
constexpr size_t R_QI = R0 + 122 * MB;
constexpr size_t R_KI = R0 + 140 * MB;
constexpr size_t R_WI = R0 + 147 * MB;
constexpr size_t R_SEL = R0 + 148 * MB;
constexpr size_t R_CNT = R0 + 157 * MB;
constexpr size_t R_BAR = R0 + 158 * MB;
constexpr size_t R_ZERO = R_BAR + 16384;
constexpr size_t WS_NEED = R0 + 159 * MB;

struct Params {
  const float *x_prompt, *x_sample, *st_re, *st_im, *cache_k, *cache_v, *cache_kidx, *cache_conv;
  const float *norm_mix, *norm_ffn, *lam_re, *lam_im, *log_dt, *b_re, *b_im, *c_re, *c_im, *ssm_d, *w_glu, *b_glu;
  const float *w_in, *q_norm, *k_norm, *w_o, *w_up, *conv_w, *conv_b, *w_down;
  float* out;
  char* ws;
  int use_cg;
  int pad0;
};

typedef __attribute__((ext_vector_type(2))) __bf16 bf16x2_t;
__device__ __forceinline__ u16 f2bf(float f) {
  __bf16 h = (__bf16)f;
  return __builtin_bit_cast(u16, h);
}
__device__ __forceinline__ float bf2f(u16 h) { return __uint_as_float(((unsigned)h) << 16); }
__device__ __forceinline__ unsigned pack2(float a, float b) {
  bf16x2_t v;
  v[0] = (__bf16)a;
  v[1] = (__bf16)b;
  return __builtin_bit_cast(unsigned, v);
}
__device__ __forceinline__ float gelu_tanh(float x) {
  const float k2 = -2.f * 0.7978845608028654f * 1.4426950408889634f;
  float x2 = x * x;
  float w = x * fmaf(x2, 0.044715f, 1.f);
  float e = __builtin_amdgcn_exp2f(w * k2);
  return x * __builtin_amdgcn_rcpf(1.f + e);
}
__device__ __forceinline__ float sigmoid_fast(float x) {
  return __builtin_amdgcn_rcpf(1.f + __builtin_amdgcn_exp2f(x * -1.4426950408889634f));
}
__device__ __forceinline__ uint4 zero4() { return make_uint4(0u, 0u, 0u, 0u); }
__device__ __forceinline__ uint4 ld16(const void* p) { return *reinterpret_cast<const uint4*>(p); }

template <class LA, class LB, class KM>
__device__ __forceinline__ void gemm_core(LA la, LB lb, KM kmap, int nkt, char* smem) {
  u16* sA = reinterpret_cast<u16*>(smem);
  u16* sB = sA + 128 * LDSK;
  const int tid = threadIdx.x, lane = tid & 63, wave = tid >> 6;
  const int wm = wave >> 1, wn = wave & 1;
  const int lr = tid >> 3, kc = (tid & 7) * 8;
  f32x16 acc[2][2];
#pragma unroll
  for (int i = 0; i < 2; ++i)
#pragma unroll
    for (int j = 0; j < 2; ++j)
#pragma unroll
      for (int r = 0; r < 16; ++r) acc[i][j][r] = 0.f;
  uint4 ra[4], rb[4];
  {
    int k0 = kmap(0);
#pragma unroll
    for (int i = 0; i < 4; ++i) {
      ra[i] = la(lr + 32 * i, k0 + kc);
      rb[i] = lb(lr + 32 * i, k0 + kc);
    }
  }
#pragma unroll 1
  for (int kt = 0; kt < nkt; ++kt) {
    __syncthreads();
#pragma unroll
    for (int i = 0; i < 4; ++i) {
      *reinterpret_cast<uint4*>(&sA[(lr + 32 * i) * LDSK + kc]) = ra[i];
      *reinterpret_cast<uint4*>(&sB[(lr + 32 * i) * LDSK + kc]) = rb[i];
    }
    __syncthreads();
    if (kt + 1 < nkt) {
      int k1 = kmap(kt + 1);
#pragma unroll
      for (int i = 0; i < 4; ++i) {
        ra[i] = la(lr + 32 * i, k1 + kc);
        rb[i] = lb(lr + 32 * i, k1 + kc);
      }
    }
#pragma unroll
    for (int kk = 0; kk < 4; ++kk) {
      bf16x8 af[2], bfr[2];
#pragma unroll
      for (int mi = 0; mi < 2; ++mi)
        af[mi] = *reinterpret_cast<const bf16x8*>(&sA[(wm * 64 + mi * 32 + (lane & 31)) * LDSK + kk * 16 + (lane >> 5) * 8]);
#pragma unroll
      for (int ni = 0; ni < 2; ++ni)
        bfr[ni] = *reinterpret_cast<const bf16x8*>(&sB[(wn * 64 + ni * 32 + (lane & 31)) * LDSK + kk * 16 + (lane >> 5) * 8]);
#pragma unroll
      for (int mi = 0; mi < 2; ++mi)
#pragma unroll
        for (int ni = 0; ni < 2; ++ni)
          acc[mi][ni] = __builtin_amdgcn_mfma_f32_32x32x16_bf16(af[mi], bfr[ni], acc[mi][ni], 0, 0, 0);
    }
  }
  __syncthreads();
  float* sC = reinterpret_cast<float*>(smem);
#pragma unroll
  for (int mi = 0; mi < 2; ++mi)
#pragma unroll
    for (int ni = 0; ni < 2; ++ni)
#pragma unroll
      for (int r = 0; r < 16; ++r) {
        int row = wm * 64 + mi * 32 + (r & 3) + 8 * (r >> 2) + 4 * (lane >> 5);
        int col = wn * 64 + ni * 32 + (lane & 31);
        sC[row * LDC + col] = acc[mi][ni][r];
      }
  __syncthreads();
}


struct TileSched {
  int i, end, step;
  __device__ __forceinline__ TileSched(int T) {
    int nx = gridDim.x >> 3;
    int x = blockIdx.x & 7, lb = blockIdx.x >> 3;
    int c0 = (int)((long long)T * x / 8);
    end = (int)((long long)T * (x + 1) / 8);
    i = c0 + lb;
    step = nx;
  }
};
__device__ __forceinline__ void tile_decode(int i, int MT, int NT, int& mt, int& nt) {
  int gsz = 8 * NT;
  int g8 = i / gsz;
  int rem = i - g8 * gsz;
  int mrows = min(8, MT - 8 * g8);
  nt = rem / mrows;
  mt = 8 * g8 + (rem - nt * mrows);
}

struct KOff {
  int base;
  __device__ __forceinline__ int operator()(int kt) const { return base + kt * 64; }
};
struct KIdent {
  __device__ __forceinline__ int operator()(int kt) const { return kt * 64; }
};

__device__ __forceinline__ void transpose_job(const float* __restrict__ src, u16* __restrict__ dst, int K, int N, int kt, int nt, char* smem) {
  float* tile = reinterpret_cast<float*>(smem);
  const int tid = threadIdx.x;
  __syncthreads();
  {
    int c4 = (tid & 15) * 4;
    int n = nt * 64 + c4;
#pragma unroll
    for (int i = 0; i < 4; ++i) {
      int kr = (tid >> 4) + 16 * i;
      float4 v = make_float4(0.f, 0.f, 0.f, 0.f);
      if (n < N) v = *reinterpret_cast<const float4*>(src + (size_t)(kt * 64 + kr) * N + n);
      tile[kr * 65 + c4 + 0] = v.x;
      tile[kr * 65 + c4 + 1] = v.y;
      tile[kr * 65 + c4 + 2] = v.z;
      tile[kr * 65 + c4 + 3] = v.w;
    }
  }
  __syncthreads();
  {
    int nr = tid >> 2, kch = (tid & 3) * 16;
    unsigned w[8];
#pragma unroll
    for (int i = 0; i < 8; ++i) w[i] = pack2(tile[(kch + 2 * i) * 65 + nr], tile[(kch + 2 * i + 1) * 65 + nr]);
    u16* d = dst + (size_t)(nt * 64 + nr) * K + kt * 64 + kch;
    *reinterpret_cast<uint4*>(d) = make_uint4(w[0], w[1], w[2], w[3]);
    *reinterpret_cast<uint4*>(d + 8) = make_uint4(w[4], w[5], w[6], w[7]);
  }
}

__device__ __forceinline__ const float* xrow_in(const Params& p, int row) {
  return row < NPR ? p.x_prompt + (size_t)row * 1024 : p.x_sample + (size_t)(row - NPR) * 1024;
}

__device__ __forceinline__ void norm_ug_job(const Params& p, int job) {
  const int lane = threadIdx.x & 63, wave = threadIdx.x >> 6;
  int row = job * 4 + wave;
  if (row >= NTOK) return;
  const float* x = xrow_in(p, row) + lane * 16;
  float v[16];
#pragma unroll
  for (int i = 0; i < 4; ++i) {
    float4 t = *reinterpret_cast<const float4*>(x + 4 * i);
    v[4 * i] = t.x; v[4 * i + 1] = t.y; v[4 * i + 2] = t.z; v[4 * i + 3] = t.w;
  }
  float ss = 0.f;
#pragma unroll
  for (int i = 0; i < 16; ++i) ss += v[i] * v[i];
#pragma unroll
  for (int d = 32; d >= 1; d >>= 1) ss += __shfl_xor(ss, d);
  float rs = rsqrtf(ss * (1.f / 1024.f) + 1e-6f);
  const float* g = p.norm_mix + lane * 16;
  unsigned w[8];
#pragma unroll
  for (int i = 0; i < 8; ++i) w[i] = pack2(v[2 * i] * rs * g[2 * i], v[2 * i + 1] * rs * g[2 * i + 1]);
  u16* ug = reinterpret_cast<u16*>(p.ws + R_UG) + ((size_t)lane * NTOK + row) * 16;
  *reinterpret_cast<uint4*>(ug) = make_uint4(w[0], w[1], w[2], w[3]);
  *reinterpret_cast<uint4*>(ug + 8) = make_uint4(w[4], w[5], w[6], w[7]);
}

__device__ __forceinline__ void norm_hn_job(const Params& p, const float* __restrict__ X, const float* __restrict__ gw, int job) {
  const int lane = threadIdx.x & 63, wave = threadIdx.x >> 6;
  const int row0 = job * 16 + wave * 4;
  float4 t[4][4];
#pragma unroll
  for (int rr = 0; rr < 4; ++rr) {
    const float* x = X + (size_t)(row0 + rr) * 1024;
#pragma unroll
    for (int i = 0; i < 4; ++i) t[rr][i] = *reinterpret_cast<const float4*>(x + 4 * lane + 256 * i);
  }
  float4 g[4];
#pragma unroll
  for (int i = 0; i < 4; ++i) g[i] = *reinterpret_cast<const float4*>(gw + 4 * lane + 256 * i);
#pragma unroll
  for (int rr = 0; rr < 4; ++rr) {
    float ss = 0.f;
#pragma unroll
    for (int i = 0; i < 4; ++i) ss += t[rr][i].x * t[rr][i].x + t[rr][i].y * t[rr][i].y + t[rr][i].z * t[rr][i].z + t[rr][i].w * t[rr][i].w;
#pragma unroll
    for (int d = 32; d >= 1; d >>= 1) ss += __shfl_xor(ss, d);
    float rs = rsqrtf(ss * (1.f / 1024.f) + 1e-6f);
    u16* hn = reinterpret_cast<u16*>(p.ws + R_HN) + (size_t)(row0 + rr) * 1024;
#pragma unroll
    for (int i = 0; i < 4; ++i) {
      uint2 o;
      o.x = pack2(t[rr][i].x * rs * g[i].x, t[rr][i].y * rs * g[i].y);
      o.y = pack2(t[rr][i].z * rs * g[i].z, t[rr][i].w * rs * g[i].w);
      *reinterpret_cast<uint2*>(hn + 4 * lane + 256 * i) = o;
    }
  }
}

__device__ __forceinline__ void s5_table_job(const Params& p, int job) {
  int t = job * 256 + threadIdx.x;
  int c = t & 15, pp = (t >> 4) & 63, g = t >> 10;
  float lre = fminf(p.lam_re[g * 64 + pp], -1e-4f);
  float lim = p.lam_im[g * 64 + pp];
  float dt = expf(p.log_dt[g]);
  float mag = expf(lre * dt);
  float sn, cs;
  sincosf(lim * dt, &sn, &cs);
  float are = mag * cs, aim = mag * sn;
  float den = lre * lre + lim * lim;
  float nre = are - 1.f;
  float fre = (nre * lre + aim * lim) / den;
  float fim = (aim * lre - nre * lim) / den;
  float br = p.b_re[(g * 64 + pp) * 16 + c], bi = p.b_im[(g * 64 + pp) * 16 + c];
  float bbr = fre * br - fim * bi;
  float bbi = fre * bi + fim * br;
  float* bb = reinterpret_cast<float*>(p.ws + R_BB) + ((size_t)(g * 64 + pp) * 16 + c) * 2;
  bb[0] = bbr; bb[1] = bbi;
  u16* W1 = reinterpret_cast<u16*>(p.ws + R_W1) + (size_t)g * 128 * 512;
  float pr = 1.f, pi = 0.f;
  for (int n = 0; n < 32; ++n) {
    int i = 31 - n;
    W1[(size_t)pp * 512 + i * 16 + c] = f2bf(pr * bbr - pi * bbi);
    W1[(size_t)(64 + pp) * 512 + i * 16 + c] = f2bf(pr * bbi + pi * bbr);
    float nr = pr * are - pi * aim, ni = pr * aim + pi * are;
    pr = nr; pi = ni;
  }
  if (c == 0) {
    float* ap = reinterpret_cast<float*>(p.ws + R_AP) + (size_t)(g * 64 + pp) * 66;
    float qr = 1.f, qi = 0.f;
    for (int n = 0; n <= 32; ++n) {
      ap[2 * n] = qr; ap[2 * n + 1] = qi;
      float nr = qr * are - qi * aim, ni = qr * aim + qi * are;
      qr = nr; qi = ni;
    }
  }
}

__device__ __forceinline__ void phase0(const Params& p, char* smem) {
  const int NJ_T = 5536, NJ_N = 4160, NJ_S = 256;
  for (int job = blockIdx.x; job < NJ_S + NJ_N + NJ_T; job += gridDim.x) {
    if (job < NJ_S) {
      s5_table_job(p, job);
    } else if (job < NJ_S + NJ_N) {
      norm_ug_job(p, job - NJ_S);
    } else {
      int j = job - NJ_S - NJ_N;
      const float* src; u16* dst; int K, N, ntn;
      if (j < 512) { src = p.w_glu; dst = (u16*)(p.ws + W_GLU); K = 1024; N = 2048; ntn = 32; }
      else if (j < 1056) { j -= 512; src = p.w_in; dst = (u16*)(p.ws + W_IN); K = 1024; N = 2120; ntn = 34; }
      else if (j < 1312) { j -= 1056; src = p.w_o; dst = (u16*)(p.ws + W_O); K = 1024; N = 1024; ntn = 16; }
      else if (j < 2720) { j -= 1312; src = p.w_up; dst = (u16*)(p.ws + W_UP); K = 1024; N = 5632; ntn = 88; }
      else if (j < 4128) { j -= 2720; src = p.w_up + (size_t)1024 * 5632; dst = (u16*)(p.ws + W_UP) + (size_t)5632 * 1024; K = 1024; N = 5632; ntn = 88; }
      else if (j < 4832) { j -= 4128; src = p.w_down; dst = (u16*)(p.ws + W_DN); K = 2816; N = 1024; ntn = 16; }
      else { j -= 4832; src = p.w_down + (size_t)2816 * 1024; dst = (u16*)(p.ws + W_DN) + (size_t)1024 * 2816; K = 2816; N = 1024; ntn = 16; }
      transpose_job(src, dst, K, N, j / ntn, j % ntn, smem);
    }
  }
}

__device__ __forceinline__ void phase1(const Params& p, char* smem) {
  const int NT_G = 320, NJ_K = 2048, NJ_W = 8192;
  const u16* UG = reinterpret_cast<const u16*>(p.ws + R_UG);
  const u16* W1 = reinterpret_cast<const u16*>(p.ws + R_W1);
  float* S = reinterpret_cast<float*>(p.ws + R_S);
  const float* AP = reinterpret_cast<const float*>(p.ws + R_AP);
  const float* BB = reinterpret_cast<const float*>(p.ws + R_BB);
  for (int job = blockIdx.x; job < NT_G + NJ_K + NJ_W; job += gridDim.x) {
    if (job < NT_G) {
      int g = job / 5, mt = job % 5;
      const u16* ug = UG + (size_t)g * NTOK * 16;
      const u16* w1 = W1 + (size_t)g * 128 * 512;
      auto la = [=](int r, int k) -> uint4 {
        int col = mt * 128 + r;
        return col < 520 ? ld16(ug + (size_t)col * 512 + k) : zero4();
      };
      auto lb = [=](int n, int k) -> uint4 { return ld16(w1 + (size_t)n * 512 + k); };
      gemm_core(la, lb, KIdent(), 8, smem);
      const float* sC = reinterpret_cast<const float*>(smem);
      {
        const int cg = threadIdx.x & 31, r0 = threadIdx.x >> 5;
#pragma unroll
        for (int i = 0; i < 16; ++i) {
          int r = r0 + 8 * i;
          int col = mt * 128 + r;
          const float* c = sC + r * LDC + 4 * cg;
          if (col < 520) *reinterpret_cast<float4*>(&S[((size_t)col * 64 + g) * 128 + 4 * cg]) = make_float4(c[0], c[1], c[2], c[3]);
        }
      }
    } else if (job < NT_G + NJ_K) {
      int t = (job - NT_G) * 256 + threadIdx.x;
      int c = t & 15, cp = (t >> 4) & 15, tau = (t >> 8) & 31, g = t >> 13;
      float acc = 0.f;
#pragma unroll 16
      for (int pp = 0; pp < 64; ++pp) {
        float cr = p.c_re[(g * 16 + cp) * 64 + pp], ci = p.c_im[(g * 16 + cp) * 64 + pp];
        const float* bb = BB + ((size_t)(g * 64 + pp) * 16 + c) * 2;
        const float* ap = AP + (size_t)(g * 64 + pp) * 66 + 2 * tau;
        float br = bb[0], bi = bb[1];
        float ar = ap[0], ai = ap[1];
        float xr = br * ar - bi * ai, xi = br * ai + bi * ar;
        acc += cr * xr - ci * xi;
      }
      reinterpret_cast<u16*>(p.ws + R_KT)[t] = f2bf(acc);
    } else {
      int t = (job - NT_G - NJ_K) * 256 + threadIdx.x;
      int pp = t & 63, cp = (t >> 6) & 15, j = (t >> 10) & 31, g = t >> 15;
      float cr = p.c_re[(g * 16 + cp) * 64 + pp], ci = p.c_im[(g * 16 + cp) * 64 + pp];
      const float* ap = AP + (size_t)(g * 64 + pp) * 66 + 2 * (j + 1);
      float ar = ap[0], ai = ap[1];
      float vr = cr * ar - ci * ai, vi = cr * ai + ci * ar;
      u16* W3 = reinterpret_cast<u16*>(p.ws + R_W3) + ((size_t)g * 512 + j * 16 + cp) * 128;
      W3[pp] = f2bf(vr);
      W3[64 + pp] = f2bf(-vi);
    }
  }
}

__device__ __forceinline__ void phase2(const Params& p) {
  const float* S = reinterpret_cast<const float*>(p.ws + R_S);
  u16* HP = reinterpret_cast<u16*>(p.ws + R_HP);
  const float* AP = reinterpret_cast<const float*>(p.ws + R_AP);
  for (int job = blockIdx.x; job < 192; job += gridDim.x) {
    int t = job * 256 + threadIdx.x;
    if (t < 16384) {
      int pp = t & 63, g = (t >> 6) & 63, b = t >> 12;
      float ar = AP[(size_t)(g * 64 + pp) * 66 + 64], ai = AP[(size_t)(g * 64 + pp) * 66 + 65];
      float hr = 0.f, hi = 0.f;
      for (int c0 = 0; c0 < 128; c0 += 16) {
        float sr[16], si[16];
#pragma unroll
        for (int u = 0; u < 16; ++u) {
          size_t o = ((size_t)(b * 128 + c0 + u) * 64 + g) * 128 + pp;
          sr[u] = S[o]; si[u] = S[o + 64];
        }
#pragma unroll
        for (int u = 0; u < 16; ++u) {
          size_t o = ((size_t)(b * 128 + c0 + u) * 64 + g) * 128 + pp;
          HP[o] = f2bf(hr);
          HP[o + 64] = f2bf(hi);
          float nr = ar * hr - ai * hi + sr[u];
          float ni = ar * hi + ai * hr + si[u];
          hr = nr; hi = ni;
        }
      }
      p.out[O_SSM_RE_P + (b * 64 + g) * 64 + pp] = hr;
      p.out[O_SSM_IM_P + (b * 64 + g) * 64 + pp] = hi;
    } else {
      int u = t - 16384;
      int pp = u & 63, g = (u >> 6) & 63, b = u >> 12;
      float ar = AP[(size_t)(g * 64 + pp) * 66 + 64], ai = AP[(size_t)(g * 64 + pp) * 66 + 65];
      float hr = p.st_re[(b * 64 + g) * 64 + pp], hi = p.st_im[(b * 64 + g) * 64 + pp];
      size_t o = ((size_t)(512 + b) * 64 + g) * 128 + pp;
      HP[o] = f2bf(hr);
      HP[o + 64] = f2bf(hi);
      float nr = ar * hr - ai * hi + S[o];
      float ni = ar * hi + ai * hr + S[o + 64];
      p.out[O_SSM_RE_S + (b * 64 + g) * 64 + pp] = nr;
      p.out[O_SSM_IM_S + (b * 64 + g) * 64 + pp] = ni;
    }
  }
}

struct KMapS3 {
  int nlow;
  __device__ __forceinline__ int operator()(int kt) const { return kt < nlow ? kt * 64 : 512 + (kt - nlow) * 64; }
};

__device__ __forceinline__ void phase3(const Params& p, char* smem) {
  const u16* UG = reinterpret_cast<const u16*>(p.ws + R_UG);
  const u16* HP = reinterpret_cast<const u16*>(p.ws + R_HP);
  const u16* KT = reinterpret_cast<const u16*>(p.ws + R_KT);
  const u16* W3 = reinterpret_cast<const u16*>(p.ws + R_W3);
  u16* Z = reinterpret_cast<u16*>(p.ws + R_Z);
  for (int job = blockIdx.x; job < 1280; job += gridDim.x) {
    int nt = 3 - (job & 3);
    int mt = (job >> 2) % 5, g = job / 20;
    const u16* ug = UG + (size_t)g * NTOK * 16;
    auto la = [=](int r, int k) -> uint4 {
      int col = mt * 128 + r;
      if (col >= 520) return zero4();
      if (k < 512) return ld16(ug + (size_t)col * 512 + k);
      return ld16(HP + ((size_t)col * 64 + g) * 128 + (k - 512));
    };
    auto lb = [=](int nl, int k) -> uint4 {
      int n = nt * 128 + nl;
      if (k < 512) {
        int j = n >> 4, cp = n & 15, i = k >> 4, c0 = k & 15;
        if (j < i) return zero4();
        return ld16(KT + ((size_t)(g * 32 + (j - i)) * 16 + cp) * 16 + c0);
      }
      return ld16(W3 + ((size_t)g * 512 + n) * 128 + (k - 512));
    };
    KMapS3 km; km.nlow = 2 * (nt + 1);
    gemm_core(la, lb, km, km.nlow + 2, smem);
    const float* sC = reinterpret_cast<const float*>(smem);
    {
      const int cg = threadIdx.x & 31, r0 = threadIdx.x >> 5;
      const int n = nt * 128 + 4 * cg;
      const int j = n >> 4, cp = n & 15;
      const float4 dv = *reinterpret_cast<const float4*>(p.ssm_d + g * 16 + cp);
      uint2 uv[16];
#pragma unroll
      for (int i = 0; i < 16; ++i) {
        int col = mt * 128 + r0 + 8 * i;
        uv[i] = make_uint2(0u, 0u);
        if (col < 520) uv[i] = *reinterpret_cast<const uint2*>(ug + (size_t)(col * 32 + j) * 16 + cp);
      }
#pragma unroll
      for (int i = 0; i < 16; ++i) {
        int r = r0 + 8 * i;
        int col = mt * 128 + r;
        if (col < 520) {
          const float* c = sC + r * LDC + 4 * cg;
          float y0 = c[0] + dv.x * __uint_as_float(uv[i].x << 16);
          float y1 = c[1] + dv.y * __uint_as_float(uv[i].x & 0xffff0000u);
          float y2 = c[2] + dv.z * __uint_as_float(uv[i].y << 16);
          float y3 = c[3] + dv.w * __uint_as_float(uv[i].y & 0xffff0000u);
          uint2 o;
          o.x = pack2(gelu_tanh(y0), gelu_tanh(y1));
          o.y = pack2(gelu_tanh(y2), gelu_tanh(y3));
          *reinterpret_cast<uint2*>(Z + (size_t)(col * 32 + j) * 1024 + g * 16 + cp) = o;
        }
      }
    }
  }
}


#define LDK2 40
#define STAGE2 (384 * LDK2)
template <bool HALO, class LA, class LB, class EPI>
__device__ __forceinline__ void gemm256(LA la, LB lb, EPI epi, int nk, char* smem) {
  u16* sbuf = reinterpret_cast<u16*>(smem);
  const int tid = threadIdx.x, lane = tid & 63, wave = tid >> 6;
  const int wm = wave >> 1, wn = wave & 1;
  const int lrow = tid >> 2, kc = (tid & 3) * 8;
  f32x16 acc[4][2];
#pragma unroll
  for (int i = 0; i < 4; ++i)
#pragma unroll
    for (int j = 0; j < 2; ++j)
#pragma unroll
      for (int r = 0; r < 16; ++r) acc[i][j][r] = 0.f;
  uint4 ra[4], rb[2];
#pragma unroll
  for (int i = 0; i < 4; ++i) ra[i] = la(lrow + 64 * i, kc);
#pragma unroll
  for (int i = 0; i < 2; ++i) rb[i] = lb(lrow + 64 * i, kc);
  __syncthreads();
#pragma unroll
  for (int i = 0; i < 4; ++i) *reinterpret_cast<uint4*>(&sbuf[(lrow + 64 * i) * LDK2 + kc]) = ra[i];
#pragma unroll
  for (int i = 0; i < 2; ++i) *reinterpret_cast<uint4*>(&sbuf[(256 + lrow + 64 * i) * LDK2 + kc]) = rb[i];
  if (nk > 1) {
#pragma unroll
    for (int i = 0; i < 4; ++i) ra[i] = la(lrow + 64 * i, 32 + kc);
#pragma unroll
    for (int i = 0; i < 2; ++i) rb[i] = lb(lrow + 64 * i, 32 + kc);
  }
#pragma unroll 1
  for (int kt = 0; kt < nk; ++kt) {
    __syncthreads();
    const u16* cA = sbuf + (kt & 1) * STAGE2;
    const u16* cB = cA + 256 * LDK2;
    u16* nA = sbuf + ((kt + 1) & 1) * STAGE2;
    {
      bf16x8 af[4], bfr[2];
#pragma unroll
      for (int mi = 0; mi < 4; ++mi)
        af[mi] = *reinterpret_cast<const bf16x8*>(&cA[(wm * 128 + mi * 32 + (lane & 31)) * LDK2 + (lane >> 5) * 8]);
#pragma unroll
      for (int ni = 0; ni < 2; ++ni)
        bfr[ni] = *reinterpret_cast<const bf16x8*>(&cB[(wn * 64 + ni * 32 + (lane & 31)) * LDK2 + (lane >> 5) * 8]);
#pragma unroll
      for (int mi = 0; mi < 4; ++mi)
#pragma unroll
        for (int ni = 0; ni < 2; ++ni)
          acc[mi][ni] = __builtin_amdgcn_mfma_f32_32x32x16_bf16(af[mi], bfr[ni], acc[mi][ni], 0, 0, 0);
    }
    if (kt + 1 < nk) {
#pragma unroll
      for (int i = 0; i < 4; ++i) *reinterpret_cast<uint4*>(&nA[(lrow + 64 * i) * LDK2 + kc]) = ra[i];
#pragma unroll
      for (int i = 0; i < 2; ++i) *reinterpret_cast<uint4*>(&nA[(256 + lrow + 64 * i) * LDK2 + kc]) = rb[i];
      if (kt + 2 < nk) {
        int k2 = (kt + 2) * 32 + kc;
#pragma unroll
        for (int i = 0; i < 4; ++i) ra[i] = la(lrow + 64 * i, k2);
#pragma unroll
        for (int i = 0; i < 2; ++i) rb[i] = lb(lrow + 64 * i, k2);
      }
    }
    {
      bf16x8 af[4], bfr[2];
#pragma unroll
      for (int mi = 0; mi < 4; ++mi)
        af[mi] = *reinterpret_cast<const bf16x8*>(&cA[(wm * 128 + mi * 32 + (lane & 31)) * LDK2 + 16 + (lane >> 5) * 8]);
#pragma unroll
      for (int ni = 0; ni < 2; ++ni)
        bfr[ni] = *reinterpret_cast<const bf16x8*>(&cB[(wn * 64 + ni * 32 + (lane & 31)) * LDK2 + 16 + (lane >> 5) * 8]);
#pragma unroll
      for (int mi = 0; mi < 4; ++mi)
#pragma unroll
        for (int ni = 0; ni < 2; ++ni)
          acc[mi][ni] = __builtin_amdgcn_mfma_f32_32x32x16_bf16(af[mi], bfr[ni], acc[mi][ni], 0, 0, 0);
    }
  }
  float* sC = reinterpret_cast<float*>(smem);
#pragma unroll
  for (int h = 0; h < 2; ++h) {
    __syncthreads();
#pragma unroll
    for (int m2 = 0; m2 < 2; ++m2)
#pragma unroll
      for (int ni = 0; ni < 2; ++ni)
#pragma unroll
        for (int r = 0; r < 16; ++r) {
          int j = m2 * 32 + (r & 3) + 8 * (r >> 2) + 4 * (lane >> 5);
          int col = wn * 64 + ni * 32 + (lane & 31);
          sC[(wm * 66 + 2 + j) * LDC + col] = acc[2 * h + m2][ni][r];
        }
    if (HALO) {
      if (h == 0) {
        if (wm == 0 && lane >= 32) {
#pragma unroll
          for (int ni = 0; ni < 2; ++ni) {
            int col = wn * 64 + ni * 32 + (lane & 31);
            sC[(66 + 0) * LDC + col] = acc[3][ni][14];
            sC[(66 + 1) * LDC + col] = acc[3][ni][15];
          }
        }
      } else {
        if (lane >= 32) {
#pragma unroll
          for (int ni = 0; ni < 2; ++ni) {
            int col = wn * 64 + ni * 32 + (lane & 31);
            sC[(wm * 66 + 0) * LDC + col] = acc[1][ni][14];
            sC[(wm * 66 + 1) * LDC + col] = acc[1][ni][15];
          }
        }
      }
    }
    __syncthreads();
    epi(h, sC);
  }
}


#define GSTAGE_B (384 * 64)
#define WAITV(n) asm volatile("s_waitcnt vmcnt(%0)" ::"n"(n) : "memory")
#define RAWBAR() do { asm volatile("s_waitcnt lgkmcnt(0)" ::: "memory"); __builtin_amdgcn_s_barrier(); } while (0)
template <bool HALO, class PA, class PB, class EPI>
__device__ __forceinline__ void gemm256g(const u16* baseA, const u16* baseB, PA pa, PB pb, EPI epi, int nk, char* smem) {
  const int tid = threadIdx.x, lane = tid & 63, wave = tid >> 6;
  const int wm = wave >> 1, wn = wave & 1;
  const int lrow = tid >> 2, cpos = tid & 3;
  f32x16 acc[4][2];
#pragma unroll
  for (int i = 0; i < 4; ++i)
#pragma unroll
    for (int j = 0; j < 2; ++j)
#pragma unroll
      for (int r = 0; r < 16; ++r) acc[i][j][r] = 0.f;
  const int koff = 8 * (cpos ^ ((lrow >> 2) & 3));
  unsigned offA[4], offB[2];
#pragma unroll
  for (int i = 0; i < 4; ++i) offA[i] = (pa(lrow + 64 * i) + koff) * 2u;
#pragma unroll
  for (int i = 0; i < 2; ++i) offB[i] = (pb(lrow + 64 * i) + koff) * 2u;
  auto issue = [&](int kt, int st) {
    char* base = smem + st * GSTAGE_B;
    const unsigned kb = kt * 64;
#pragma unroll
    for (int i = 0; i < 4; ++i)
      __builtin_amdgcn_global_load_lds((const unsigned*)(reinterpret_cast<const char*>(baseA) + (size_t)(offA[i] + kb)),
                                       (unsigned*)(base + (lrow + 64 * i) * 64 + cpos * 16), 16, 0, 0);
#pragma unroll
    for (int i = 0; i < 2; ++i)
      __builtin_amdgcn_global_load_lds((const unsigned*)(reinterpret_cast<const char*>(baseB) + (size_t)(offB[i] + kb)),
                                       (unsigned*)(base + (256 + lrow + 64 * i) * 64 + cpos * 16), 16, 0, 0);
  };
  WAITV(0);
  __syncthreads();
  issue(0, 0);
  if (nk > 1) issue(1, 1);
  if (nk > 2) issue(2, 2);
  if (nk > 2) WAITV(12); else if (nk > 1) WAITV(6); else WAITV(0);
  RAWBAR();
  const int sw = ((lane & 31) >> 2) & 3;
  const unsigned lds0 = (unsigned)(size_t)((__attribute__((address_space(3))) char*)smem);
  const unsigned ra_off = lds0 + (wm * 128 + (lane & 31)) * 64;
  const unsigned rb_off = lds0 + (256 + wn * 64 + (lane & 31)) * 64;
  const unsigned ph0 = (((lane >> 5)) ^ sw) * 16, ph1 = ((2 + (lane >> 5)) ^ sw) * 16;
#define GR6(F, aA, aB)                                                                                              \
  asm volatile("ds_read_b128 %0, %6\n\tds_read_b128 %4, %7\n\tds_read_b128 %1, %6 offset:2048\n\t"                 \
               "ds_read_b128 %5, %7 offset:2048\n\tds_read_b128 %2, %6 offset:4096\n\tds_read_b128 %3, %6 offset:6144" \
               : "=&v"(F[0]), "=&v"(F[1]), "=&v"(F[2]), "=&v"(F[3]), "=&v"(F[4]), "=&v"(F[5])                       \
               : "v"(aA), "v"(aB)                                                                                   \
               : "memory")
#define GW(n, F)                                                                                                    \
  asm volatile("s_waitcnt lgkmcnt(" #n ")"                                                                          \
               : "+v"(F[0]), "+v"(F[1]), "+v"(F[2]), "+v"(F[3]), "+v"(F[4]), "+v"(F[5])::"memory")
#define GMMA(F)                                                                                                     \
  _Pragma("unroll") for (int mi = 0; mi < 4; ++mi) _Pragma("unroll") for (int ni = 0; ni < 2; ++ni)                 \
      acc[mi][ni] = __builtin_amdgcn_mfma_f32_32x32x16_bf16(F[mi], F[4 + ni], acc[mi][ni], 0, 0, 0)
  bf16x8 F0[6], F1[6];
  {
    const unsigned aA = ra_off + ph0, aB = rb_off + ph0;
    GR6(F0, aA, aB);
  }
  int st = 0;
#pragma unroll 1
  for (int kt = 0; kt < nk; ++kt) {
    const unsigned sb = st * GSTAGE_B;
    {
      const unsigned aA = sb + ra_off + ph1, aB = sb + rb_off + ph1;
      GR6(F1, aA, aB);
    }
    GW(6, F0);
    __builtin_amdgcn_sched_barrier(0);
    GMMA(F0);
    __builtin_amdgcn_sched_barrier(0);
    GW(0, F1);
    if (kt + 1 < nk) { if (kt + 2 < nk) WAITV(6); else WAITV(0); }
    __builtin_amdgcn_s_barrier();
    __builtin_amdgcn_sched_barrier(0);
    int st1 = st + 1; if (st1 >= 3) st1 = 0;
    if (kt + 1 < nk) {
      const unsigned aA = st1 * GSTAGE_B + ra_off + ph0, aB = st1 * GSTAGE_B + rb_off + ph0;
      GR6(F0, aA, aB);
    }
    if (kt + 3 < nk) issue(kt + 3, st);
    __builtin_amdgcn_sched_barrier(0);
    GMMA(F1);
    __builtin_amdgcn_sched_barrier(0);
    st = st1;
  }
  asm volatile("s_waitcnt lgkmcnt(0)" ::: "memory");
  float* sC = reinterpret_cast<float*>(smem);
#pragma unroll
  for (int h = 0; h < 2; ++h) {
    __syncthreads();
#pragma unroll
    for (int m2 = 0; m2 < 2; ++m2)
#pragma unroll
      for (int ni = 0; ni < 2; ++ni)
#pragma unroll
        for (int r = 0; r < 16; ++r) {
          int j = m2 * 32 + (r & 3) + 8 * (r >> 2) + 4 * (lane >> 5);
          int col = wn * 64 + ni * 32 + (lane & 31);
          sC[(wm * 66 + 2 + j) * LDG + col] = acc[2 * h + m2][ni][r];
        }
    if (HALO) {
      if (h == 0) {
        if (wm == 0 && lane >= 32) {
#pragma unroll
          for (int ni = 0; ni < 2; ++ni) {
            int col = wn * 64 + ni * 32 + (lane & 31);
            sC[(66 + 0) * LDG + col] = acc[3][ni][14];
            sC[(66 + 1) * LDG + col] = acc[3][ni][15];
          }
        }
      } else {
        if (lane >= 32) {
#pragma unroll
          for (int ni = 0; ni < 2; ++ni) {
            int col = wn * 64 + ni * 32 + (lane & 31);
            sC[(wm * 66 + 0) * LDG + col] = acc[1][ni][14];
            sC[(wm * 66 + 1) * LDG + col] = acc[1][ni][15];
          }
        }
      }
    }
    __syncthreads();
    epi(h, sC);
  }
}

__device__ __forceinline__ float4 ld4f(const float* p, bool vec) {
  if (vec) return *reinterpret_cast<const float4*>(p);
  return make_float4(p[0], p[1], p[2], p[3]);
}
template <bool SPLIT>
__device__ __forceinline__ int epi_srow(int v) { return SPLIT ? (v >> 6) * 66 + 2 + (v & 63) : v; }
template <bool SPLIT>
__device__ __forceinline__ int epi_grow(int v, int row0, int h) { return SPLIT ? row0 + 128 * (v >> 6) + 64 * h + (v & 63) : row0 + v; }

template <bool SPLIT>
__device__ __forceinline__ void glu_epi(const Params& p, const float* sC, int row0, int h, int n0) {
  float* X = p.out;
  const int cg = threadIdx.x & 15, r0 = threadIdx.x >> 4;
  const float4 b1 = *reinterpret_cast<const float4*>(p.b_glu + n0 + 4 * cg);
  const float4 b2 = *reinterpret_cast<const float4*>(p.b_glu + 1024 + n0 + 4 * cg);
#pragma unroll
  for (int hh = 0; hh < 2; ++hh) {
    float4 xv[4];
#pragma unroll
    for (int i = 0; i < 4; ++i) xv[i] = *reinterpret_cast<const float4*>(xrow_in(p, epi_grow<SPLIT>(r0 + 16 * (hh * 4 + i), row0, h)) + n0 + 4 * cg);
#pragma unroll
    for (int i = 0; i < 4; ++i) {
      int v = r0 + 16 * (hh * 4 + i);
      const float* c = sC + epi_srow<SPLIT>(v) * (SPLIT ? LDG : LDC) + 4 * cg;
      const float4 g1 = ld4f(c, SPLIT), g2 = ld4f(c + 64, SPLIT);
      float4 o;
      o.x = xv[i].x + (g1.x + b1.x) * sigmoid_fast(g2.x + b2.x);
      o.y = xv[i].y + (g1.y + b1.y) * sigmoid_fast(g2.y + b2.y);
      o.z = xv[i].z + (g1.z + b1.z) * sigmoid_fast(g2.z + b2.z);
      o.w = xv[i].w + (g1.w + b1.w) * sigmoid_fast(g2.w + b2.w);
      *reinterpret_cast<float4*>(X + (size_t)epi_grow<SPLIT>(v, row0, h) * 1024 + n0 + 4 * cg) = o;
    }
  }
}
template <bool SPLIT>
__device__ __forceinline__ void resid_epi(const Params& p, const float* sC, int row0, int h, int col0) {
  const int cg = threadIdx.x & 31, r0 = threadIdx.x >> 5;
  float* xb = p.out + col0 + 4 * cg;
#pragma unroll
  for (int half = 0; half < 2; ++half) {
    float4 xv[8];
#pragma unroll
    for (int i = 0; i < 8; ++i) xv[i] = *reinterpret_cast<const float4*>(xb + (size_t)epi_grow<SPLIT>(r0 + 8 * (half * 8 + i), row0, h) * 1024);
#pragma unroll
    for (int i = 0; i < 8; ++i) {
      int v = r0 + 8 * (half * 8 + i);
      const float4 cv = ld4f(sC + epi_srow<SPLIT>(v) * (SPLIT ? LDG : LDC) + 4 * cg, SPLIT);
      float4 o = make_float4(xv[i].x + cv.x, xv[i].y + cv.y, xv[i].z + cv.z, xv[i].w + cv.w);
      *reinterpret_cast<float4*>(xb + (size_t)epi_grow<SPLIT>(v, row0, h) * 1024) = o;
    }
  }
}

__device__ __forceinline__ void phase4(const Params& p, char* smem) {
  const u16* Z = reinterpret_cast<const u16*>(p.ws + R_Z);
  const u16* W = reinterpret_cast<const u16*>(p.ws + W_GLU);
  for (TileSched ts(64 * 16); ts.i < ts.end; ts.i += ts.step) {
    int mt, nt;
    tile_decode(ts.i, 64, 16, mt, nt);
    int n0 = nt * 64;
    auto la = [=](int r) -> unsigned { return (unsigned)(mt * 256 + r) * 1024u; };
    auto lb = [=](int nl) -> unsigned {
      int nrow = nl < 64 ? n0 + nl : 1024 + n0 + nl - 64;
      return (unsigned)nrow * 1024u;
    };
    auto epi = [&](int h, const float* sC) { glu_epi<true>(p, sC, mt * 256, h, n0); };
    gemm256g<false>(Z, W, la, lb, epi, 32, smem);
  }
  for (int job = blockIdx.x; job < 32; job += gridDim.x) {
    int mt = 128 + (job >> 4), nt = job & 15;
    int n0 = nt * 64;
    auto la = [=](int r, int k) -> uint4 { return ld16(Z + (size_t)(mt * 128 + r) * 1024 + k); };
    auto lb = [=](int nl, int k) -> uint4 {
      int nrow = nl < 64 ? n0 + nl : 1024 + n0 + nl - 64;
      return ld16(W + (size_t)nrow * 1024 + k);
    };
    gemm_core(la, lb, KIdent(), 16, smem);
    glu_epi<false>(p, reinterpret_cast<const float*>(smem), mt * 128, 0, n0);
  }
}


__device__ __forceinline__ size_t ki_off(int row, int kc) { return ((size_t)((row >> 5) * 8 + kc) * 32 + (row & 31)) * 8; }

__device__ __forceinline__ void phase_norm(const Params& p, const float* gw, bool conv_caches) {
  int nj = 1040 + (conv_caches ? (4096 + 4096 + 1024) : 0);
  if (blockIdx.x == 0 && threadIdx.x < 128) *reinterpret_cast<uint4*>(reinterpret_cast<u16*>(p.ws + R_HN) + (size_t)NTOK * 1024 + threadIdx.x * 8) = zero4();
  for (int job = blockIdx.x; job < nj; job += gridDim.x) {
    if (job < 1040) {
      norm_hn_job(p, p.out, gw, job);
    } else {
      int j = job - 1040;
      if (j < 8192) {
        const float* src = j < 4096 ? p.cache_k : p.cache_v;
        u16* dst = reinterpret_cast<u16*>(p.ws + (j < 4096 ? R_KB : R_VB));
        int jj = j & 4095;
        size_t e = ((size_t)jj * 256 + threadIdx.x) * 8;
        int b = (int)(e >> 20);
        size_t within = e & ((1u << 20) - 1);
        float4 a = *reinterpret_cast<const float4*>(src + e);
        float4 c = *reinterpret_cast<const float4*>(src + e + 4);
        uint4 o = make_uint4(pack2(a.x, a.y), pack2(a.z, a.w), pack2(c.x, c.y), pack2(c.z, c.w));
        *reinterpret_cast<uint4*>(dst + ((size_t)NPR + (size_t)b * 4128) * 256 + within) = o;
      } else {
        int jj = j - 8192;
        size_t e = ((size_t)jj * 256 + threadIdx.x) * 8;
        int b = (int)(e >> 18);
        size_t within = e & ((1u << 18) - 1);
        float4 a = *reinterpret_cast<const float4*>(p.cache_kidx + e);
        float4 c = *reinterpret_cast<const float4*>(p.cache_kidx + e + 4);
        uint4 o = make_uint4(pack2(a.x, a.y), pack2(a.z, a.w), pack2(c.x, c.y), pack2(c.z, c.w));
        {
          int row = NPR + b * 4128 + (int)(within >> 6), kc = (int)((within & 63) >> 3);
          *reinterpret_cast<uint4*>(reinterpret_cast<u16*>(p.ws + R_KI) + ki_off(row, kc)) = o;
        }
      }
    }
  }
}

__device__ __forceinline__ void phase_up(const Params& p, int layer, char* smem) {
  const u16* HN = reinterpret_cast<const u16*>(p.ws + R_HN);
  const u16* W = reinterpret_cast<const u16*>(p.ws + W_UP) + (size_t)layer * 5632 * 1024;
  u16* GT = reinterpret_cast<u16*>(p.ws + R_GT);
  const float* cw = p.conv_w + (size_t)layer * 3 * 2816;
  const float* cb = p.conv_b + (size_t)layer * 2816;
  for (TileSched ts(69 * 44); ts.i < ts.end; ts.i += ts.step) {
    int mt, nt;
    tile_decode(ts.i, 69, 44, mt, nt);
    const int n0 = nt * 64;
    const bool prompt = mt < 68;
    const int s = mt / 17, it = mt - s * 17;
    const int tbase = 254 * it - 2;
    const int rbase = prompt ? s * 4096 : NPR;
    auto la = [=](int r) -> unsigned {
      if (prompt) {
        int tp = tbase + r;
        if (tp < 0 || tp >= 4096) return (unsigned)NTOK * 1024u;
        return (unsigned)(rbase + tp) * 1024u;
      }
      return (unsigned)(rbase + r) * 1024u;
    };
    auto lb = [=](int nl) -> unsigned {
      int nrow = nl < 64 ? n0 + nl : 2816 + n0 + nl - 64;
      return (unsigned)nrow * 1024u;
    };
    auto epi = [&](int h, const float* sC) {
      const int cg = threadIdx.x & 15, r0 = threadIdx.x >> 4;
      const int col = n0 + 4 * cg;
      const float4 w0 = *reinterpret_cast<const float4*>(cw + col);
      const float4 w1 = *reinterpret_cast<const float4*>(cw + 2816 + col);
      const float4 w2 = *reinterpret_cast<const float4*>(cw + 2 * 2816 + col);
      const float4 bb = *reinterpret_cast<const float4*>(cb + col);
#pragma unroll 1
      for (int i = 0; i < 8; ++i) {
        const int v = r0 + 16 * i;
        const int r = 128 * (v >> 6) + 64 * h + (v & 63);
        const int sr = (v >> 6) * 66 + 2 + (v & 63);
        const float* c = sC + sr * LDG + 4 * cg;
        float4 a0 = *reinterpret_cast<const float4*>(c);
        float4 bv = *reinterpret_cast<const float4*>(c + 64);
        float4 a1 = *reinterpret_cast<const float4*>(c - LDG);
        float4 a2 = *reinterpret_cast<const float4*>(c - 2 * LDG);
        size_t orow;
        bool doit;
        if (prompt) {
          int tp = tbase + r;
          doit = (r >= 2 && tp < 4096);
          orow = (size_t)(rbase + tp);
          if (doit && tp >= 4094)
            *reinterpret_cast<float4*>(p.out + O_CONV_P + ((size_t)(layer * 4 + s) * 2 + (tp - 4094)) * 2816 + col) = a0;
        } else {
          doit = true;
          int b = r >> 5, t = r & 31;
          const float* cc = p.cache_conv + ((size_t)(layer * 8 + b) * 2) * 2816 + col;
          if (t < 1) a1 = *reinterpret_cast<const float4*>(cc + 2816);
          if (t < 2) a2 = *reinterpret_cast<const float4*>(cc + (size_t)t * 2816);
          orow = (size_t)(rbase + r);
          if (t >= 30) *reinterpret_cast<float4*>(p.out + O_CONV_S + ((size_t)(layer * 8 + b) * 2 + (t - 30)) * 2816 + col) = a0;
        }
        if (doit) {
          float c0 = bb.x + w0.x * a2.x + w1.x * a1.x + w2.x * a0.x;
          float c1v = bb.y + w0.y * a2.y + w1.y * a1.y + w2.y * a0.y;
          float c2v = bb.z + w0.z * a2.z + w1.z * a1.z + w2.z * a0.z;
          float c3v = bb.w + w0.w * a2.w + w1.w * a1.w + w2.w * a0.w;
          uint2 o;
          o.x = pack2(gelu_tanh(c0) * bv.x, gelu_tanh(c1v) * bv.y);
          o.y = pack2(gelu_tanh(c2v) * bv.z, gelu_tanh(c3v) * bv.w);
          *reinterpret_cast<uint2*>(GT + orow * 2816 + col) = o;
        }
      }
    };
    gemm256g<true>(HN, W, la, lb, epi, 32, smem);
  }
}

__device__ __forceinline__ void phase_resid_gemm(const Params& p, const u16* A, const u16* W, int K, char* smem) {
  {
    const int nsplit = K / 256;
    for (int job = blockIdx.x; job < 16 * nsplit; job += gridDim.x) {
      int sp = job / 16, tl = job % 16;
      int mt = 128 + (tl >> 3), nt = tl & 7;
      auto la = [=](int r, int k) -> uint4 { return ld16(A + (size_t)(mt * 128 + r) * K + k); };
      auto lb = [=](int nl, int k) -> uint4 { return ld16(W + (size_t)(nt * 128 + nl) * K + k); };
      KOff ko; ko.base = sp * 256;
      gemm_core(la, lb, ko, 4, smem);
      const float* sC = reinterpret_cast<const float*>(smem);
      float* xb = p.out + (size_t)(mt * 128) * 1024 + nt * 128;
      for (int idx = threadIdx.x; idx < 128 * 128; idx += 256) {
        int r = idx >> 7, n = idx & 127;
        unsafeAtomicAdd(xb + (size_t)r * 1024 + n, sC[r * LDC + n]);
      }
    }
  }
  for (TileSched ts(64 * 8); ts.i < ts.end; ts.i += ts.step) {
    int mt, nt;
    tile_decode(ts.i, 64, 8, mt, nt);
    auto la = [=](int r) -> unsigned { return (unsigned)(mt * 256 + r) * (unsigned)K; };
    auto lb = [=](int nl) -> unsigned { return (unsigned)(nt * 128 + nl) * (unsigned)K; };
    auto epi = [&](int h, const float* sC) { resid_epi<true>(p, sC, mt * 256, h, nt * 128); };
    gemm256g<false>(A, W, la, lb, epi, K / 32, smem);
  }
}

__device__ __forceinline__ void rope16(float* v, int pos) {
  const float inv[8] = {1.000000000e+00f, 1.939227432e-01f, 3.760603070e-02f, 7.292664610e-03f,
                        1.414213562e-03f, 2.742481884e-04f, 5.318296098e-05f, 1.031338616e-05f};
  float fp = (float)pos;
#pragma unroll
  for (int i = 0; i < 8; ++i) {
    float ang = fp * inv[i];
    float kq = rintf(ang * 0.15915494309189535f);
    float red = fmaf(-kq, 6.28125f, ang);
    red = fmaf(-kq, 1.9353071795864769e-3f, red);
    float rev = red * 0.15915494309189535f;
    float sn = __builtin_amdgcn_sinf(rev), cs = __builtin_amdgcn_cosf(rev);
    float x1 = v[i], x2 = v[8 + i];
    v[i] = x1 * cs - x2 * sn;
    v[8 + i] = x2 * cs + x1 * sn;
  }
}

__device__ __forceinline__ void store64_bf16(u16* dst, const float* v) {
#pragma unroll
  for (int i = 0; i < 8; ++i) {
    uint4 o = make_uint4(pack2(v[8 * i], v[8 * i + 1]), pack2(v[8 * i + 2], v[8 * i + 3]),
                         pack2(v[8 * i + 4], v[8 * i + 5]), pack2(v[8 * i + 6], v[8 * i + 7]));
    *reinterpret_cast<uint4*>(dst + 8 * i) = o;
  }
}
__device__ __forceinline__ void store64_f32(float* dst, const float* v) {
#pragma unroll
  for (int i = 0; i < 16; ++i) *reinterpret_cast<float4*>(dst + 4 * i) = make_float4(v[4 * i], v[4 * i + 1], v[4 * i + 2], v[4 * i + 3]);
}

__device__ __forceinline__ void phase_win(const Params& p, char* smem) {
  const u16* HN = reinterpret_cast<const u16*>(p.ws + R_HN);
  const u16* W = reinterpret_cast<const u16*>(p.ws + W_IN);
  u16* QB = reinterpret_cast<u16*>(p.ws + R_QB);
  u16* KB = reinterpret_cast<u16*>(p.ws + R_KB);
  u16* VB = reinterpret_cast<u16*>(p.ws + R_VB);
  u16* QI = reinterpret_cast<u16*>(p.ws + R_QI);
  u16* KI = reinterpret_cast<u16*>(p.ws + R_KI);
  float* WI = reinterpret_cast<float*>(p.ws + R_WI);
  for (TileSched ts(130 * 17); ts.i < ts.end; ts.i += ts.step) {
    int mt, nt;
    tile_decode(ts.i, 130, 17, mt, nt);
    auto la = [=](int r, int k) -> uint4 { return ld16(HN + (size_t)(mt * 128 + r) * 1024 + k); };
    auto lb = [=](int nl, int k) -> uint4 { return ld16(W + (size_t)(nt * 128 + nl) * 1024 + k); };
    gemm_core(la, lb, KIdent(), 16, smem);
    const float* sC = reinterpret_cast<const float*>(smem);
    int r = threadIdx.x & 127, h = threadIdx.x >> 7;
    int cbase = nt * 128 + 64 * h;
    int row = mt * 128 + r;
    int pos, kvrow;
    if (row < NPR) { pos = row & 4095; kvrow = row; }
    else { int bs = (row - NPR) >> 5, t = (row - NPR) & 31; pos = 4096 + t; kvrow = NPR + bs * 4128 + 4096 + t; }
    if (cbase < 2112) {
      float v[64];
#pragma unroll
      for (int d = 0; d < 64; ++d) v[d] = sC[r * LDC + 64 * h + d];
      if (cbase < 1280) {
        float ss = 0.f;
#pragma unroll
        for (int d = 0; d < 64; ++d) ss += v[d] * v[d];
        float rs = rsqrtf(ss * (1.f / 64.f) + 1e-6f);
        const float* gw = cbase < 1024 ? p.q_norm : p.k_norm;
#pragma unroll
        for (int d = 0; d < 64; ++d) v[d] = v[d] * rs * gw[d];
      }
      if (cbase < 1280 || cbase >= 1536) rope16(v, pos);
      if (cbase < 1024) {
        store64_bf16(QB + (size_t)row * 1024 + cbase, v);
      } else if (cbase < 1280) {
        store64_bf16(KB + (size_t)kvrow * 256 + (cbase - 1024), v);
        float* o = row < NPR ? p.out + O_K_P + (size_t)row * 256 : p.out + O_K_S + (size_t)(row - NPR) * 256;
        store64_f32(o + (cbase - 1024), v);
      } else if (cbase < 1536) {
        store64_bf16(VB + (size_t)kvrow * 256 + (cbase - 1280), v);
        float* o = row < NPR ? p.out + O_V_P + (size_t)row * 256 : p.out + O_V_S + (size_t)(row - NPR) * 256;
        store64_f32(o + (cbase - 1280), v);
      } else if (cbase < 2048) {
        store64_bf16(QI + (size_t)row * 512 + (cbase - 1536), v);
      } else {
#pragma unroll
        for (int kc = 0; kc < 8; ++kc) {
          uint4 o = make_uint4(pack2(v[8 * kc], v[8 * kc + 1]), pack2(v[8 * kc + 2], v[8 * kc + 3]),
                               pack2(v[8 * kc + 4], v[8 * kc + 5]), pack2(v[8 * kc + 6], v[8 * kc + 7]));
          *reinterpret_cast<uint4*>(KI + ki_off(kvrow, kc)) = o;
        }
        float* o = row < NPR ? p.out + O_KI_P + (size_t)row * 64 : p.out + O_KI_S + (size_t)(row - NPR) * 64;
        store64_f32(o, v);
      }
    } else if (cbase == 2112) {
      float w[8];
#pragma unroll
      for (int d = 0; d < 8; ++d) w[d] = sC[r * LDC + 64 * h + d];
      *reinterpret_cast<float4*>(WI + (size_t)row * 8) = make_float4(w[0], w[1], w[2], w[3]);
      *reinterpret_cast<float4*>(WI + (size_t)row * 8 + 4) = make_float4(w[4], w[5], w[6], w[7]);
    }
  }
}

__device__ __forceinline__ unsigned f2key(float f) {
  unsigned u = __float_as_uint(f);
  return (u & 0x80000000u) ? ~u : (u | 0x80000000u);
}

__device__ __forceinline__ void phase_index(const Params& p, char* smem) {
  const u16* QI = reinterpret_cast<const u16*>(p.ws + R_QI);
  const u16* KI = reinterpret_cast<const u16*>(p.ws + R_KI);
  const float* WI = reinterpret_cast<const float*>(p.ws + R_WI);
  u16* SEL = reinterpret_cast<u16*>(p.ws + R_SEL);
  int* CNT = reinterpret_cast<int*>(p.ws + R_CNT);
  float* sc = reinterpret_cast<float*>(smem);
  unsigned* histall = reinterpret_cast<unsigned*>(smem + 66048);
  const int tid = threadIdx.x, lane = tid & 63, wave = tid >> 6;
  for (int item = blockIdx.x; item < 64 + 4096; item += gridDim.x) {
    int tok0, nk, seqbase;
    if (item < 64) {
      tok0 = NPR + item * 4;
      nk = 4128;
      seqbase = NPR + (item >> 3) * 4128;
    } else {
      int it = item - 64;
      int c = 63 - (it >> 6);
      int b = (it & 63) >> 4, q4 = it & 15;
      tok0 = b * 4096 + c * 64 + q4 * 4;
      nk = 64 * (c + 1);
      seqbase = b * 4096;
    }
    __syncthreads();
    if (nk > 256) {
      bf16x8 af[4];
      {
        int q = (lane & 31) >> 3, h = lane & 7;
        const u16* src = QI + (size_t)(tok0 + q) * 512 + h * 64 + 8 * (lane >> 5);
#pragma unroll
        for (int kk = 0; kk < 4; ++kk) {
          uint4 t = ld16(src + kk * 16);
          af[kk] = *reinterpret_cast<bf16x8*>(&t);
        }
      }
      float wsc[16];
#pragma unroll
      for (int q = 0; q < 4; ++q) {
        float4 t = *reinterpret_cast<const float4*>(WI + (size_t)(tok0 + q) * 8 + 4 * (lane >> 5));
        const float s = 0.125f * 0.35355339059327373f;
        wsc[4 * q] = t.x * s; wsc[4 * q + 1] = t.y * s; wsc[4 * q + 2] = t.z * s; wsc[4 * q + 3] = t.w * s;
      }
      int ntile = nk >> 5;
      const u16* kbase = KI + (size_t)seqbase * 64;
      for (int t0 = wave; t0 < ntile; t0 += 32) {
        uint4 kb[8][4];
#pragma unroll
        for (int j = 0; j < 8; ++j) {
          int tile = t0 + 4 * j;
          if (tile < ntile) {
            const u16* kr = kbase + ((size_t)(tile * 8 + (lane >> 5)) * 32 + (lane & 31)) * 8;
#pragma unroll
            for (int kk = 0; kk < 4; ++kk) kb[j][kk] = ld16(kr + kk * 2 * 256);
          }
        }
        __builtin_amdgcn_sched_barrier(0);
#pragma unroll
        for (int j = 0; j < 8; ++j) {
          int tile = t0 + 4 * j;
          if (tile < ntile) {
            f32x16 acc;
#pragma unroll
            for (int r = 0; r < 16; ++r) acc[r] = 0.f;
#pragma unroll
            for (int kk = 0; kk < 4; ++kk)
              acc = __builtin_amdgcn_mfma_f32_32x32x16_bf16(af[kk], *reinterpret_cast<bf16x8*>(&kb[j][kk]), acc, 0, 0, 0);
            float sq[4];
#pragma unroll
            for (int q = 0; q < 4; ++q) {
              float sv = 0.f;
#pragma unroll
              for (int rr = 0; rr < 4; ++rr) sv += fmaxf(acc[4 * q + rr], 0.f) * wsc[4 * q + rr];
              sv += __shfl_xor(sv, 32);
              sq[q] = sv;
            }
            if (lane < 32) {
#pragma unroll
              for (int q = 0; q < 4; ++q) sc[q * SC_LD + tile * 32 + lane] = sq[q];
            }
          }
        }
      }
    }
    __syncthreads();
    {
      int token = tok0 + wave;
      u16* sel = SEL + (size_t)token * 256;
      if (nk <= 256) {
        for (int i = lane; i < 256; i += 64) sel[i] = (u16)(i < nk ? i : 0);
        if (lane == 0) CNT[token] = nk;
      } else {
        const float* s = sc + wave * SC_LD;
        unsigned* hist = histall + wave * 256;
        unsigned prefix = 0, mask = 0;
        unsigned need = 256;
        for (int shift = 24; shift >= 0; shift -= 8) {
          for (int i = lane; i < 256; i += 64) hist[i] = 0;
          __builtin_amdgcn_s_waitcnt(0xc07f);
          for (int e0 = lane * 4; e0 < nk; e0 += 256) {
            float4 v4 = *reinterpret_cast<const float4*>(s + e0);
            unsigned u0 = f2key(v4.x), u1 = f2key(v4.y), u2 = f2key(v4.z), u3 = f2key(v4.w);
            if ((u0 & mask) == prefix) atomicAdd(&hist[(u0 >> shift) & 255u], 1u);
            if ((u1 & mask) == prefix) atomicAdd(&hist[(u1 >> shift) & 255u], 1u);
            if ((u2 & mask) == prefix) atomicAdd(&hist[(u2 >> shift) & 255u], 1u);
            if ((u3 & mask) == prefix) atomicAdd(&hist[(u3 >> shift) & 255u], 1u);
          }
          __builtin_amdgcn_s_waitcnt(0xc07f);
          __builtin_amdgcn_wave_barrier();
          unsigned h0 = hist[4 * lane], h1 = hist[4 * lane + 1], h2 = hist[4 * lane + 2], h3 = hist[4 * lane + 3];
          unsigned loc = h0 + h1 + h2 + h3;
          unsigned suf = loc;
#pragma unroll
          for (int d = 1; d < 64; d <<= 1) {
            unsigned t = __shfl_down(suf, d);
            if (lane + d < 64) suf += t;
          }
          unsigned above = suf - loc;
          bool cross = (above < need) && (need <= above + loc);
          unsigned long long bal = __ballot(cross);
          int src = __ffsll((long long)bal) - 1;
          unsigned binsel = 0, newneed = 0;
          if (cross) {
            unsigned cum = above;
            if (cum + h3 >= need) { binsel = 4 * lane + 3; newneed = need - cum; }
            else {
              cum += h3;
              if (cum + h2 >= need) { binsel = 4 * lane + 2; newneed = need - cum; }
              else {
                cum += h2;
                if (cum + h1 >= need) { binsel = 4 * lane + 1; newneed = need - cum; }
                else { cum += h1; binsel = 4 * lane; newneed = need - cum; }
              }
            }
          }
          binsel = __shfl(binsel, src);
          newneed = __shfl(newneed, src);
          prefix |= binsel << shift;
          mask |= 255u << shift;
          need = newneed;
          __builtin_amdgcn_wave_barrier();
        }
        const unsigned T = prefix;
        const unsigned long long lt = (1ull << lane) - 1ull;
        int base = 0, eqtaken = 0;
        for (int i0 = 0; i0 < nk; i0 += 256) {
          int e0 = i0 + lane * 4;
          bool in = e0 < nk;
          float4 v4 = in ? *reinterpret_cast<const float4*>(s + e0) : make_float4(0.f, 0.f, 0.f, 0.f);
          unsigned u[4] = {f2key(v4.x), f2key(v4.y), f2key(v4.z), f2key(v4.w)};
          bool eq[4], gt[4];
          int eqbefore = 0;
#pragma unroll
          for (int j = 0; j < 4; ++j) {
            gt[j] = in && (u[j] > T);
            eq[j] = in && (u[j] == T);
          }
          unsigned long long be[4];
          int eqtot = 0;
#pragma unroll
          for (int j = 0; j < 4; ++j) {
            be[j] = __ballot(eq[j]);
            eqbefore += __popcll(be[j] & lt);
            eqtot += __popcll(be[j]);
          }
          bool take[4];
          int mine_eq = 0;
#pragma unroll
          for (int j = 0; j < 4; ++j) {
            int eqrank = eqtaken + eqbefore + mine_eq;
            take[j] = gt[j] || (eq[j] && eqrank < (int)need);
            mine_eq += eq[j] ? 1 : 0;
          }
          int tkbefore = 0, tktot = 0;
#pragma unroll
          for (int j = 0; j < 4; ++j) {
            unsigned long long bt = __ballot(take[j]);
            tkbefore += __popcll(bt & lt);
            tktot += __popcll(bt);
          }
          int pos = base + tkbefore;
#pragma unroll
          for (int j = 0; j < 4; ++j) {
            if (take[j]) {
              if (pos < 256) sel[pos] = (u16)(e0 + j);
              ++pos;
            }
          }
          base += tktot;
          eqtaken += eqtot;
        }
        if (lane == 0) CNT[token] = 256;
      }
    }
  }
}

__device__ __forceinline__ void load_v_round(const u16* __restrict__ VB, const int* sidx, int rd, int kvh, int lane, uint4 (&vv)[8]) {
#pragma unroll
  for (int i = 0; i < 8; ++i) {
    int pid = lane + 64 * i;
    int rowl = pid >> 3, piece = pid & 7;
    int row = sidx[64 * rd + rowl];
    unsigned off = (unsigned)row * 512u + (unsigned)(kvh * 128 + piece * 16);
    vv[i] = ld16(reinterpret_cast<const char*>(VB) + off);
  }
}

template <int RD>
__device__ __forceinline__ void pv_round(const u16* __restrict__ VB, const int* sidx, int kvh, int lane, u16* Vs,
                                         uint4 (&vv)[8], f32x4 (&sacc)[16], float inv, f32x4 (&oacc)[4]) {
  const int g = lane >> 4, n = lane & 15;
  uint4 vn[8];
  if (RD < 3) load_v_round(VB, sidx, RD + 1, kvh, lane, vn);
  __builtin_amdgcn_sched_barrier(0);
  __builtin_amdgcn_wave_barrier();
#pragma unroll
  for (int i = 0; i < 8; ++i) {
    int pid = lane + 64 * i;
    int rowl = pid >> 3, piece = pid & 7;
    *reinterpret_cast<uint4*>(&Vs[rowl * LDSK + piece * 8]) = vv[i];
  }
  __builtin_amdgcn_s_waitcnt(0xc07f);
  __builtin_amdgcn_wave_barrier();
#pragma unroll
  for (int ch = 0; ch < 2; ++ch) {
    constexpr int tb = 4 * RD;
    const int t0 = tb + 2 * ch;
    uint4 pa;
    pa.x = pack2(sacc[t0][0] * inv, sacc[t0][1] * inv);
    pa.y = pack2(sacc[t0][2] * inv, sacc[t0][3] * inv);
    pa.z = pack2(sacc[t0 + 1][0] * inv, sacc[t0 + 1][1] * inv);
    pa.w = pack2(sacc[t0 + 1][2] * inv, sacc[t0 + 1][3] * inv);
    bf16x8 afrag = *reinterpret_cast<bf16x8*>(&pa);
    int qq = n >> 2, pp = n & 3;
    int lr0 = 32 * ch + 4 * g + qq;
#pragma unroll
    for (int nt = 0; nt < 4; ++nt) {
      typedef __attribute__((address_space(3))) s16x4* lds_s4p;
      s16x4 r0 = __builtin_amdgcn_ds_read_tr16_b64_v4i16((lds_s4p)(&Vs[lr0 * LDSK + 16 * nt + 4 * pp]));
      s16x4 r1 = __builtin_amdgcn_ds_read_tr16_b64_v4i16((lds_s4p)(&Vs[(lr0 + 16) * LDSK + 16 * nt + 4 * pp]));
      uint4 bw;
      bw.x = (unsigned)(u16)r0[0] | ((unsigned)(u16)r0[1] << 16);
      bw.y = (unsigned)(u16)r0[2] | ((unsigned)(u16)r0[3] << 16);
      bw.z = (unsigned)(u16)r1[0] | ((unsigned)(u16)r1[1] << 16);
      bw.w = (unsigned)(u16)r1[2] | ((unsigned)(u16)r1[3] << 16);
      oacc[nt] = __builtin_amdgcn_mfma_f32_16x16x32_bf16(afrag, *reinterpret_cast<bf16x8*>(&bw), oacc[nt], 0, 0, 0);
    }
  }
  __builtin_amdgcn_wave_barrier();
  __builtin_amdgcn_sched_barrier(0);
  if (RD < 3) {
#pragma unroll
    for (int i = 0; i < 8; ++i) vv[i] = vn[i];
  }
}

__device__ __forceinline__ void phase_attn(const Params& p, char* smem) {
  const u16* QB = reinterpret_cast<const u16*>(p.ws + R_QB);
  const u16* KB = reinterpret_cast<const u16*>(p.ws + R_KB);
  const u16* VB = reinterpret_cast<const u16*>(p.ws + R_VB);
  const u16* SEL = reinterpret_cast<const u16*>(p.ws + R_SEL);
  const int* CNT = reinterpret_cast<const int*>(p.ws + R_CNT);
  u16* OB = reinterpret_cast<u16*>(p.ws + R_OB);
  const int tid = threadIdx.x, lane = tid & 63, wave = tid >> 6;
  const int g = lane >> 4, n = lane & 15;
  u16* Vs = reinterpret_cast<u16*>(smem) + wave * (64 * LDSK);
  int* sidx2 = reinterpret_cast<int*>(smem + 4 * 64 * LDSK * 2);
  const int kvh = wave;
  auto seqbase_of = [](int token) -> int {
    return token < NPR ? (token >> 12) * 4096 : NPR + ((token - NPR) >> 5) * 4128;
  };
  const int xq = blockIdx.x & 7, lbq = blockIdx.x >> 3, nlq = gridDim.x >> 3;
  auto token_of = [=](int it) -> int {
    return it < 32 ? NPR + xq * 32 + it : (xq >> 1) * 4096 + 2 * (it - 32) + (xq & 1);
  };
  int cur = 0, cnt_cur = 0;
  __syncthreads();
  if (lbq < 2080) {
    int t0 = token_of(lbq);
    cnt_cur = CNT[t0];
    sidx2[tid] = seqbase_of(t0) + (int)SEL[(size_t)t0 * 256 + tid];
  }
  __syncthreads();
  for (int it = lbq; it < 2080; it += nlq) {
    const int token = token_of(it);
    const int* sidx = sidx2 + cur * 256;
    const int cnt = cnt_cur;
    const int itn = it + nlq;
    const int tnext = itn < 2080 ? token_of(itn) : -1;
    int nsel = 0, ncnt = 0;
    if (tnext >= 0) {
      nsel = (int)SEL[(size_t)tnext * 256 + tid];
      ncnt = CNT[tnext];
    }
    bf16x8 qf[2];
    {
      uint4 t0 = zero4(), t1 = zero4();
      if (n < 4) {
        const u16* q = QB + (size_t)token * 1024 + (kvh * 4 + n) * 64 + 8 * g;
        t0 = ld16(q);
        t1 = ld16(q + 32);
      }
      qf[0] = *reinterpret_cast<bf16x8*>(&t0);
      qf[1] = *reinterpret_cast<bf16x8*>(&t1);
    }
    f32x4 sacc[16];
#pragma unroll
    for (int hb = 0; hb < 2; ++hb) {
      uint4 ka[8][2];
#pragma unroll
      for (int t = 0; t < 8; ++t) {
        int row = sidx[16 * (hb * 8 + t) + n];
        unsigned off = (unsigned)row * 512u + (unsigned)(kvh * 128 + 16 * g);
        ka[t][0] = ld16(reinterpret_cast<const char*>(KB) + off);
        ka[t][1] = ld16(reinterpret_cast<const char*>(KB) + off + 64u);
      }
      __builtin_amdgcn_sched_barrier(0);
#pragma unroll
      for (int t = 0; t < 8; ++t) {
        f32x4 acc = {0.f, 0.f, 0.f, 0.f};
        acc = __builtin_amdgcn_mfma_f32_16x16x32_bf16(*reinterpret_cast<bf16x8*>(&ka[t][0]), qf[0], acc, 0, 0, 0);
        acc = __builtin_amdgcn_mfma_f32_16x16x32_bf16(*reinterpret_cast<bf16x8*>(&ka[t][1]), qf[1], acc, 0, 0, 0);
        sacc[hb * 8 + t] = acc;
      }
      __builtin_amdgcn_sched_barrier(0);
    }
    uint4 vv[8];
    load_v_round(VB, sidx, 0, kvh, lane, vv);
    __builtin_amdgcn_sched_barrier(0);
    float m = -3.0e38f;
    if (cnt < 256) {
#pragma unroll
      for (int t = 0; t < 16; ++t)
#pragma unroll
        for (int r = 0; r < 4; ++r) {
          int slot = 16 * t + 4 * g + r;
          if (slot >= cnt) sacc[t][r] = -3.0e38f;
        }
    }
#pragma unroll
    for (int t = 0; t < 16; ++t)
#pragma unroll
      for (int r = 0; r < 4; ++r) m = fmaxf(m, sacc[t][r]);
    m = fmaxf(m, __shfl_xor(m, 16));
    m = fmaxf(m, __shfl_xor(m, 32));
    const float cexp = 0.125f * 1.4426950408889634f;
    const float mc = -m * cexp;
    float sum = 0.f;
#pragma unroll
    for (int t = 0; t < 16; ++t)
#pragma unroll
      for (int r = 0; r < 4; ++r) {
        float e = __builtin_amdgcn_exp2f(fmaf(sacc[t][r], cexp, mc));
        sacc[t][r] = e;
        sum += e;
      }
    sum += __shfl_xor(sum, 16);
    sum += __shfl_xor(sum, 32);
    const float inv = 1.f / sum;
    f32x4 oacc[4];
#pragma unroll
    for (int nt = 0; nt < 4; ++nt) oacc[nt] = (f32x4){0.f, 0.f, 0.f, 0.f};
    pv_round<0>(VB, sidx, kvh, lane, Vs, vv, sacc, 1.f, oacc);
    pv_round<1>(VB, sidx, kvh, lane, Vs, vv, sacc, 1.f, oacc);
    pv_round<2>(VB, sidx, kvh, lane, Vs, vv, sacc, 1.f, oacc);
    pv_round<3>(VB, sidx, kvh, lane, Vs, vv, sacc, 1.f, oacc);
    {
      float i0 = __shfl(inv, 0), i1 = __shfl(inv, 1), i2 = __shfl(inv, 2), i3 = __shfl(inv, 3);
#pragma unroll
      for (int nt = 0; nt < 4; ++nt) {
        oacc[nt][0] *= i0; oacc[nt][1] *= i1; oacc[nt][2] *= i2; oacc[nt][3] *= i3;
      }
    }
    if (lane < 16) {
#pragma unroll
      for (int nt = 0; nt < 4; ++nt)
#pragma unroll
        for (int r = 0; r < 4; ++r)
          OB[(size_t)token * 1024 + (kvh * 4 + r) * 64 + 16 * nt + lane] = f2bf(oacc[nt][r]);
    }
    if (tnext >= 0) sidx2[(cur ^ 1) * 256 + tid] = seqbase_of(tnext) + nsel;
    cnt_cur = ncnt;
    cur ^= 1;
    __syncthreads();
  }
}


#define XB_TMO      128
#define XB_XCNT(j)  (256  + 64 * (j))
#define XB_XSUB(j)  (1280 + 64 * (j))
#define XB_XGEN(j)  (2304 + 64 * (j))
#define XB_TOP      3328
#define XB_TOPGEN   3392
#define XCD_BAR_WORDS 3456
#define XB_SPIN_CAP (1u << 18)
#define LAS __attribute__((address_space(3)))

__device__ __forceinline__ unsigned xb_ld(unsigned* p) { return __hip_atomic_load(p, __ATOMIC_RELAXED, __HIP_MEMORY_SCOPE_AGENT); }
__device__ __forceinline__ unsigned xb_add(unsigned* p, unsigned v) { return __hip_atomic_fetch_add(p, v, __ATOMIC_RELAXED, __HIP_MEMORY_SCOPE_AGENT); }
__device__ __forceinline__ unsigned xb_xcc_id() { return (unsigned)__builtin_amdgcn_s_getreg((3 << 11) | 20) & 0xFu; }
#define XB_SPIN(cond, bar) do { unsigned _sp = 0; while (cond) { __builtin_amdgcn_s_sleep(1); \
    if ((++_sp & 255u) == 0u) { if (xb_ld(&(bar)[XB_TMO])) break; if (_sp > XB_SPIN_CAP) { atomicAdd(&(bar)[XB_TMO], 1u); break; } } } } while (0)

struct XcdBarrier {
  unsigned* bar; unsigned x;
  volatile LAS unsigned* st;
};
__device__ __forceinline__ XcdBarrier xcd_barrier_post(unsigned* bar, volatile LAS unsigned* st) {
  XcdBarrier b; b.bar = bar; b.x = xb_xcc_id(); b.st = st;
  if (threadIdx.x == 0) (void)xb_add(&bar[XB_XCNT(b.x)], 1u);
  return b;
}
__device__ __forceinline__ void xcd_barrier_complete(unsigned* bar, unsigned x, unsigned& nloc, unsigned& nx) {
  const unsigned G = gridDim.x * gridDim.y * gridDim.z;
  unsigned sum, cnt, mine, sp = 0u;
  for (;;) {
    sum = 0u; cnt = 0u; mine = 0u;
#pragma unroll
    for (unsigned j = 0; j < 16; ++j) { const unsigned c = xb_ld(&bar[XB_XCNT(j)]); sum += c; cnt += (c > 0u) ? 1u : 0u; mine = (j == x) ? c : mine; }
    if (sum == G) break;
    __builtin_amdgcn_s_sleep(1);
    if ((++sp & 255u) == 0u) { if (xb_ld(&bar[XB_TMO])) break; if (sp > XB_SPIN_CAP) { atomicAdd(&bar[XB_TMO], 1u); break; } }
  }
  nloc = mine > 0u ? mine : 1u; nx = cnt > 0u ? cnt : 1u;
}
__device__ __forceinline__ void xcd_barrier(const XcdBarrier& b) {
  asm volatile("s_waitcnt vmcnt(0)" ::: "memory");
  __syncthreads();
  if (threadIdx.x == 0) {
    unsigned* bar = b.bar;
    __builtin_amdgcn_s_waitcnt(0);
    unsigned nloc = b.st[0], nx = b.st[1];
    if (nloc == 0u) { xcd_barrier_complete(bar, b.x, nloc, nx); b.st[0] = nloc; b.st[1] = nx; }
    const unsigned old = xb_add(&bar[XB_XSUB(b.x)], 1u);
    const unsigned gen = old / nloc;
    if (old + 1u == (gen + 1u) * nloc) {
      __builtin_amdgcn_fence(__ATOMIC_RELEASE, "agent");
      asm volatile("s_waitcnt vmcnt(0)" ::: "memory");
      const unsigned og = xb_add(&bar[XB_TOP], 1u);
      const unsigned tg = og / nx;
      if (og + 1u == (tg + 1u) * nx) xb_add(&bar[XB_TOPGEN], 1u);
      else XB_SPIN(xb_ld(&bar[XB_TOPGEN]) == tg, bar);
      __builtin_amdgcn_fence(__ATOMIC_ACQUIRE, "agent");
      xb_add(&bar[XB_XGEN(b.x)], 1u);
      asm volatile("s_waitcnt vmcnt(0)" ::: "memory");
    } else {
      XB_SPIN(xb_ld(&bar[XB_XGEN(b.x)]) == gen, bar);
      __builtin_amdgcn_fence(__ATOMIC_ACQUIRE, "agent");
      asm volatile("s_waitcnt vmcnt(0)" ::: "memory");
    }
  }
  __syncthreads();
}

__global__ void __launch_bounds__(256, 2) mega(Params p) {
  __shared__ __attribute__((aligned(16))) char smem[SMEM_BYTES];
  __shared__ uint4 xb_words;
  if (threadIdx.x == 0) xb_words = make_uint4(0u, 0u, 0u, 0u);
  __syncthreads();
  XcdBarrier xb = xcd_barrier_post(reinterpret_cast<unsigned*>(p.ws + R_BAR), (volatile LAS unsigned*)&xb_words);
  if (p.use_cg) cg::this_grid().sync();
  phase0(p, smem);
  xcd_barrier(xb);
  phase1(p, smem);
  xcd_barrier(xb);
  phase2(p);
  xcd_barrier(xb);
  phase3(p, smem);
  xcd_barrier(xb);
  phase4(p, smem);
  xcd_barrier(xb);
  phase_norm(p, p.norm_ffn, false);
  xcd_barrier(xb);
  phase_up(p, 0, smem);
  xcd_barrier(xb);
  phase_resid_gemm(p, (const u16*)(p.ws + R_GT), (const u16*)(p.ws + W_DN), 2816, smem);
  xcd_barrier(xb);
  phase_norm(p, p.norm_mix + 1024, true);
  xcd_barrier(xb);
  phase_win(p, smem);
  xcd_barrier(xb);
  phase_index(p, smem);
  xcd_barrier(xb);
  phase_attn(p, smem);
  xcd_barrier(xb);
  phase_resid_gemm(p, (const u16*)(p.ws + R_OB), (const u16*)(p.ws + W_O), 1024, smem);
  xcd_barrier(xb);
  phase_norm(p, p.norm_ffn + 1024, false);
  xcd_barrier(xb);
  phase_up(p, 1, smem);
  xcd_barrier(xb);
  phase_resid_gemm(p, (const u16*)(p.ws + R_GT), (const u16*)(p.ws + W_DN) + (size_t)1024 * 2816, 2816, smem);
}

extern "C" void kernel_launch(void* const* d_in, const int* in_sizes, int n_in, void* d_out, int out_size, void* d_ws,
                              size_t ws_size, hipStream_t stream) {
  static int grid_blocks = 0;
  if (!grid_blocks) {
    int dev = 0, cus = 0, per_cu = 0;
    hipGetDevice(&dev);
    hipDeviceGetAttribute(&cus, hipDeviceAttributeMultiprocessorCount, dev);
    hipOccupancyMaxActiveBlocksPerMultiprocessor(&per_cu, mega, 256, 0);
    if (per_cu > 2) per_cu = 2;
    if (per_cu < 1) per_cu = 1;
    grid_blocks = cus * per_cu;
  }
  Params p{};
  const float** pf = reinterpret_cast<const float**>(&p);
  for (int i = 0; i < 28; ++i) pf[i] = reinterpret_cast<const float*>(d_in[i]);
  p.out = reinterpret_cast<float*>(d_out);
  p.ws = reinterpret_cast<char*>(d_ws);
  if (ws_size < WS_NEED) fprintf(stderr, "workspace too small: %zu < %zu\n", ws_size, (size_t)WS_NEED);
  p.use_cg = 0;
  p.pad0 = 0;
  hipMemsetAsync(reinterpret_cast<char*>(d_ws) + R_BAR, 0, 16384 + 4096, stream);
  void* args[] = {&p};
  hipError_t e = hipLaunchCooperativeKernel((void*)mega, dim3(grid_blocks), dim3(256), args, 0, stream);
  if (e != hipSuccess) fprintf(stderr, "cooperative launch failed: %s (grid %d)\n", hipGetErrorString(e), grid_blocks);
}
```

```cpp
#include <hip/hip_runtime.h>
#include <hip/hip_cooperative_groups.h>
#include <stdint.h>
#include <cstdio>
namespace cg = cooperative_groups;

typedef unsigned short u16;
typedef __attribute__((ext_vector_type(8))) __bf16 bf16x8;
typedef __attribute__((ext_vector_type(4))) short s16x4;
typedef __attribute__((ext_vector_type(16))) float f32x16;
typedef __attribute__((ext_vector_type(4))) float f32x4;

#define NTOK 16640
#define NPR 16384
#define LDSK 72
#define LDC 129
#define LDG 132
#define SC_LD 4128
#define SMEM_BYTES (73728)

#define O_SSM_RE_P 17039360
#define O_SSM_IM_P 17055744
#define O_SSM_RE_S 17072128
#define O_SSM_IM_S 17104896
#define O_K_P 17137664
#define O_V_P 21331968
#define O_KI_P 25526272
#define O_K_S 26574848
#define O_V_S 26640384
#define O_KI_S 26705920
#define O_CONV_P 26722304
#define O_CONV_S 26767360

constexpr size_t MB = 1ull << 20;
constexpr size_t W_GLU = 0;
constexpr size_t W_IN = W_GLU + 2048ull * 1024 * 2;
constexpr size_t W_O = W_IN + 2176ull * 1024 * 2;
constexpr size_t W_UP = W_O + 1024ull * 1024 * 2;
constexpr size_t W_DN = W_UP + 2ull * 5632 * 1024 * 2;
constexpr size_t R0 = W_DN + 2ull * 1024 * 2816 * 2;
constexpr size_t R_UG = R0;
constexpr size_t R_Z = R0 + 35 * MB;
constexpr size_t R_S = R0 + 70 * MB;
constexpr size_t R_HP = R0 + 88 * MB;
constexpr size_t R_W1 = R0 + 97 * MB;
constexpr size_t R_W3 = R0 + 106 * MB;
constexpr size_t R_KT = R0 + 115 * MB;
constexpr size_t R_AP = R0 + 117 * MB;
constexpr size_t R_BB = R0 + 119 * MB;
constexpr size_t R_HN = R0;
constexpr size_t R_GT = R0 + 35 * MB;
constexpr size_t R_OB = R0;
constexpr size_t R_QB = R0 + 35 * MB;
constexpr size_t R_KB = R0 + 70 * MB;
constexpr size_t R_VB = R0 + 96 * MB;
constexpr size_t R_QI = R0 + 122 * MB;
constexpr size_t R_KI = R0 + 140 * MB;
constexpr size_t R_WI = R0 + 147 * MB;
constexpr size_t R_SEL = R0 + 148 * MB;
constexpr size_t R_CNT = R0 + 157 * MB;
constexpr size_t R_BAR = R0 + 158 * MB;
constexpr size_t R_ZERO = R_BAR + 16384;
constexpr size_t WS_NEED = R0 + 159 * MB;

struct Params {
  const float *x_prompt, *x_sample, *st_re, *st_im, *cache_k, *cache_v, *cache_kidx, *cache_conv;
  const float *norm_mix, *norm_ffn, *lam_re, *lam_im, *log_dt, *b_re, *b_im, *c_re, *c_im, *ssm_d, *w_glu, *b_glu;
  const float *w_in, *q_norm, *k_norm, *w_o, *w_up, *conv_w, *conv_b, *w_down;
  float* out;
  char* ws;
  int use_cg;
  int pad0;
};

typedef __attribute__((ext_vector_type(2))) __bf16 bf16x2_t;
__device__ __forceinline__ u16 f2bf(float f) {
  __bf16 h = (__bf16)f;
  return __builtin_bit_cast(u16, h);
}
__device__ __forceinline__ float bf2f(u16 h) { return __uint_as_float(((unsigned)h) << 16); }
__device__ __forceinline__ unsigned pack2(float a, float b) {
  bf16x2_t v;
  v[0] = (__bf16)a;
  v[1] = (__bf16)b;
  return __builtin_bit_cast(unsigned, v);
}
__device__ __forceinline__ float gelu_tanh(float x) {
  const float k2 = -2.f * 0.7978845608028654f * 1.4426950408889634f;
  float x2 = x * x;
  float w = x * fmaf(x2, 0.044715f, 1.f);
  float e = __builtin_amdgcn_exp2f(w * k2);
  return x * __builtin_amdgcn_rcpf(1.f + e);
}
__device__ __forceinline__ float sigmoid_fast(float x) {
  return __builtin_amdgcn_rcpf(1.f + __builtin_amdgcn_exp2f(x * -1.4426950408889634f));
}
__device__ __forceinline__ uint4 zero4() { return make_uint4(0u, 0u, 0u, 0u); }
__device__ __forceinline__ uint4 ld16(const void* p) { return *reinterpret_cast<const uint4*>(p); }

template <class LA, class LB, class KM>
__device__ __forceinline__ void gemm_core(LA la, LB lb, KM kmap, int nkt, char* smem) {
  u16* sA = reinterpret_cast<u16*>(smem);
  u16* sB = sA + 128 * LDSK;
  const int tid = threadIdx.x, lane = tid & 63, wave = tid >> 6;
  const int wm = wave >> 1, wn = wave & 1;
  const int lr = tid >> 3, kc = (tid & 7) * 8;
  f32x16 acc[2][2];
#pragma unroll
  for (int i = 0; i < 2; ++i)
#pragma unroll
    for (int j = 0; j < 2; ++j)
#pragma unroll
      for (int r = 0; r < 16; ++r) acc[i][j][r] = 0.f;
  uint4 ra[4], rb[4];
  {
    int k0 = kmap(0);
#pragma unroll
    for (int i = 0; i < 4; ++i) {
      ra[i] = la(lr + 32 * i, k0 + kc);
      rb[i] = lb(lr + 32 * i, k0 + kc);
    }
  }
#pragma unroll 1
  for (int kt = 0; kt < nkt; ++kt) {
    __syncthreads();
#pragma unroll
    for (int i = 0; i < 4; ++i) {
      *reinterpret_cast<uint4*>(&sA[(lr + 32 * i) * LDSK + kc]) = ra[i];
      *reinterpret_cast<uint4*>(&sB[(lr + 32 * i) * LDSK + kc]) = rb[i];
    }
    __syncthreads();
    if (kt + 1 < nkt) {
      int k1 = kmap(kt + 1);
#pragma unroll
      for (int i = 0; i < 4; ++i) {
        ra[i] = la(lr + 32 * i, k1 + kc);
        rb[i] = lb(lr + 32 * i, k1 + kc);
      }
    }
#pragma unroll
    for (int kk = 0; kk < 4; ++kk) {
      bf16x8 af[2], bfr[2];
#pragma unroll
      for (int mi = 0; mi < 2; ++mi)
        af[mi] = *reinterpret_cast<const bf16x8*>(&sA[(wm * 64 + mi * 32 + (lane & 31)) * LDSK + kk * 16 + (lane >> 5) * 8]);
#pragma unroll
      for (int ni = 0; ni < 2; ++ni)
        bfr[ni] = *reinterpret_cast<const bf16x8*>(&sB[(wn * 64 + ni * 32 + (lane & 31)) * LDSK + kk * 16 + (lane >> 5) * 8]);
#pragma unroll
      for (int mi = 0; mi < 2; ++mi)
#pragma unroll
        for (int ni = 0; ni < 2; ++ni)
          acc[mi][ni] = __builtin_amdgcn_mfma_f32_32x32x16_bf16(af[mi], bfr[ni], acc[mi][ni], 0, 0, 0);
    }
  }
  __syncthreads();
  float* sC = reinterpret_cast<float*>(smem);
#pragma unroll
  for (int mi = 0; mi < 2; ++mi)
#pragma unroll
    for (int ni = 0; ni < 2; ++ni)
#pragma unroll
      for (int r = 0; r < 16; ++r) {
        int row = wm * 64 + mi * 32 + (r & 3) + 8 * (r >> 2) + 4 * (lane >> 5);
        int col = wn * 64 + ni * 32 + (lane & 31);
        sC[row * LDC + col] = acc[mi][ni][r];
      }
  __syncthreads();
}


struct TileSched {
  int i, end, step;
  __device__ __forceinline__ TileSched(int T) {
    int nx = gridDim.x >> 3;
    int x = blockIdx.x & 7, lb = blockIdx.x >> 3;
    int c0 = (int)((long long)T * x / 8);
    end = (int)((long long)T * (x + 1) / 8);
    i = c0 + lb;
    step = nx;
  }
};
__device__ __forceinline__ void tile_decode(int i, int MT, int NT, int& mt, int& nt) {
  int gsz = 8 * NT;
  int g8 = i / gsz;
  int rem = i - g8 * gsz;
  int mrows = min(8, MT - 8 * g8);
  nt = rem / mrows;
  mt = 8 * g8 + (rem - nt * mrows);
}

struct KOff {
  int base;
  __device__ __forceinline__ int operator()(int kt) const { return base + kt * 64; }
};
struct KIdent {
  __device__ __forceinline__ int operator()(int kt) const { return kt * 64; }
};

__device__ __forceinline__ void transpose_job(const float* __restrict__ src, u16* __restrict__ dst, int K, int N, int kt, int nt, char* smem) {
  float* tile = reinterpret_cast<float*>(smem);
  const int tid = threadIdx.x;
  __syncthreads();
  {
    int c4 = (tid & 15) * 4;
    int n = nt * 64 + c4;
#pragma unroll
    for (int i = 0; i < 4; ++i) {
      int kr = (tid >> 4) + 16 * i;
      float4 v = make_float4(0.f, 0.f, 0.f, 0.f);
      if (n < N) v = *reinterpret_cast<const float4*>(src + (size_t)(kt * 64 + kr) * N + n);
      tile[kr * 65 + c4 + 0] = v.x;
      tile[kr * 65 + c4 + 1] = v.y;
      tile[kr * 65 + c4 + 2] = v.z;
      tile[kr * 65 + c4 + 3] = v.w;
    }
  }
  __syncthreads();
  {
    int nr = tid >> 2, kch = (tid & 3) * 16;
    unsigned w[8];
#pragma unroll
    for (int i = 0; i < 8; ++i) w[i] = pack2(tile[(kch + 2 * i) * 65 + nr], tile[(kch + 2 * i + 1) * 65 + nr]);
    u16* d = dst + (size_t)(nt * 64 + nr) * K + kt * 64 + kch;
    *reinterpret_cast<uint4*>(d) = make_uint4(w[0], w[1], w[2], w[3]);
    *reinterpret_cast<uint4*>(d + 8) = make_uint4(w[4], w[5], w[6], w[7]);
  }
}

__device__ __forceinline__ const float* xrow_in(const Params& p, int row) {
  return row < NPR ? p.x_prompt + (size_t)row * 1024 : p.x_sample + (size_t)(row - NPR) * 1024;
}

__device__ __forceinline__ void norm_ug_job(const Params& p, int job) {
  const int lane = threadIdx.x & 63, wave = threadIdx.x >> 6;
  int row = job * 4 + wave;
  if (row >= NTOK) return;
  const float* x = xrow_in(p, row) + lane * 16;
  float v[16];
#pragma unroll
  for (int i = 0; i < 4; ++i) {
    float4 t = *reinterpret_cast<const float4*>(x + 4 * i);
    v[4 * i] = t.x; v[4 * i + 1] = t.y; v[4 * i + 2] = t.z; v[4 * i + 3] = t.w;
  }
  float ss = 0.f;
#pragma unroll
  for (int i = 0; i < 16; ++i) ss += v[i] * v[i];
#pragma unroll
  for (int d = 32; d >= 1; d >>= 1) ss += __shfl_xor(ss, d);
  float rs = rsqrtf(ss * (1.f / 1024.f) + 1e-6f);
  const float* g = p.norm_mix + lane * 16;
  unsigned w[8];
#pragma unroll
  for (int i = 0; i < 8; ++i) w[i] = pack2(v[2 * i] * rs * g[2 * i], v[2 * i + 1] * rs * g[2 * i + 1]);
  u16* ug = reinterpret_cast<u16*>(p.ws + R_UG) + ((size_t)lane * NTOK + row) * 16;
  *reinterpret_cast<uint4*>(ug) = make_uint4(w[0], w[1], w[2], w[3]);
  *reinterpret_cast<uint4*>(ug + 8) = make_uint4(w[4], w[5], w[6], w[7]);
}

__device__ __forceinline__ void norm_hn_job(const Params& p, const float* __restrict__ X, const float* __restrict__ gw, int job) {
  const int lane = threadIdx.x & 63, wave = threadIdx.x >> 6;
  const int row0 = job * 16 + wave * 4;
  float4 t[4][4];
#pragma unroll
  for (int rr = 0; rr < 4; ++rr) {
    const float* x = X + (size_t)(row0 + rr) * 1024;
#pragma unroll
    for (int i = 0; i < 4; ++i) t[rr][i] = *reinterpret_cast<const float4*>(x + 4 * lane + 256 * i);
  }
  float4 g[4];
#pragma unroll
  for (int i = 0; i < 4; ++i) g[i] = *reinterpret_cast<const float4*>(gw + 4 * lane + 256 * i);
#pragma unroll
  for (int rr = 0; rr < 4; ++rr) {
    float ss = 0.f;
#pragma unroll
    for (int i = 0; i < 4; ++i) ss += t[rr][i].x * t[rr][i].x + t[rr][i].y * t[rr][i].y + t[rr][i].z * t[rr][i].z + t[rr][i].w * t[rr][i].w;
#pragma unroll
    for (int d = 32; d >= 1; d >>= 1) ss += __shfl_xor(ss, d);
    float rs = rsqrtf(ss * (1.f / 1024.f) + 1e-6f);
    u16* hn = reinterpret_cast<u16*>(p.ws + R_HN) + (size_t)(row0 + rr) * 1024;
#pragma unroll
    for (int i = 0; i < 4; ++i) {
      uint2 o;
      o.x = pack2(t[rr][i].x * rs * g[i].x, t[rr][i].y * rs * g[i].y);
      o.y = pack2(t[rr][i].z * rs * g[i].z, t[rr][i].w * rs * g[i].w);
      *reinterpret_cast<uint2*>(hn + 4 * lane + 256 * i) = o;
    }
  }
}

__device__ __forceinline__ void s5_table_job(const Params& p, int job) {
  int t = job * 256 + threadIdx.x;
  int c = t & 15, pp = (t >> 4) & 63, g = t >> 10;
  float lre = fminf(p.lam_re[g * 64 + pp], -1e-4f);
  float lim = p.lam_im[g * 64 + pp];
  float dt = expf(p.log_dt[g]);
  float mag = expf(lre * dt);
  float sn, cs;
  sincosf(lim * dt, &sn, &cs);
  float are = mag * cs, aim = mag * sn;
  float den = lre * lre + lim * lim;
  float nre = are - 1.f;
  float fre = (nre * lre + aim * lim) / den;
  float fim = (aim * lre - nre * lim) / den;
  float br = p.b_re[(g * 64 + pp) * 16 + c], bi = p.b_im[(g * 64 + pp) * 16 + c];
  float bbr = fre * br - fim * bi;
  float bbi = fre * bi + fim * br;
  float* bb = reinterpret_cast<float*>(p.ws + R_BB) + ((size_t)(g * 64 + pp) * 16 + c) * 2;
  bb[0] = bbr; bb[1] = bbi;
  u16* W1 = reinterpret_cast<u16*>(p.ws + R_W1) + (size_t)g * 128 * 512;
  float pr = 1.f, pi = 0.f;
  for (int n = 0; n < 32; ++n) {
    int i = 31 - n;
    W1[(size_t)pp * 512 + i * 16 + c] = f2bf(pr * bbr - pi * bbi);
    W1[(size_t)(64 + pp) * 512 + i * 16 + c] = f2bf(pr * bbi + pi * bbr);
    float nr = pr * are - pi * aim, ni = pr * aim + pi * are;
    pr = nr; pi = ni;
  }
  if (c == 0) {
    float* ap = reinterpret_cast<float*>(p.ws + R_AP) + (size_t)(g * 64 + pp) * 66;
    float qr = 1.f, qi = 0.f;
    for (int n = 0; n <= 32; ++n) {
      ap[2 * n] = qr; ap[2 * n + 1] = qi;
      float nr = qr * are - qi * aim, ni = qr * aim + qi * are;
      qr = nr; qi = ni;
    }
  }
}

__device__ __forceinline__ void phase0(const Params& p, char* smem) {
  const int NJ_T = 5536, NJ_N = 4160, NJ_S = 256;
  for (int job = blockIdx.x; job < NJ_S + NJ_N + NJ_T; job += gridDim.x) {
    if (job < NJ_S) {
      s5_table_job(p, job);
    } else if (job < NJ_S + NJ_N) {
      norm_ug_job(p, job - NJ_S);
    } else {
      int j = job - NJ_S - NJ_N;
      const float* src; u16* dst; int K, N, ntn;
      if (j < 512) { src = p.w_glu; dst = (u16*)(p.ws + W_GLU); K = 1024; N = 2048; ntn = 32; }
      else if (j < 1056) { j -= 512; src = p.w_in; dst = (u16*)(p.ws + W_IN); K = 1024; N = 2120; ntn = 34; }
      else if (j < 1312) { j -= 1056; src = p.w_o; dst = (u16*)(p.ws + W_O); K = 1024; N = 1024; ntn = 16; }
      else if (j < 2720) { j -= 1312; src = p.w_up; dst = (u16*)(p.ws + W_UP); K = 1024; N = 5632; ntn = 88; }
      else if (j < 4128) { j -= 2720; src = p.w_up + (size_t)1024 * 5632; dst = (u16*)(p.ws + W_UP) + (size_t)5632 * 1024; K = 1024; N = 5632; ntn = 88; }
      else if (j < 4832) { j -= 4128; src = p.w_down; dst = (u16*)(p.ws + W_DN); K = 2816; N = 1024; ntn = 16; }
      else { j -= 4832; src = p.w_down + (size_t)2816 * 1024; dst = (u16*)(p.ws + W_DN) + (size_t)1024 * 2816; K = 2816; N = 1024; ntn = 16; }
      transpose_job(src, dst, K, N, j / ntn, j % ntn, smem);
    }
  }
}

__device__ __forceinline__ void phase1(const Params& p, char* smem) {
  const int NT_G = 320, NJ_K = 2048, NJ_W = 2048;
  const u16* UG = reinterpret_cast<const u16*>(p.ws + R_UG);
  const u16* W1 = reinterpret_cast<const u16*>(p.ws + R_W1);
  float* S = reinterpret_cast<float*>(p.ws + R_S);
  const float* AP = reinterpret_cast<const float*>(p.ws + R_AP);
  const float* BB = reinterpret_cast<const float*>(p.ws + R_BB);
  for (int job = blockIdx.x; job < NT_G + NJ_K + NJ_W; job += gridDim.x) {
    if (job < NT_G) {
      int g = job / 5, mt = job % 5;
      const u16* ug = UG + (size_t)g * NTOK * 16;
      const u16* w1 = W1 + (size_t)g * 128 * 512;
      auto la = [=](int r, int k) -> uint4 {
        int col = mt * 128 + r;
        return col < 520 ? ld16(ug + (size_t)col * 512 + k) : zero4();
      };
      auto lb = [=](int n, int k) -> uint4 { return ld16(w1 + (size_t)n * 512 + k); };
      gemm_core(la, lb, KIdent(), 8, smem);
      const float* sC = reinterpret_cast<const float*>(smem);
      {
        const int cg = threadIdx.x & 31, r0 = threadIdx.x >> 5;
#pragma unroll
        for (int i = 0; i < 16; ++i) {
          int r = r0 + 8 * i;
          int col = mt * 128 + r;
          const float* c = sC + r * LDC + 4 * cg;
          if (col < 520) *reinterpret_cast<float4*>(&S[((size_t)col * 64 + g) * 128 + 4 * cg]) = make_float4(c[0], c[1], c[2], c[3]);
        }
      }
    } else if (job < NT_G + NJ_K) {
      int t = (job - NT_G) * 256 + threadIdx.x;
      int c = t & 15, cp = (t >> 4) & 15, tau = (t >> 8) & 31, g = t >> 13;
      float acc = 0.f;
#pragma unroll 16
      for (int pp = 0; pp < 64; ++pp) {
        float cr = p.c_re[(g * 16 + cp) * 64 + pp], ci = p.c_im[(g * 16 + cp) * 64 + pp];
        const float* bb = BB + ((size_t)(g * 64 + pp) * 16 + c) * 2;
        const float* ap = AP + (size_t)(g * 64 + pp) * 66 + 2 * tau;
        float br = bb[0], bi = bb[1];
        float ar = ap[0], ai = ap[1];
        float xr = br * ar - bi * ai, xi = br * ai + bi * ar;
        acc += cr * xr - ci * xi;
      }
      reinterpret_cast<u16*>(p.ws + R_KT)[t] = f2bf(acc);
    } else {
      int t = (job - NT_G - NJ_K) * 256 + threadIdx.x;
      int pp = t & 63, cp = (t >> 6) & 15, j4 = (t >> 10) & 7, g = t >> 13;
      float cr = p.c_re[(g * 16 + cp) * 64 + pp], ci = p.c_im[(g * 16 + cp) * 64 + pp];
      const float* ap = AP + (size_t)(g * 64 + pp) * 66 + 2 * (4 * j4 + 1);
      float ar[4], ai[4];
#pragma unroll
      for (int q = 0; q < 4; ++q) { ar[q] = ap[2 * q]; ai[q] = ap[2 * q + 1]; }
#pragma unroll
      for (int q = 0; q < 4; ++q) {
        float vr = cr * ar[q] - ci * ai[q], vi = cr * ai[q] + ci * ar[q];
        u16* W3 = reinterpret_cast<u16*>(p.ws + R_W3) + ((size_t)g * 512 + (4 * j4 + q) * 16 + cp) * 128;
        W3[pp] = f2bf(vr);
        W3[64 + pp] = f2bf(-vi);
      }
    }
  }
}

__device__ __forceinline__ void phase2(const Params& p) {
  const float* S = reinterpret_cast<const float*>(p.ws + R_S);
  u16* HP = reinterpret_cast<u16*>(p.ws + R_HP);
  const float* AP = reinterpret_cast<const float*>(p.ws + R_AP);
  for (int job = blockIdx.x; job < 192; job += gridDim.x) {
    int t = job * 256 + threadIdx.x;
    if (t < 16384) {
      int pp = t & 63, g = (t >> 6) & 63, b = t >> 12;
      float ar = AP[(size_t)(g * 64 + pp) * 66 + 64], ai = AP[(size_t)(g * 64 + pp) * 66 + 65];
      float hr = 0.f, hi = 0.f;
      for (int c0 = 0; c0 < 128; c0 += 16) {
        float sr[16], si[16];
#pragma unroll
        for (int u = 0; u < 16; ++u) {
          size_t o = ((size_t)(b * 128 + c0 + u) * 64 + g) * 128 + pp;
          sr[u] = S[o]; si[u] = S[o + 64];
        }
#pragma unroll
        for (int u = 0; u < 16; ++u) {
          size_t o = ((size_t)(b * 128 + c0 + u) * 64 + g) * 128 + pp;
          HP[o] = f2bf(hr);
          HP[o + 64] = f2bf(hi);
          float nr = ar * hr - ai * hi + sr[u];
          float ni = ar * hi + ai * hr + si[u];
          hr = nr; hi = ni;
        }
      }
      p.out[O_SSM_RE_P + (b * 64 + g) * 64 + pp] = hr;
      p.out[O_SSM_IM_P + (b * 64 + g) * 64 + pp] = hi;
    } else {
      int u = t - 16384;
      int pp = u & 63, g = (u >> 6) & 63, b = u >> 12;
      float ar = AP[(size_t)(g * 64 + pp) * 66 + 64], ai = AP[(size_t)(g * 64 + pp) * 66 + 65];
      float hr = p.st_re[(b * 64 + g) * 64 + pp], hi = p.st_im[(b * 64 + g) * 64 + pp];
      size_t o = ((size_t)(512 + b) * 64 + g) * 128 + pp;
      HP[o] = f2bf(hr);
      HP[o + 64] = f2bf(hi);
      float nr = ar * hr - ai * hi + S[o];
      float ni = ar * hi + ai * hr + S[o + 64];
      p.out[O_SSM_RE_S + (b * 64 + g) * 64 + pp] = nr;
      p.out[O_SSM_IM_S + (b * 64 + g) * 64 + pp] = ni;
    }
  }
}

struct KMapS3 {
  int nlow;
  __device__ __forceinline__ int operator()(int kt) const { return kt < nlow ? kt * 64 : 512 + (kt - nlow) * 64; }
};

__device__ __forceinline__ void phase3(const Params& p, char* smem) {
  const u16* UG = reinterpret_cast<const u16*>(p.ws + R_UG);
  const u16* HP = reinterpret_cast<const u16*>(p.ws + R_HP);
  const u16* KT = reinterpret_cast<const u16*>(p.ws + R_KT);
  const u16* W3 = reinterpret_cast<const u16*>(p.ws + R_W3);
  u16* Z = reinterpret_cast<u16*>(p.ws + R_Z);
  for (int job = blockIdx.x; job < 1280; job += gridDim.x) {
    int nt = 3 - (job & 3);
    int mt = (job >> 2) % 5, g = job / 20;
    const u16* ug = UG + (size_t)g * NTOK * 16;
    auto la = [=](int r, int k) -> uint4 {
      int col = mt * 128 + r;
      if (col >= 520) return zero4();
      if (k < 512) return ld16(ug + (size_t)col * 512 + k);
      return ld16(HP + ((size_t)col * 64 + g) * 128 + (k - 512));
    };
    auto lb = [=](int nl, int k) -> uint4 {
      int n = nt * 128 + nl;
      if (k < 512) {
        int j = n >> 4, cp = n & 15, i = k >> 4, c0 = k & 15;
        if (j < i) return zero4();
        return ld16(KT + ((size_t)(g * 32 + (j - i)) * 16 + cp) * 16 + c0);
      }
      return ld16(W3 + ((size_t)g * 512 + n) * 128 + (k - 512));
    };
    KMapS3 km; km.nlow = 2 * (nt + 1);
    gemm_core(la, lb, km, km.nlow + 2, smem);
    const float* sC = reinterpret_cast<const float*>(smem);
    {
      const int cg = threadIdx.x & 31, r0 = threadIdx.x >> 5;
      const int n = nt * 128 + 4 * cg;
      const int j = n >> 4, cp = n & 15;
      const float4 dv = *reinterpret_cast<const float4*>(p.ssm_d + g * 16 + cp);
      uint2 uv[16];
#pragma unroll
      for (int i = 0; i < 16; ++i) {
        int col = mt * 128 + r0 + 8 * i;
        uv[i] = make_uint2(0u, 0u);
        if (col < 520) uv[i] = *reinterpret_cast<const uint2*>(ug + (size_t)(col * 32 + j) * 16 + cp);
      }
#pragma unroll
      for (int i = 0; i < 16; ++i) {
        int r = r0 + 8 * i;
        int col = mt * 128 + r;
        if (col < 520) {
          const float* c = sC + r * LDC + 4 * cg;
          float y0 = c[0] + dv.x * __uint_as_float(uv[i].x << 16);
          float y1 = c[1] + dv.y * __uint_as_float(uv[i].x & 0xffff0000u);
          float y2 = c[2] + dv.z * __uint_as_float(uv[i].y << 16);
          float y3 = c[3] + dv.w * __uint_as_float(uv[i].y & 0xffff0000u);
          uint2 o;
          o.x = pack2(gelu_tanh(y0), gelu_tanh(y1));
          o.y = pack2(gelu_tanh(y2), gelu_tanh(y3));
          *reinterpret_cast<uint2*>(Z + (size_t)(col * 32 + j) * 1024 + g * 16 + cp) = o;
        }
      }
    }
  }
}


#define LDK2 40
#define STAGE2 (384 * LDK2)
template <bool HALO, class LA, class LB, class EPI>
__device__ __forceinline__ void gemm256(LA la, LB lb, EPI epi, int nk, char* smem) {
  u16* sbuf = reinterpret_cast<u16*>(smem);
  const int tid = threadIdx.x, lane = tid & 63, wave = tid >> 6;
  const int wm = wave >> 1, wn = wave & 1;
  const int lrow = tid >> 2, kc = (tid & 3) * 8;
  f32x16 acc[4][2];
#pragma unroll
  for (int i = 0; i < 4; ++i)
#pragma unroll
    for (int j = 0; j < 2; ++j)
#pragma unroll
      for (int r = 0; r < 16; ++r) acc[i][j][r] = 0.f;
  uint4 ra[4], rb[2];
#pragma unroll
  for (int i = 0; i < 4; ++i) ra[i] = la(lrow + 64 * i, kc);
#pragma unroll
  for (int i = 0; i < 2; ++i) rb[i] = lb(lrow + 64 * i, kc);
  __syncthreads();
#pragma unroll
  for (int i = 0; i < 4; ++i) *reinterpret_cast<uint4*>(&sbuf[(lrow + 64 * i) * LDK2 + kc]) = ra[i];
#pragma unroll
  for (int i = 0; i < 2; ++i) *reinterpret_cast<uint4*>(&sbuf[(256 + lrow + 64 * i) * LDK2 + kc]) = rb[i];
  if (nk > 1) {
#pragma unroll
    for (int i = 0; i < 4; ++i) ra[i] = la(lrow + 64 * i, 32 + kc);
#pragma unroll
    for (int i = 0; i < 2; ++i) rb[i] = lb(lrow + 64 * i, 32 + kc);
  }
#pragma unroll 1
  for (int kt = 0; kt < nk; ++kt) {
    __syncthreads();
    const u16* cA = sbuf + (kt & 1) * STAGE2;
    const u16* cB = cA + 256 * LDK2;
    u16* nA = sbuf + ((kt + 1) & 1) * STAGE2;
    {
      bf16x8 af[4], bfr[2];
#pragma unroll
      for (int mi = 0; mi < 4; ++mi)
        af[mi] = *reinterpret_cast<const bf16x8*>(&cA[(wm * 128 + mi * 32 + (lane & 31)) * LDK2 + (lane >> 5) * 8]);
#pragma unroll
      for (int ni = 0; ni < 2; ++ni)
        bfr[ni] = *reinterpret_cast<const bf16x8*>(&cB[(wn * 64 + ni * 32 + (lane & 31)) * LDK2 + (lane >> 5) * 8]);
#pragma unroll
      for (int mi = 0; mi < 4; ++mi)
#pragma unroll
        for (int ni = 0; ni < 2; ++ni)
          acc[mi][ni] = __builtin_amdgcn_mfma_f32_32x32x16_bf16(af[mi], bfr[ni], acc[mi][ni], 0, 0, 0);
    }
    if (kt + 1 < nk) {
#pragma unroll
      for (int i = 0; i < 4; ++i) *reinterpret_cast<uint4*>(&nA[(lrow + 64 * i) * LDK2 + kc]) = ra[i];
#pragma unroll
      for (int i = 0; i < 2; ++i) *reinterpret_cast<uint4*>(&nA[(256 + lrow + 64 * i) * LDK2 + kc]) = rb[i];
      if (kt + 2 < nk) {
        int k2 = (kt + 2) * 32 + kc;
#pragma unroll
        for (int i = 0; i < 4; ++i) ra[i] = la(lrow + 64 * i, k2);
#pragma unroll
        for (int i = 0; i < 2; ++i) rb[i] = lb(lrow + 64 * i, k2);
      }
    }
    {
      bf16x8 af[4], bfr[2];
#pragma unroll
      for (int mi = 0; mi < 4; ++mi)
        af[mi] = *reinterpret_cast<const bf16x8*>(&cA[(wm * 128 + mi * 32 + (lane & 31)) * LDK2 + 16 + (lane >> 5) * 8]);
#pragma unroll
      for (int ni = 0; ni < 2; ++ni)
        bfr[ni] = *reinterpret_cast<const bf16x8*>(&cB[(wn * 64 + ni * 32 + (lane & 31)) * LDK2 + 16 + (lane >> 5) * 8]);
#pragma unroll
      for (int mi = 0; mi < 4; ++mi)
#pragma unroll
        for (int ni = 0; ni < 2; ++ni)
          acc[mi][ni] = __builtin_amdgcn_mfma_f32_32x32x16_bf16(af[mi], bfr[ni], acc[mi][ni], 0, 0, 0);
    }
  }
  float* sC = reinterpret_cast<float*>(smem);
#pragma unroll
  for (int h = 0; h < 2; ++h) {
    __syncthreads();
#pragma unroll
    for (int m2 = 0; m2 < 2; ++m2)
#pragma unroll
      for (int ni = 0; ni < 2; ++ni)
#pragma unroll
        for (int r = 0; r < 16; ++r) {
          int j = m2 * 32 + (r & 3) + 8 * (r >> 2) + 4 * (lane >> 5);
          int col = wn * 64 + ni * 32 + (lane & 31);
          sC[(wm * 66 + 2 + j) * LDC + col] = acc[2 * h + m2][ni][r];
        }
    if (HALO) {
      if (h == 0) {
        if (wm == 0 && lane >= 32) {
#pragma unroll
          for (int ni = 0; ni < 2; ++ni) {
            int col = wn * 64 + ni * 32 + (lane & 31);
            sC[(66 + 0) * LDC + col] = acc[3][ni][14];
            sC[(66 + 1) * LDC + col] = acc[3][ni][15];
          }
        }
      } else {
        if (lane >= 32) {
#pragma unroll
          for (int ni = 0; ni < 2; ++ni) {
            int col = wn * 64 + ni * 32 + (lane & 31);
            sC[(wm * 66 + 0) * LDC + col] = acc[1][ni][14];
            sC[(wm * 66 + 1) * LDC + col] = acc[1][ni][15];
          }
        }
      }
    }
    __syncthreads();
    epi(h, sC);
  }
}


#define GSTAGE_B (384 * 64)
#define WAITV(n) asm volatile("s_waitcnt vmcnt(%0)" ::"n"(n) : "memory")
#define RAWBAR() do { asm volatile("s_waitcnt lgkmcnt(0)" ::: "memory"); __builtin_amdgcn_s_barrier(); } while (0)
template <bool HALO, class PA, class PB, class EPI>
__device__ __forceinline__ void gemm256g(const u16* baseA, const u16* baseB, PA pa, PB pb, EPI epi, int nk, char* smem) {
  const int tid = threadIdx.x, lane = tid & 63, wave = tid >> 6;
  const int wm = wave >> 1, wn = wave & 1;
  const int lrow = tid >> 2, cpos = tid & 3;
  f32x16 acc[4][2];
#pragma unroll
  for (int i = 0; i < 4; ++i)
#pragma unroll
    for (int j = 0; j < 2; ++j)
#pragma unroll
      for (int r = 0; r < 16; ++r) acc[i][j][r] = 0.f;
  const int koff = 8 * (cpos ^ ((lrow >> 2) & 3));
  unsigned offA[4], offB[2];
#pragma unroll
  for (int i = 0; i < 4; ++i) offA[i] = (pa(lrow + 64 * i) + koff) * 2u;
#pragma unroll
  for (int i = 0; i < 2; ++i) offB[i] = (pb(lrow + 64 * i) + koff) * 2u;
  auto issue = [&](int kt, int st) {
    char* base = smem + st * GSTAGE_B;
    const unsigned kb = kt * 64;
#pragma unroll
    for (int i = 0; i < 4; ++i)
      __builtin_amdgcn_global_load_lds((const unsigned*)(reinterpret_cast<const char*>(baseA) + (size_t)(offA[i] + kb)),
                                       (unsigned*)(base + (lrow + 64 * i) * 64 + cpos * 16), 16, 0, 0);
#pragma unroll
    for (int i = 0; i < 2; ++i)
      __builtin_amdgcn_global_load_lds((const unsigned*)(reinterpret_cast<const char*>(baseB) + (size_t)(offB[i] + kb)),
                                       (unsigned*)(base + (256 + lrow + 64 * i) * 64 + cpos * 16), 16, 0, 0);
  };
  WAITV(0);
  __syncthreads();
  issue(0, 0);
  if (nk > 1) issue(1, 1);
  if (nk > 2) issue(2, 2);
  if (nk > 2) WAITV(12); else if (nk > 1) WAITV(6); else WAITV(0);
  RAWBAR();
  const int sw = ((lane & 31) >> 2) & 3;
  const unsigned lds0 = (unsigned)(size_t)((__attribute__((address_space(3))) char*)smem);
  const unsigned ra_off = lds0 + (wm * 128 + (lane & 31)) * 64;
  const unsigned rb_off = lds0 + (256 + wn * 64 + (lane & 31)) * 64;
  const unsigned ph0 = (((lane >> 5)) ^ sw) * 16, ph1 = ((2 + (lane >> 5)) ^ sw) * 16;
#define GR6(F, aA, aB)                                                                                              \
  asm volatile("ds_read_b128 %0, %6\n\tds_read_b128 %4, %7\n\tds_read_b128 %1, %6 offset:2048\n\t"                 \
               "ds_read_b128 %5, %7 offset:2048\n\tds_read_b128 %2, %6 offset:4096\n\tds_read_b128 %3, %6 offset:6144" \
               : "=&v"(F[0]), "=&v"(F[1]), "=&v"(F[2]), "=&v"(F[3]), "=&v"(F[4]), "=&v"(F[5])                       \
               : "v"(aA), "v"(aB)                                                                                   \
               : "memory")
#define GW(n, F)                                                                                                    \
  asm volatile("s_waitcnt lgkmcnt(" #n ")"                                                                          \
               : "+v"(F[0]), "+v"(F[1]), "+v"(F[2]), "+v"(F[3]), "+v"(F[4]), "+v"(F[5])::"memory")
#define GMMA(F)                                                                                                     \
  _Pragma("unroll") for (int mi = 0; mi < 4; ++mi) _Pragma("unroll") for (int ni = 0; ni < 2; ++ni)                 \
      acc[mi][ni] = __builtin_amdgcn_mfma_f32_32x32x16_bf16(F[mi], F[4 + ni], acc[mi][ni], 0, 0, 0)
  bf16x8 F0[6], F1[6];
  {
    const unsigned aA = ra_off + ph0, aB = rb_off + ph0;
    GR6(F0, aA, aB);
  }
  int st = 0;
#pragma unroll 1
  for (int kt = 0; kt < nk; ++kt) {
    const unsigned sb = st * GSTAGE_B;
    {
      const unsigned aA = sb + ra_off + ph1, aB = sb + rb_off + ph1;
      GR6(F1, aA, aB);
    }
    GW(6, F0);
    __builtin_amdgcn_sched_barrier(0);
    GMMA(F0);
    __builtin_amdgcn_sched_barrier(0);
    GW(0, F1);
    if (kt + 1 < nk) { if (kt + 2 < nk) WAITV(6); else WAITV(0); }
    __builtin_amdgcn_s_barrier();
    __builtin_amdgcn_sched_barrier(0);
    int st1 = st + 1; if (st1 >= 3) st1 = 0;
    if (kt + 1 < nk) {
      const unsigned aA = st1 * GSTAGE_B + ra_off + ph0, aB = st1 * GSTAGE_B + rb_off + ph0;
      GR6(F0, aA, aB);
    }
    if (kt + 3 < nk) issue(kt + 3, st);
    __builtin_amdgcn_sched_barrier(0);
    GMMA(F1);
    __builtin_amdgcn_sched_barrier(0);
    st = st1;
  }
  asm volatile("s_waitcnt lgkmcnt(0)" ::: "memory");
  float* sC = reinterpret_cast<float*>(smem);
#pragma unroll
  for (int h = 0; h < 2; ++h) {
    __syncthreads();
#pragma unroll
    for (int m2 = 0; m2 < 2; ++m2)
#pragma unroll
      for (int ni = 0; ni < 2; ++ni)
#pragma unroll
        for (int r = 0; r < 16; ++r) {
          int j = m2 * 32 + (r & 3) + 8 * (r >> 2) + 4 * (lane >> 5);
          int col = wn * 64 + ni * 32 + (lane & 31);
          sC[(wm * 66 + 2 + j) * LDG + col] = acc[2 * h + m2][ni][r];
        }
    if (HALO) {
      if (h == 0) {
        if (wm == 0 && lane >= 32) {
#pragma unroll
          for (int ni = 0; ni < 2; ++ni) {
            int col = wn * 64 + ni * 32 + (lane & 31);
            sC[(66 + 0) * LDG + col] = acc[3][ni][14];
            sC[(66 + 1) * LDG + col] = acc[3][ni][15];
          }
        }
      } else {
        if (lane >= 32) {
#pragma unroll
          for (int ni = 0; ni < 2; ++ni) {
            int col = wn * 64 + ni * 32 + (lane & 31);
            sC[(wm * 66 + 0) * LDG + col] = acc[1][ni][14];
            sC[(wm * 66 + 1) * LDG + col] = acc[1][ni][15];
          }
        }
      }
    }
    __syncthreads();
    epi(h, sC);
  }
}

__device__ __forceinline__ float4 ld4f(const float* p, bool vec) {
  if (vec) return *reinterpret_cast<const float4*>(p);
  return make_float4(p[0], p[1], p[2], p[3]);
}
template <bool SPLIT>
__device__ __forceinline__ int epi_srow(int v) { return SPLIT ? (v >> 6) * 66 + 2 + (v & 63) : v; }
template <bool SPLIT>
__device__ __forceinline__ int epi_grow(int v, int row0, int h) { return SPLIT ? row0 + 128 * (v >> 6) + 64 * h + (v & 63) : row0 + v; }

template <bool SPLIT>
__device__ __forceinline__ void glu_epi(const Params& p, const float* sC, int row0, int h, int n0) {
  float* X = p.out;
  const int cg = threadIdx.x & 15, r0 = threadIdx.x >> 4;
  const float4 b1 = *reinterpret_cast<const float4*>(p.b_glu + n0 + 4 * cg);
  const float4 b2 = *reinterpret_cast<const float4*>(p.b_glu + 1024 + n0 + 4 * cg);
#pragma unroll
  for (int hh = 0; hh < 2; ++hh) {
    float4 xv[4];
#pragma unroll
    for (int i = 0; i < 4; ++i) xv[i] = *reinterpret_cast<const float4*>(xrow_in(p, epi_grow<SPLIT>(r0 + 16 * (hh * 4 + i), row0, h)) + n0 + 4 * cg);
#pragma unroll
    for (int i = 0; i < 4; ++i) {
      int v = r0 + 16 * (hh * 4 + i);
      const float* c = sC + epi_srow<SPLIT>(v) * (SPLIT ? LDG : LDC) + 4 * cg;
      const float4 g1 = ld4f(c, SPLIT), g2 = ld4f(c + 64, SPLIT);
      float4 o;
      o.x = xv[i].x + (g1.x + b1.x) * sigmoid_fast(g2.x + b2.x);
      o.y = xv[i].y + (g1.y + b1.y) * sigmoid_fast(g2.y + b2.y);
      o.z = xv[i].z + (g1.z + b1.z) * sigmoid_fast(g2.z + b2.z);
      o.w = xv[i].w + (g1.w + b1.w) * sigmoid_fast(g2.w + b2.w);
      *reinterpret_cast<float4*>(X + (size_t)epi_grow<SPLIT>(v, row0, h) * 1024 + n0 + 4 * cg) = o;
    }
  }
}
template <bool SPLIT>
__device__ __forceinline__ void resid_epi(const Params& p, const float* sC, int row0, int h, int col0) {
  const int cg = threadIdx.x & 31, r0 = threadIdx.x >> 5;
  float* xb = p.out + col0 + 4 * cg;
#pragma unroll
  for (int half = 0; half < 2; ++half) {
    float4 xv[8];
#pragma unroll
    for (int i = 0; i < 8; ++i) xv[i] = *reinterpret_cast<const float4*>(xb + (size_t)epi_grow<SPLIT>(r0 + 8 * (half * 8 + i), row0, h) * 1024);
#pragma unroll
    for (int i = 0; i < 8; ++i) {
      int v = r0 + 8 * (half * 8 + i);
      const float4 cv = ld4f(sC + epi_srow<SPLIT>(v) * (SPLIT ? LDG : LDC) + 4 * cg, SPLIT);
      float4 o = make_float4(xv[i].x + cv.x, xv[i].y + cv.y, xv[i].z + cv.z, xv[i].w + cv.w);
      *reinterpret_cast<float4*>(xb + (size_t)epi_grow<SPLIT>(v, row0, h) * 1024) = o;
    }
  }
}

__device__ __forceinline__ void phase4(const Params& p, char* smem) {
  const u16* Z = reinterpret_cast<const u16*>(p.ws + R_Z);
  const u16* W = reinterpret_cast<const u16*>(p.ws + W_GLU);
  for (TileSched ts(64 * 16); ts.i < ts.end; ts.i += ts.step) {
    int mt, nt;
    tile_decode(ts.i, 64, 16, mt, nt);
    int n0 = nt * 64;
    auto la = [=](int r) -> unsigned { return (unsigned)(mt * 256 + r) * 1024u; };
    auto lb = [=](int nl) -> unsigned {
      int nrow = nl < 64 ? n0 + nl : 1024 + n0 + nl - 64;
      return (unsigned)nrow * 1024u;
    };
    auto epi = [&](int h, const float* sC) { glu_epi<true>(p, sC, mt * 256, h, n0); };
    gemm256g<false>(Z, W, la, lb, epi, 32, smem);
  }
  for (int job = blockIdx.x; job < 32; job += gridDim.x) {
    int mt = 128 + (job >> 4), nt = job & 15;
    int n0 = nt * 64;
    auto la = [=](int r, int k) -> uint4 { return ld16(Z + (size_t)(mt * 128 + r) * 1024 + k); };
    auto lb = [=](int nl, int k) -> uint4 {
      int nrow = nl < 64 ? n0 + nl : 1024 + n0 + nl - 64;
      return ld16(W + (size_t)nrow * 1024 + k);
    };
    gemm_core(la, lb, KIdent(), 16, smem);
    glu_epi<false>(p, reinterpret_cast<const float*>(smem), mt * 128, 0, n0);
  }
}


__device__ __forceinline__ size_t ki_off(int row, int kc) { return ((size_t)((row >> 5) * 8 + kc) * 32 + (row & 31)) * 8; }

__device__ __forceinline__ void phase_norm(const Params& p, const float* gw, bool conv_caches) {
  int nj = 1040 + (conv_caches ? (4096 + 4096 + 1024) : 0);
  if (blockIdx.x == 0 && threadIdx.x < 128) *reinterpret_cast<uint4*>(reinterpret_cast<u16*>(p.ws + R_HN) + (size_t)NTOK * 1024 + threadIdx.x * 8) = zero4();
  for (int job = blockIdx.x; job < nj; job += gridDim.x) {
    if (job < 1040) {
      norm_hn_job(p, p.out, gw, job);
    } else {
      int j = job - 1040;
      if (j < 8192) {
        const float* src = j < 4096 ? p.cache_k : p.cache_v;
        u16* dst = reinterpret_cast<u16*>(p.ws + (j < 4096 ? R_KB : R_VB));
        int jj = j & 4095;
        size_t e = ((size_t)jj * 256 + threadIdx.x) * 8;
        int b = (int)(e >> 20);
        size_t within = e & ((1u << 20) - 1);
        float4 a = *reinterpret_cast<const float4*>(src + e);
        float4 c = *reinterpret_cast<const float4*>(src + e + 4);
        uint4 o = make_uint4(pack2(a.x, a.y), pack2(a.z, a.w), pack2(c.x, c.y), pack2(c.z, c.w));
        *reinterpret_cast<uint4*>(dst + ((size_t)NPR + (size_t)b * 4128) * 256 + within) = o;
      } else {
        int jj = j - 8192;
        size_t e = ((size_t)jj * 256 + threadIdx.x) * 8;
        int b = (int)(e >> 18);
        size_t within = e & ((1u << 18) - 1);
        float4 a = *reinterpret_cast<const float4*>(p.cache_kidx + e);
        float4 c = *reinterpret_cast<const float4*>(p.cache_kidx + e + 4);
        uint4 o = make_uint4(pack2(a.x, a.y), pack2(a.z, a.w), pack2(c.x, c.y), pack2(c.z, c.w));
        {
          int row = NPR + b * 4128 + (int)(within >> 6), kc = (int)((within & 63) >> 3);
          *reinterpret_cast<uint4*>(reinterpret_cast<u16*>(p.ws + R_KI) + ki_off(row, kc)) = o;
        }
      }
    }
  }
}

__device__ __forceinline__ void phase_up(const Params& p, int layer, char* smem) {
  const u16* HN = reinterpret_cast<const u16*>(p.ws + R_HN);
  const u16* W = reinterpret_cast<const u16*>(p.ws + W_UP) + (size_t)layer * 5632 * 1024;
  u16* GT = reinterpret_cast<u16*>(p.ws + R_GT);
  const float* cw = p.conv_w + (size_t)layer * 3 * 2816;
  const float* cb = p.conv_b + (size_t)layer * 2816;
  for (TileSched ts(69 * 44); ts.i < ts.end; ts.i += ts.step) {
    int mt, nt;
    tile_decode(ts.i, 69, 44, mt, nt);
    const int n0 = nt * 64;
    const bool prompt = mt < 68;
    const int s = mt / 17, it = mt - s * 17;
    const int tbase = 254 * it - 2;
    const int rbase = prompt ? s * 4096 : NPR;
    auto la = [=](int r) -> unsigned {
      if (prompt) {
        int tp = tbase + r;
        if (tp < 0 || tp >= 4096) return (unsigned)NTOK * 1024u;
        return (unsigned)(rbase + tp) * 1024u;
      }
      return (unsigned)(rbase + r) * 1024u;
    };
    auto lb = [=](int nl) -> unsigned {
      int nrow = nl < 64 ? n0 + nl : 2816 + n0 + nl - 64;
      return (unsigned)nrow * 1024u;
    };
    auto epi = [&](int h, const float* sC) {
      const int cg = threadIdx.x & 15, r0 = threadIdx.x >> 4;
      const int col = n0 + 4 * cg;
      const float4 w0 = *reinterpret_cast<const float4*>(cw + col);
      const float4 w1 = *reinterpret_cast<const float4*>(cw + 2816 + col);
      const float4 w2 = *reinterpret_cast<const float4*>(cw + 2 * 2816 + col);
      const float4 bb = *reinterpret_cast<const float4*>(cb + col);
#pragma unroll 1
      for (int i = 0; i < 8; ++i) {
        const int v = r0 + 16 * i;
        const int r = 128 * (v >> 6) + 64 * h + (v & 63);
        const int sr = (v >> 6) * 66 + 2 + (v & 63);
        const float* c = sC + sr * LDG + 4 * cg;
        float4 a0 = *reinterpret_cast<const float4*>(c);
        float4 bv = *reinterpret_cast<const float4*>(c + 64);
        float4 a1 = *reinterpret_cast<const float4*>(c - LDG);
        float4 a2 = *reinterpret_cast<const float4*>(c - 2 * LDG);
        size_t orow;
        bool doit;
        if (prompt) {
          int tp = tbase + r;
          doit = (r >= 2 && tp < 4096);
          orow = (size_t)(rbase + tp);
          if (doit && tp >= 4094)
            *reinterpret_cast<float4*>(p.out + O_CONV_P + ((size_t)(layer * 4 + s) * 2 + (tp - 4094)) * 2816 + col) = a0;
        } else {
          doit = true;
          int b = r >> 5, t = r & 31;
          const float* cc = p.cache_conv + ((size_t)(layer * 8 + b) * 2) * 2816 + col;
          if (t < 1) a1 = *reinterpret_cast<const float4*>(cc + 2816);
          if (t < 2) a2 = *reinterpret_cast<const float4*>(cc + (size_t)t * 2816);
          orow = (size_t)(rbase + r);
          if (t >= 30) *reinterpret_cast<float4*>(p.out + O_CONV_S + ((size_t)(layer * 8 + b) * 2 + (t - 30)) * 2816 + col) = a0;
        }
        if (doit) {
          float c0 = bb.x + w0.x * a2.x + w1.x * a1.x + w2.x * a0.x;
          float c1v = bb.y + w0.y * a2.y + w1.y * a1.y + w2.y * a0.y;
          float c2v = bb.z + w0.z * a2.z + w1.z * a1.z + w2.z * a0.z;
          float c3v = bb.w + w0.w * a2.w + w1.w * a1.w + w2.w * a0.w;
          uint2 o;
          o.x = pack2(gelu_tanh(c0) * bv.x, gelu_tanh(c1v) * bv.y);
          o.y = pack2(gelu_tanh(c2v) * bv.z, gelu_tanh(c3v) * bv.w);
          *reinterpret_cast<uint2*>(GT + orow * 2816 + col) = o;
        }
      }
    };
    gemm256g<true>(HN, W, la, lb, epi, 32, smem);
  }
}

__device__ __forceinline__ void phase_resid_gemm(const Params& p, const u16* A, const u16* W, int K, char* smem) {
  {
    const int nsplit = K / 256;
    for (int job = blockIdx.x; job < 16 * nsplit; job += gridDim.x) {
      int sp = job / 16, tl = job % 16;
      int mt = 128 + (tl >> 3), nt = tl & 7;
      auto la = [=](int r, int k) -> uint4 { return ld16(A + (size_t)(mt * 128 + r) * K + k); };
      auto lb = [=](int nl, int k) -> uint4 { return ld16(W + (size_t)(nt * 128 + nl) * K + k); };
      KOff ko; ko.base = sp * 256;
      gemm_core(la, lb, ko, 4, smem);
      const float* sC = reinterpret_cast<const float*>(smem);
      float* xb = p.out + (size_t)(mt * 128) * 1024 + nt * 128;
      for (int idx = threadIdx.x; idx < 128 * 128; idx += 256) {
        int r = idx >> 7, n = idx & 127;
        unsafeAtomicAdd(xb + (size_t)r * 1024 + n, sC[r * LDC + n]);
      }
    }
  }
  for (TileSched ts(64 * 8); ts.i < ts.end; ts.i += ts.step) {
    int mt, nt;
    tile_decode(ts.i, 64, 8, mt, nt);
    auto la = [=](int r) -> unsigned { return (unsigned)(mt * 256 + r) * (unsigned)K; };
    auto lb = [=](int nl) -> unsigned { return (unsigned)(nt * 128 + nl) * (unsigned)K; };
    auto epi = [&](int h, const float* sC) { resid_epi<true>(p, sC, mt * 256, h, nt * 128); };
    gemm256g<false>(A, W, la, lb, epi, K / 32, smem);
  }
}

__device__ __forceinline__ void rope16(float* v, int pos) {
  const float inv[8] = {1.000000000e+00f, 1.939227432e-01f, 3.760603070e-02f, 7.292664610e-03f,
                        1.414213562e-03f, 2.742481884e-04f, 5.318296098e-05f, 1.031338616e-05f};
  float fp = (float)pos;
#pragma unroll
  for (int i = 0; i < 8; ++i) {
    float ang = fp * inv[i];
    float sn, cs;
    sincosf(ang, &sn, &cs);
    float x1 = v[i], x2 = v[8 + i];
    v[i] = x1 * cs - x2 * sn;
    v[8 + i] = x2 * cs + x1 * sn;
  }
}

__device__ __forceinline__ void store64_bf16(u16* dst, const float* v) {
#pragma unroll
  for (int i = 0; i < 8; ++i) {
    uint4 o = make_uint4(pack2(v[8 * i], v[8 * i + 1]), pack2(v[8 * i + 2], v[8 * i + 3]),
                         pack2(v[8 * i + 4], v[8 * i + 5]), pack2(v[8 * i + 6], v[8 * i + 7]));
    *reinterpret_cast<uint4*>(dst + 8 * i) = o;
  }
}
__device__ __forceinline__ void store64_f32(float* dst, const float* v) {
#pragma unroll
  for (int i = 0; i < 16; ++i) *reinterpret_cast<float4*>(dst + 4 * i) = make_float4(v[4 * i], v[4 * i + 1], v[4 * i + 2], v[4 * i + 3]);
}

__device__ __forceinline__ void phase_win(const Params& p, char* smem) {
  const u16* HN = reinterpret_cast<const u16*>(p.ws + R_HN);
  const u16* W = reinterpret_cast<const u16*>(p.ws + W_IN);
  u16* QB = reinterpret_cast<u16*>(p.ws + R_QB);
  u16* KB = reinterpret_cast<u16*>(p.ws + R_KB);
  u16* VB = reinterpret_cast<u16*>(p.ws + R_VB);
  u16* QI = reinterpret_cast<u16*>(p.ws + R_QI);
  u16* KI = reinterpret_cast<u16*>(p.ws + R_KI);
  float* WI = reinterpret_cast<float*>(p.ws + R_WI);
  for (TileSched ts(130 * 17); ts.i < ts.end; ts.i += ts.step) {
    int mt, nt;
    tile_decode(ts.i, 130, 17, mt, nt);
    auto la = [=](int r, int k) -> uint4 { return ld16(HN + (size_t)(mt * 128 + r) * 1024 + k); };
    auto lb = [=](int nl, int k) -> uint4 { return ld16(W + (size_t)(nt * 128 + nl) * 1024 + k); };
    gemm_core(la, lb, KIdent(), 16, smem);
    const float* sC = reinterpret_cast<const float*>(smem);
    int r = threadIdx.x & 127, h = threadIdx.x >> 7;
    int cbase = nt * 128 + 64 * h;
    int row = mt * 128 + r;
    int pos, kvrow;
    if (row < NPR) { pos = row & 4095; kvrow = row; }
    else { int bs = (row - NPR) >> 5, t = (row - NPR) & 31; pos = 4096 + t; kvrow = NPR + bs * 4128 + 4096 + t; }
    if (cbase < 2112) {
      float v[64];
#pragma unroll
      for (int d = 0; d < 64; ++d) v[d] = sC[r * LDC + 64 * h + d];
      if (cbase < 1280) {
        float ss = 0.f;
#pragma unroll
        for (int d = 0; d < 64; ++d) ss += v[d] * v[d];
        float rs = rsqrtf(ss * (1.f / 64.f) + 1e-6f);
        const float* gw = cbase < 1024 ? p.q_norm : p.k_norm;
#pragma unroll
        for (int d = 0; d < 64; ++d) v[d] = v[d] * rs * gw[d];
      }
      if (cbase < 1280 || cbase >= 1536) rope16(v, pos);
      if (cbase < 1024) {
        store64_bf16(QB + (size_t)row * 1024 + cbase, v);
      } else if (cbase < 1280) {
        store64_bf16(KB + (size_t)kvrow * 256 + (cbase - 1024), v);
        float* o = row < NPR ? p.out + O_K_P + (size_t)row * 256 : p.out + O_K_S + (size_t)(row - NPR) * 256;
        store64_f32(o + (cbase - 1024), v);
      } else if (cbase < 1536) {
        store64_bf16(VB + (size_t)kvrow * 256 + (cbase - 1280), v);
        float* o = row < NPR ? p.out + O_V_P + (size_t)row * 256 : p.out + O_V_S + (size_t)(row - NPR) * 256;
        store64_f32(o + (cbase - 1280), v);
      } else if (cbase < 2048) {
        store64_bf16(QI + (size_t)row * 512 + (cbase - 1536), v);
      } else {
#pragma unroll
        for (int kc = 0; kc < 8; ++kc) {
          uint4 o = make_uint4(pack2(v[8 * kc], v[8 * kc + 1]), pack2(v[8 * kc + 2], v[8 * kc + 3]),
                               pack2(v[8 * kc + 4], v[8 * kc + 5]), pack2(v[8 * kc + 6], v[8 * kc + 7]));
          *reinterpret_cast<uint4*>(KI + ki_off(kvrow, kc)) = o;
        }
        float* o = row < NPR ? p.out + O_KI_P + (size_t)row * 64 : p.out + O_KI_S + (size_t)(row - NPR) * 64;
        store64_f32(o, v);
      }
    } else if (cbase == 2112) {
      float w[8];
#pragma unroll
      for (int d = 0; d < 8; ++d) w[d] = sC[r * LDC + 64 * h + d];
      *reinterpret_cast<float4*>(WI + (size_t)row * 8) = make_float4(w[0], w[1], w[2], w[3]);
      *reinterpret_cast<float4*>(WI + (size_t)row * 8 + 4) = make_float4(w[4], w[5], w[6], w[7]);
    }
  }
}

__device__ __forceinline__ unsigned f2key(float f) {
  unsigned u = __float_as_uint(f);
  return (u & 0x80000000u) ? ~u : (u | 0x80000000u);
}

__device__ __forceinline__ void phase_index(const Params& p, char* smem) {
  const u16* QI = reinterpret_cast<const u16*>(p.ws + R_QI);
  const u16* KI = reinterpret_cast<const u16*>(p.ws + R_KI);
  const float* WI = reinterpret_cast<const float*>(p.ws + R_WI);
  u16* SEL = reinterpret_cast<u16*>(p.ws + R_SEL);
  int* CNT = reinterpret_cast<int*>(p.ws + R_CNT);
  float* sc = reinterpret_cast<float*>(smem);
  unsigned* histall = reinterpret_cast<unsigned*>(smem + 66048);
  const int tid = threadIdx.x, lane = tid & 63, wave = tid >> 6;
  for (int item = blockIdx.x; item < 64 + 4096; item += gridDim.x) {
    int tok0, nk, seqbase;
    if (item < 64) {
      tok0 = NPR + item * 4;
      nk = 4128;
      seqbase = NPR + (item >> 3) * 4128;
    } else {
      int it = item - 64;
      int c = 63 - (it >> 6);
      int b = (it & 63) >> 4, q4 = it & 15;
      tok0 = b * 4096 + c * 64 + q4 * 4;
      nk = 64 * (c + 1);
      seqbase = b * 4096;
    }
    __syncthreads();
    if (nk > 256) {
      bf16x8 af[4];
      {
        int q = (lane & 31) >> 3, h = lane & 7;
        const u16* src = QI + (size_t)(tok0 + q) * 512 + h * 64 + 8 * (lane >> 5);
#pragma unroll
        for (int kk = 0; kk < 4; ++kk) {
          uint4 t = ld16(src + kk * 16);
          af[kk] = *reinterpret_cast<bf16x8*>(&t);
        }
      }
      float wsc[16];
#pragma unroll
      for (int q = 0; q < 4; ++q) {
        float4 t = *reinterpret_cast<const float4*>(WI + (size_t)(tok0 + q) * 8 + 4 * (lane >> 5));
        const float s = 0.125f * 0.35355339059327373f;
        wsc[4 * q] = t.x * s; wsc[4 * q + 1] = t.y * s; wsc[4 * q + 2] = t.z * s; wsc[4 * q + 3] = t.w * s;
      }
      int ntile = nk >> 5;
      const u16* kbase = KI + (size_t)seqbase * 64;
      for (int t0 = wave; t0 < ntile; t0 += 32) {
        uint4 kb[8][4];
#pragma unroll
        for (int j = 0; j < 8; ++j) {
          int tile = t0 + 4 * j;
          if (tile < ntile) {
            const u16* kr = kbase + ((size_t)(tile * 8 + (lane >> 5)) * 32 + (lane & 31)) * 8;
#pragma unroll
            for (int kk = 0; kk < 4; ++kk) kb[j][kk] = ld16(kr + kk * 2 * 256);
          }
        }
        __builtin_amdgcn_sched_barrier(0);
#pragma unroll
        for (int j = 0; j < 8; ++j) {
          int tile = t0 + 4 * j;
          if (tile < ntile) {
            f32x16 acc;
#pragma unroll
            for (int r = 0; r < 16; ++r) acc[r] = 0.f;
#pragma unroll
            for (int kk = 0; kk < 4; ++kk)
              acc = __builtin_amdgcn_mfma_f32_32x32x16_bf16(af[kk], *reinterpret_cast<bf16x8*>(&kb[j][kk]), acc, 0, 0, 0);
            float sq[4];
#pragma unroll
            for (int q = 0; q < 4; ++q) {
              float sv = 0.f;
#pragma unroll
              for (int rr = 0; rr < 4; ++rr) sv += fmaxf(acc[4 * q + rr], 0.f) * wsc[4 * q + rr];
              sv += __shfl_xor(sv, 32);
              sq[q] = sv;
            }
            if (lane < 32) {
#pragma unroll
              for (int q = 0; q < 4; ++q) sc[q * SC_LD + tile * 32 + lane] = sq[q];
            }
          }
        }
      }
    }
    __syncthreads();
    {
      int token = tok0 + wave;
      u16* sel = SEL + (size_t)token * 256;
      if (nk <= 256) {
        for (int i = lane; i < 256; i += 64) sel[i] = (u16)(i < nk ? i : 0);
        if (lane == 0) CNT[token] = nk;
      } else {
        const float* s = sc + wave * SC_LD;
        unsigned* hist = histall + wave * 256;
        unsigned prefix = 0, mask = 0;
        unsigned need = 256;
        for (int shift = 24; shift >= 0; shift -= 8) {
          for (int i = lane; i < 256; i += 64) hist[i] = 0;
          __builtin_amdgcn_s_waitcnt(0xc07f);
          for (int e0 = lane * 4; e0 < nk; e0 += 256) {
            float4 v4 = *reinterpret_cast<const float4*>(s + e0);
            unsigned u0 = f2key(v4.x), u1 = f2key(v4.y), u2 = f2key(v4.z), u3 = f2key(v4.w);
            if ((u0 & mask) == prefix) atomicAdd(&hist[(u0 >> shift) & 255u], 1u);
            if ((u1 & mask) == prefix) atomicAdd(&hist[(u1 >> shift) & 255u], 1u);
            if ((u2 & mask) == prefix) atomicAdd(&hist[(u2 >> shift) & 255u], 1u);
            if ((u3 & mask) == prefix) atomicAdd(&hist[(u3 >> shift) & 255u], 1u);
          }
          __builtin_amdgcn_s_waitcnt(0xc07f);
          __builtin_amdgcn_wave_barrier();
          unsigned h0 = hist[4 * lane], h1 = hist[4 * lane + 1], h2 = hist[4 * lane + 2], h3 = hist[4 * lane + 3];
          unsigned loc = h0 + h1 + h2 + h3;
          unsigned suf = loc;
#pragma unroll
          for (int d = 1; d < 64; d <<= 1) {
            unsigned t = __shfl_down(suf, d);
            if (lane + d < 64) suf += t;
          }
          unsigned above = suf - loc;
          bool cross = (above < need) && (need <= above + loc);
          unsigned long long bal = __ballot(cross);
          int src = __ffsll((long long)bal) - 1;
          unsigned binsel = 0, newneed = 0;
          if (cross) {
            unsigned cum = above;
            if (cum + h3 >= need) { binsel = 4 * lane + 3; newneed = need - cum; }
            else {
              cum += h3;
              if (cum + h2 >= need) { binsel = 4 * lane + 2; newneed = need - cum; }
              else {
                cum += h2;
                if (cum + h1 >= need) { binsel = 4 * lane + 1; newneed = need - cum; }
                else { cum += h1; binsel = 4 * lane; newneed = need - cum; }
              }
            }
          }
          binsel = __shfl(binsel, src);
          newneed = __shfl(newneed, src);
          prefix |= binsel << shift;
          mask |= 255u << shift;
          need = newneed;
          __builtin_amdgcn_wave_barrier();
        }
        const unsigned T = prefix;
        const unsigned long long lt = (1ull << lane) - 1ull;
        int base = 0, eqtaken = 0;
        for (int i0 = 0; i0 < nk; i0 += 256) {
          int e0 = i0 + lane * 4;
          bool in = e0 < nk;
          float4 v4 = in ? *reinterpret_cast<const float4*>(s + e0) : make_float4(0.f, 0.f, 0.f, 0.f);
          unsigned u[4] = {f2key(v4.x), f2key(v4.y), f2key(v4.z), f2key(v4.w)};
          bool eq[4], gt[4];
          int eqbefore = 0;
#pragma unroll
          for (int j = 0; j < 4; ++j) {
            gt[j] = in && (u[j] > T);
            eq[j] = in && (u[j] == T);
          }
          unsigned long long be[4];
          int eqtot = 0;
#pragma unroll
          for (int j = 0; j < 4; ++j) {
            be[j] = __ballot(eq[j]);
            eqbefore += __popcll(be[j] & lt);
            eqtot += __popcll(be[j]);
          }
          bool take[4];
          int mine_eq = 0;
#pragma unroll
          for (int j = 0; j < 4; ++j) {
            int eqrank = eqtaken + eqbefore + mine_eq;
            take[j] = gt[j] || (eq[j] && eqrank < (int)need);
            mine_eq += eq[j] ? 1 : 0;
          }
          int tkbefore = 0, tktot = 0;
#pragma unroll
          for (int j = 0; j < 4; ++j) {
            unsigned long long bt = __ballot(take[j]);
            tkbefore += __popcll(bt & lt);
            tktot += __popcll(bt);
          }
          int pos = base + tkbefore;
#pragma unroll
          for (int j = 0; j < 4; ++j) {
            if (take[j]) {
              if (pos < 256) sel[pos] = (u16)(e0 + j);
              ++pos;
            }
          }
          base += tktot;
          eqtaken += eqtot;
        }
        if (lane == 0) CNT[token] = 256;
      }
    }
  }
}

__device__ __forceinline__ void load_v_round(const u16* __restrict__ VB, const int* sidx, int rd, int kvh, int lane, uint4 (&vv)[8]) {
#pragma unroll
  for (int i = 0; i < 8; ++i) {
    int pid = lane + 64 * i;
    int rowl = pid >> 3, piece = pid & 7;
    int row = sidx[64 * rd + rowl];
    unsigned off = (unsigned)row * 512u + (unsigned)(kvh * 128 + piece * 16);
    vv[i] = ld16(reinterpret_cast<const char*>(VB) + off);
  }
}

template <int RD>
__device__ __forceinline__ void pv_round(const u16* __restrict__ VB, const int* sidx, int kvh, int lane, u16* Vs,
                                         uint4 (&vv)[8], f32x4 (&sacc)[16], float inv, f32x4 (&oacc)[4]) {
  const int g = lane >> 4, n = lane & 15;
  uint4 vn[8];
  if (RD < 3) load_v_round(VB, sidx, RD + 1, kvh, lane, vn);
  __builtin_amdgcn_sched_barrier(0);
  __builtin_amdgcn_wave_barrier();
#pragma unroll
  for (int i = 0; i < 8; ++i) {
    int pid = lane + 64 * i;
    int rowl = pid >> 3, piece = pid & 7;
    *reinterpret_cast<uint4*>(&Vs[rowl * LDSK + piece * 8]) = vv[i];
  }
  __builtin_amdgcn_s_waitcnt(0xc07f);
  __builtin_amdgcn_wave_barrier();
#pragma unroll
  for (int ch = 0; ch < 2; ++ch) {
    constexpr int tb = 4 * RD;
    const int t0 = tb + 2 * ch;
    uint4 pa;
    pa.x = pack2(sacc[t0][0] * inv, sacc[t0][1] * inv);
    pa.y = pack2(sacc[t0][2] * inv, sacc[t0][3] * inv);
    pa.z = pack2(sacc[t0 + 1][0] * inv, sacc[t0 + 1][1] * inv);
    pa.w = pack2(sacc[t0 + 1][2] * inv, sacc[t0 + 1][3] * inv);
    bf16x8 afrag = *reinterpret_cast<bf16x8*>(&pa);
    int qq = n >> 2, pp = n & 3;
    int lr0 = 32 * ch + 4 * g + qq;
#pragma unroll
    for (int nt = 0; nt < 4; ++nt) {
      typedef __attribute__((address_space(3))) s16x4* lds_s4p;
      s16x4 r0 = __builtin_amdgcn_ds_read_tr16_b64_v4i16((lds_s4p)(&Vs[lr0 * LDSK + 16 * nt + 4 * pp]));
      s16x4 r1 = __builtin_amdgcn_ds_read_tr16_b64_v4i16((lds_s4p)(&Vs[(lr0 + 16) * LDSK + 16 * nt + 4 * pp]));
      uint4 bw;
      bw.x = (unsigned)(u16)r0[0] | ((unsigned)(u16)r0[1] << 16);
      bw.y = (unsigned)(u16)r0[2] | ((unsigned)(u16)r0[3] << 16);
      bw.z = (unsigned)(u16)r1[0] | ((unsigned)(u16)r1[1] << 16);
      bw.w = (unsigned)(u16)r1[2] | ((unsigned)(u16)r1[3] << 16);
      oacc[nt] = __builtin_amdgcn_mfma_f32_16x16x32_bf16(afrag, *reinterpret_cast<bf16x8*>(&bw), oacc[nt], 0, 0, 0);
    }
  }
  __builtin_amdgcn_wave_barrier();
  __builtin_amdgcn_sched_barrier(0);
  if (RD < 3) {
#pragma unroll
    for (int i = 0; i < 8; ++i) vv[i] = vn[i];
  }
}

__device__ __forceinline__ void phase_attn(const Params& p, char* smem) {
  const u16* QB = reinterpret_cast<const u16*>(p.ws + R_QB);
  const u16* KB = reinterpret_cast<const u16*>(p.ws + R_KB);
  const u16* VB = reinterpret_cast<const u16*>(p.ws + R_VB);
  const u16* SEL = reinterpret_cast<const u16*>(p.ws + R_SEL);
  const int* CNT = reinterpret_cast<const int*>(p.ws + R_CNT);
  u16* OB = reinterpret_cast<u16*>(p.ws + R_OB);
  const int tid = threadIdx.x, lane = tid & 63, wave = tid >> 6;
  const int g = lane >> 4, n = lane & 15;
  u16* Vs = reinterpret_cast<u16*>(smem) + wave * (64 * LDSK);
  int* sidx2 = reinterpret_cast<int*>(smem + 4 * 64 * LDSK * 2);
  const int kvh = wave;
  auto seqbase_of = [](int token) -> int {
    return token < NPR ? (token >> 12) * 4096 : NPR + ((token - NPR) >> 5) * 4128;
  };
  const int xq = blockIdx.x & 7, lbq = blockIdx.x >> 3, nlq = gridDim.x >> 3;
  auto token_of = [=](int it) -> int {
    return it < 32 ? NPR + xq * 32 + it : (xq >> 1) * 4096 + 2 * (it - 32) + (xq & 1);
  };
  int cur = 0, cnt_cur = 0;
  __syncthreads();
  if (lbq < 2080) {
    int t0 = token_of(lbq);
    cnt_cur = CNT[t0];
    sidx2[tid] = seqbase_of(t0) + (int)SEL[(size_t)t0 * 256 + tid];
  }
  __syncthreads();
  for (int it = lbq; it < 2080; it += nlq) {
    const int token = token_of(it);
    const int* sidx = sidx2 + cur * 256;
    const int cnt = cnt_cur;
    const int itn = it + nlq;
    const int tnext = itn < 2080 ? token_of(itn) : -1;
    int nsel = 0, ncnt = 0;
    if (tnext >= 0) {
      nsel = (int)SEL[(size_t)tnext * 256 + tid];
      ncnt = CNT[tnext];
    }
    bf16x8 qf[2];
    {
      uint4 t0 = zero4(), t1 = zero4();
      if (n < 4) {
        const u16* q = QB + (size_t)token * 1024 + (kvh * 4 + n) * 64 + 8 * g;
        t0 = ld16(q);
        t1 = ld16(q + 32);
      }
      qf[0] = *reinterpret_cast<bf16x8*>(&t0);
      qf[1] = *reinterpret_cast<bf16x8*>(&t1);
    }
    f32x4 sacc[16];
#pragma unroll
    for (int hb = 0; hb < 2; ++hb) {
      uint4 ka[8][2];
#pragma unroll
      for (int t = 0; t < 8; ++t) {
        int row = sidx[16 * (hb * 8 + t) + n];
        unsigned off = (unsigned)row * 512u + (unsigned)(kvh * 128 + 16 * g);
        ka[t][0] = ld16(reinterpret_cast<const char*>(KB) + off);
        ka[t][1] = ld16(reinterpret_cast<const char*>(KB) + off + 64u);
      }
      __builtin_amdgcn_sched_barrier(0);
#pragma unroll
      for (int t = 0; t < 8; ++t) {
        f32x4 acc = {0.f, 0.f, 0.f, 0.f};
        acc = __builtin_amdgcn_mfma_f32_16x16x32_bf16(*reinterpret_cast<bf16x8*>(&ka[t][0]), qf[0], acc, 0, 0, 0);
        acc = __builtin_amdgcn_mfma_f32_16x16x32_bf16(*reinterpret_cast<bf16x8*>(&ka[t][1]), qf[1], acc, 0, 0, 0);
        sacc[hb * 8 + t] = acc;
      }
      __builtin_amdgcn_sched_barrier(0);
    }
    uint4 vv[8];
    load_v_round(VB, sidx, 0, kvh, lane, vv);
    __builtin_amdgcn_sched_barrier(0);
    float m = -3.0e38f;
    if (cnt < 256) {
#pragma unroll
      for (int t = 0; t < 16; ++t)
#pragma unroll
        for (int r = 0; r < 4; ++r) {
          int slot = 16 * t + 4 * g + r;
          if (slot >= cnt) sacc[t][r] = -3.0e38f;
        }
    }
#pragma unroll
    for (int t = 0; t < 16; ++t)
#pragma unroll
      for (int r = 0; r < 4; ++r) m = fmaxf(m, sacc[t][r]);
    m = fmaxf(m, __shfl_xor(m, 16));
    m = fmaxf(m, __shfl_xor(m, 32));
    const float cexp = 0.125f * 1.4426950408889634f;
    const float mc = -m * cexp;
    float sum = 0.f;
#pragma unroll
    for (int t = 0; t < 16; ++t)
#pragma unroll
      for (int r = 0; r < 4; ++r) {
        float e = __builtin_amdgcn_exp2f(fmaf(sacc[t][r], cexp, mc));
        sacc[t][r] = e;
        sum += e;
      }
    sum += __shfl_xor(sum, 16);
    sum += __shfl_xor(sum, 32);
    const float inv = 1.f / sum;
    f32x4 oacc[4];
#pragma unroll
    for (int nt = 0; nt < 4; ++nt) oacc[nt] = (f32x4){0.f, 0.f, 0.f, 0.f};
    pv_round<0>(VB, sidx, kvh, lane, Vs, vv, sacc, 1.f, oacc);
    pv_round<1>(VB, sidx, kvh, lane, Vs, vv, sacc, 1.f, oacc);
    pv_round<2>(VB, sidx, kvh, lane, Vs, vv, sacc, 1.f, oacc);
    pv_round<3>(VB, sidx, kvh, lane, Vs, vv, sacc, 1.f, oacc);
    {
      float i0 = __shfl(inv, 0), i1 = __shfl(inv, 1), i2 = __shfl(inv, 2), i3 = __shfl(inv, 3);
#pragma unroll
      for (int nt = 0; nt < 4; ++nt) {
        oacc[nt][0] *= i0; oacc[nt][1] *= i1; oacc[nt][2] *= i2; oacc[nt][3] *= i3;
      }
    }
    if (lane < 16) {
#pragma unroll
      for (int nt = 0; nt < 4; ++nt)
#pragma unroll
        for (int r = 0; r < 4; ++r)
          OB[(size_t)token * 1024 + (kvh * 4 + r) * 64 + 16 * nt + lane] = f2bf(oacc[nt][r]);
    }
    if (tnext >= 0) sidx2[(cur ^ 1) * 256 + tid] = seqbase_of(tnext) + nsel;
    cnt_cur = ncnt;
    cur ^= 1;
    __syncthreads();
  }
}


#define XB_TMO      128
#define XB_XCNT(j)  (256  + 64 * (j))
#define XB_XSUB(j)  (1280 + 64 * (j))
#define XB_XGEN(j)  (2304 + 64 * (j))
#define XB_TOP      3328
#define XB_TOPGEN   3392
#define XCD_BAR_WORDS 3456
#define XB_SPIN_CAP (1u << 18)
#define LAS __attribute__((address_space(3)))

__device__ __forceinline__ unsigned xb_ld(unsigned* p) { return __hip_atomic_load(p, __ATOMIC_RELAXED, __HIP_MEMORY_SCOPE_AGENT); }
__device__ __forceinline__ unsigned xb_add(unsigned* p, unsigned v) { return __hip_atomic_fetch_add(p, v, __ATOMIC_RELAXED, __HIP_MEMORY_SCOPE_AGENT); }
__device__ __forceinline__ unsigned xb_xcc_id() { return (unsigned)__builtin_amdgcn_s_getreg((3 << 11) | 20) & 0xFu; }
#define XB_SPIN(cond, bar) do { unsigned _sp = 0; while (cond) { __builtin_amdgcn_s_sleep(1); \
    if ((++_sp & 255u) == 0u) { if (xb_ld(&(bar)[XB_TMO])) break; if (_sp > XB_SPIN_CAP) { atomicAdd(&(bar)[XB_TMO], 1u); break; } } } } while (0)

struct XcdBarrier {
  unsigned* bar; unsigned x;
  volatile LAS unsigned* st;
};
__device__ __forceinline__ XcdBarrier xcd_barrier_post(unsigned* bar, volatile LAS unsigned* st) {
  XcdBarrier b; b.bar = bar; b.x = xb_xcc_id(); b.st = st;
  if (threadIdx.x == 0) (void)xb_add(&bar[XB_XCNT(b.x)], 1u);
  return b;
}
__device__ __forceinline__ void xcd_barrier_complete(unsigned* bar, unsigned x, unsigned& nloc, unsigned& nx) {
  const unsigned G = gridDim.x * gridDim.y * gridDim.z;
  unsigned sum, cnt, mine, sp = 0u;
  for (;;) {
    sum = 0u; cnt = 0u; mine = 0u;
#pragma unroll
    for (unsigned j = 0; j < 16; ++j) { const unsigned c = xb_ld(&bar[XB_XCNT(j)]); sum += c; cnt += (c > 0u) ? 1u : 0u; mine = (j == x) ? c : mine; }
    if (sum == G) break;
    __builtin_amdgcn_s_sleep(1);
    if ((++sp & 255u) == 0u) { if (xb_ld(&bar[XB_TMO])) break; if (sp > XB_SPIN_CAP) { atomicAdd(&bar[XB_TMO], 1u); break; } }
  }
  nloc = mine > 0u ? mine : 1u; nx = cnt > 0u ? cnt : 1u;
}
__device__ __forceinline__ void xcd_barrier(const XcdBarrier& b) {
  asm volatile("s_waitcnt vmcnt(0)" ::: "memory");
  __syncthreads();
  if (threadIdx.x == 0) {
    unsigned* bar = b.bar;
    __builtin_amdgcn_s_waitcnt(0);
    unsigned nloc = b.st[0], nx = b.st[1];
    if (nloc == 0u) { xcd_barrier_complete(bar, b.x, nloc, nx); b.st[0] = nloc; b.st[1] = nx; }
    const unsigned old = xb_add(&bar[XB_XSUB(b.x)], 1u);
    const unsigned gen = old / nloc;
    if (old + 1u == (gen + 1u) * nloc) {
      __builtin_amdgcn_fence(__ATOMIC_RELEASE, "agent");
      asm volatile("s_waitcnt vmcnt(0)" ::: "memory");
      const unsigned og = xb_add(&bar[XB_TOP], 1u);
      const unsigned tg = og / nx;
      if (og + 1u == (tg + 1u) * nx) xb_add(&bar[XB_TOPGEN], 1u);
      else XB_SPIN(xb_ld(&bar[XB_TOPGEN]) == tg, bar);
      __builtin_amdgcn_fence(__ATOMIC_ACQUIRE, "agent");
      xb_add(&bar[XB_XGEN(b.x)], 1u);
      asm volatile("s_waitcnt vmcnt(0)" ::: "memory");
    } else {
      XB_SPIN(xb_ld(&bar[XB_XGEN(b.x)]) == gen, bar);
      __builtin_amdgcn_fence(__ATOMIC_ACQUIRE, "agent");
      asm volatile("s_waitcnt vmcnt(0)" ::: "memory");
    }
  }
  __syncthreads();
}

__global__ void __launch_bounds__(256, 2) mega(Params p) {
  __shared__ __attribute__((aligned(16))) char smem[SMEM_BYTES];
  __shared__ uint4 xb_words;
  if (threadIdx.x == 0) xb_words = make_uint4(0u, 0u, 0u, 0u);
  __syncthreads();
  XcdBarrier xb = xcd_barrier_post(reinterpret_cast<unsigned*>(p.ws + R_BAR), (volatile LAS unsigned*)&xb_words);
  if (p.use_cg) cg::this_grid().sync();
  phase0(p, smem);
  xcd_barrier(xb);
  phase1(p, smem);
  xcd_barrier(xb);
  phase2(p);
  xcd_barrier(xb);
  phase3(p, smem);
  xcd_barrier(xb);
  phase4(p, smem);
  xcd_barrier(xb);
  phase_norm(p, p.norm_ffn, false);
  xcd_barrier(xb);
  phase_up(p, 0, smem);
  xcd_barrier(xb);
  phase_resid_gemm(p, (const u16*)(p.ws + R_GT), (const u16*)(p.ws + W_DN), 2816, smem);
  xcd_barrier(xb);
  phase_norm(p, p.norm_mix + 1024, true);
  xcd_barrier(xb);
  phase_win(p, smem);
  xcd_barrier(xb);
  phase_index(p, smem);
  xcd_barrier(xb);
  phase_attn(p, smem);
  xcd_barrier(xb);
  phase_resid_gemm(p, (const u16*)(p.ws + R_OB), (const u16*)(p.ws + W_O), 1024, smem);
  xcd_barrier(xb);
  phase_norm(p, p.norm_ffn + 1024, false);
  xcd_barrier(xb);
  phase_up(p, 1, smem);
  xcd_barrier(xb);
  phase_resid_gemm(p, (const u16*)(p.ws + R_GT), (const u16*)(p.ws + W_DN) + (size_t)1024 * 2816, 2816, smem);
}

extern "C" void kernel_launch(void* const* d_in, const int* in_sizes, int n_in, void* d_out, int out_size, void* d_ws,
                              size_t ws_size, hipStream_t stream) {
  static int grid_blocks = 0;
  if (!grid_blocks) {
    int dev = 0, cus = 0, per_cu = 0;
    hipGetDevice(&dev);
    hipDeviceGetAttribute(&cus, hipDeviceAttributeMultiprocessorCount, dev);
    hipOccupancyMaxActiveBlocksPerMultiprocessor(&per_cu, mega, 256, 0);
    if (per_cu > 2) per_cu = 2;
    if (per_cu < 1) per_cu = 1;
    grid_blocks = cus * per_cu;
  }
  Params p{};
  const float** pf = reinterpret_cast<const float**>(&p);
  for (int i = 0; i < 28; ++i) pf[i] = reinterpret_cast<const float*>(d_in[i]);
  p.out = reinterpret_cast<float*>(d_out);
  p.ws = reinterpret_cast<char*>(d_ws);
  if (ws_size < WS_NEED) fprintf(stderr, "workspace too small: %zu < %zu\n", ws_size, (size_t)WS_NEED);
  p.use_cg = 0;
  p.pad0 = 0;
  hipMemsetAsync(reinterpret_cast<char*>(d_ws) + R_BAR, 0, 16384 + 4096, stream);
  void* args[] = {&p};
  hipError_t e = hipLaunchCooperativeKernel((void*)mega, dim3(grid_blocks), dim3(256), args, 0, stream);
  if (e != hipSuccess) fprintf(stderr, "cooperative launch failed: %s (grid %d)\n", hipGetErrorString(e), grid_blocks);
}
```
